# Optimizing an MI355X kernel written in HIP

```python
import math
import jax, jax.numpy as jnp
from jax import lax
import numpy as np

D_MODEL = 1024
BATCH = 2
SEQ = 16384
DEPTH = 2

CTX_LEN = 256
GRID_W = 64
GROUP_W = D_MODEL // 4
D_MIX = 4 * GROUP_W
HEAD_DIM = 64
EPS = 1e-6
A_BLOCKS = 4
A_BLK = GROUP_W // A_BLOCKS
CONV_W = 4
LRU_C = 8.0
B_HEADS = 4
B_DK = GROUP_W // B_HEADS
B_DV = GROUP_W // B_HEADS
B_CHUNK = 128
C_HEADS = 4
C_KV = 2
WINDOW = 128
BLK = 128
D_HEADS = 4
D_KV = 2
ROPE_THETA = 10000.0
N_EXPERTS = 16
CAP_FACTOR = 2
D_EXPERT = 1024

IN_WIDTHS = (GROUP_W, GROUP_W,
             GROUP_W, GROUP_W, GROUP_W, GROUP_W, GROUP_W,
             C_HEADS * HEAD_DIM, C_KV * HEAD_DIM, C_KV * HEAD_DIM,
             D_HEADS * HEAD_DIM, D_KV * HEAD_DIM, D_KV * HEAD_DIM)
D_IN = sum(IN_WIDTHS)

kernel_name = "hybrid_parallel_heads_ec_moe_dit"


def rmsnorm(x, w):
    x32 = x.astype(jnp.float32)
    y = x32 * lax.rsqrt(jnp.mean(x32 * x32, axis=-1, keepdims=True) + EPS)
    return y.astype(x.dtype) * w


def modulate(h, shift, scale):
    return h * (1.0 + scale) + shift


def split_in(z):
    offs = np.cumsum(IN_WIDTHS)[:-1].tolist()
    return jnp.split(z, offs, axis=-1)


def split_heads(t, n):
    return t.reshape(*t.shape[:-1], n, t.shape[-1] // n)


def axial_rope(rows):
    half = HEAD_DIM // 2
    n_freq = half // 2
    inv = ROPE_THETA ** (-jnp.arange(n_freq, dtype=jnp.float32) * 2.0 / half)
    r = jnp.repeat(jnp.arange(rows, dtype=jnp.float32), GRID_W)
    col = jnp.tile(jnp.arange(GRID_W, dtype=jnp.float32), rows)
    ang = jnp.stack([r[:, None] * inv, col[:, None] * inv], axis=1)
    return jnp.cos(ang), jnp.sin(ang)


def apply_rope(x, cos, sin):
    xr = x.reshape(*x.shape[:-1], 2, 2, HEAD_DIM // 4)
    x1, x2 = xr[..., 0, :], xr[..., 1, :]
    c = cos[None, :, None].astype(x.dtype)
    s = sin[None, :, None].astype(x.dtype)
    return jnp.stack([x1 * c - x2 * s, x2 * c + x1 * s], axis=-2).reshape(x.shape)


def conv_centred(x, w, b):
    left = CONV_W // 2
    xp = jnp.pad(x, ((0, 0), (left, CONV_W - 1 - left), (0, 0)))
    L = x.shape[1]
    return sum(xp[:, j:j + L] * w[j] for j in range(CONV_W)) + b


def block_diag(x, w, b):
    xb = x.reshape(*x.shape[:-1], A_BLOCKS, A_BLK)
    return jnp.einsum('blni,nij->blnj', xb, w).reshape(x.shape) + b


def lru_coeffs(x, wa, ba, wx, bx, lam):
    xf = x.astype(jnp.float32)
    r = jax.nn.sigmoid(block_diag(xf, wa, ba))
    i = jax.nn.sigmoid(block_diag(xf, wx, bx))
    log_a = -LRU_C * r * jax.nn.softplus(-lam.astype(jnp.float32))
    a = jnp.exp(log_a)
    u = jnp.sqrt(-jnp.expm1(2.0 * log_a)) * (i * xf)
    return a, u


def _lin_combine(e1, e2):
    a1, u1 = e1
    a2, u2 = e2
    return a1 * a2, a2 * u1 + u2


def linear_scan(a, u, h0):
    u = u.at[:, 0].add(a[:, 0] * h0)
    _, h = lax.associative_scan(_lin_combine, (a, u), axis=1)
    return h


def hgrn_forget(f_raw, lb):
    z = f_raw.astype(jnp.float32)
    log_f = jnp.logaddexp(jnp.log(lb), jnp.log1p(-lb) + jax.nn.log_sigmoid(z))
    k = (1.0 - lb) * jax.nn.sigmoid(-z)
    return log_f, k


def hgrn_inputs(q_raw, f_fwd, f_bwd, i_raw, lb):
    q = split_heads(jax.nn.silu(q_raw.astype(jnp.float32)) * (B_DK ** -0.5), B_HEADS)
    v = split_heads(i_raw.astype(jnp.float32), B_HEADS)
    dirs = []
    for f_raw in (f_fwd, f_bwd):
        log_f, k = hgrn_forget(f_raw, lb)
        dirs.append((q, split_heads(k, B_HEADS), v, split_heads(log_f, B_HEADS)))
    return dirs


def hgrn2_chunk_scan(q, k, v, logf, S0):
    Bn, L, H, dk = q.shape
    n = L // B_CHUNK
    mask = jnp.tril(jnp.ones((B_CHUNK, B_CHUNK), dtype=bool))[None, :, :, None, None]

    def to_chunks(t):
        return jnp.moveaxis(t.reshape(Bn, n, B_CHUNK, *t.shape[2:]), 1, 0)

    def step(S, inp):
        qc, kc, vc, gc = inp
        b = jnp.cumsum(gc, axis=1)
        o = jnp.einsum('bthk,bhkv->bthv', qc * jnp.exp(b), S)
        decay = jnp.exp(jnp.where(mask, b[:, :, None] - b[:, None, :], -jnp.inf))
        attn = jnp.einsum('bthk,bshk,btshk->bhts', qc, kc, decay)
        o = o + jnp.einsum('bhts,bshv->bthv', attn, vc)
        b_last = b[:, -1]
        S = jnp.exp(b_last)[..., None] * S + jnp.einsum('bshk,bshv->bhkv', kc * jnp.exp(b_last[:, None] - b), vc)
        return S, o

    S, o = lax.scan(step, S0, tuple(to_chunks(t) for t in (q, k, v, logf)))
    return jnp.moveaxis(o, 0, 1).reshape(Bn, L, H, v.shape[-1]), S


def hgrn_readout(o, g, w):
    y = rmsnorm(o, w)
    return y.reshape(*y.shape[:-2], GROUP_W).astype(g.dtype) * jax.nn.silu(g)


def bidirectional(scan_dir, ctx_ins, lat_ins, ctx_out):
    y_ctx, y_lat = None, None
    for d in range(2):
        flip = (lambda t: jnp.flip(t, axis=1)) if d == 1 else (lambda t: t)
        yc, state = scan_dir(d, [flip(t) for t in ctx_ins[d]], None)
        yl, _ = scan_dir(d, [flip(t) for t in lat_ins[d]], state)
        y_lat = flip(yl) if y_lat is None else y_lat + flip(yl)
        if ctx_out:
            y_ctx = flip(yc) if y_ctx is None else y_ctx + flip(yc)
    return y_ctx, y_lat


def ctx_attention(q, k, v, sink):
    Bn, Lc, Hq, d = q.shape
    hk = k.shape[2]
    g = Hq // hk
    qg = q.reshape(Bn, Lc, hk, g, d) * (d ** -0.5)
    s = jnp.einsum('bqhgd,bkhd->bhgqk', qg, k).astype(jnp.float32)
    if sink is not None:
        sc = jnp.broadcast_to(sink.reshape(hk, g).astype(jnp.float32)[None, :, :, None, None], s.shape[:-1] + (1,))
        p = jax.nn.softmax(jnp.concatenate([sc, s], axis=-1), axis=-1)[..., 1:]
    else:
        p = jax.nn.softmax(s, axis=-1)
    return jnp.einsum('bhgqk,bkhd->bqhgd', p.astype(v.dtype), v).reshape(Bn, Lc, Hq * d)


def window_attention(q, k, v, k_ctx, v_ctx, sink):
    Bn, L, Hq, d = q.shape
    hk = k.shape[2]
    g = Hq // hk
    nb = L // BLK
    Lc = k_ctx.shape[1]
    qb = jnp.moveaxis(q.reshape(Bn, nb, BLK, hk, g, d), 1, 0) * (d ** -0.5)

    def band(t):
        tp = jnp.pad(t, ((0, 0), (BLK, BLK), (0, 0), (0, 0))).reshape(Bn, nb + 2, BLK, hk, d)
        tb = jnp.concatenate([tp[:, :-2], tp[:, 1:-1], tp[:, 2:]], axis=2)
        return jnp.moveaxis(tb, 1, 0)

    kb, vb = band(k), band(v)
    qpos = jnp.arange(nb)[:, None] * BLK + jnp.arange(BLK)[None]
    kpos = (jnp.arange(nb)[:, None] - 1) * BLK + jnp.arange(3 * BLK)[None]
    valid = ((kpos[:, None, :] >= 0) & (kpos[:, None, :] < L)
             & (jnp.abs(qpos[:, :, None] - kpos[:, None, :]) <= WINDOW))
    sink_logit = sink.reshape(hk, g).astype(jnp.float32)

    def one_block(args):
        qblk, kblk, vblk, vmask = args
        s_c = jnp.einsum('bqhgd,bkhd->bhgqk', qblk, k_ctx).astype(jnp.float32)
        s_w = jnp.where(vmask, jnp.einsum('bqhgd,bkhd->bhgqk', qblk, kblk).astype(jnp.float32), -jnp.inf)
        sc = jnp.broadcast_to(sink_logit[None, :, :, None, None], s_c.shape[:-1] + (1,))
        p = jax.nn.softmax(jnp.concatenate([sc, s_c, s_w], axis=-1), axis=-1).astype(v.dtype)
        return (jnp.einsum('bhgqk,bkhd->bqhgd', p[..., 1:1 + Lc], v_ctx)
                + jnp.einsum('bhgqk,bkhd->bqhgd', p[..., 1 + Lc:], vblk))

    out = lax.map(one_block, (qb, kb, vb, valid))
    return jnp.moveaxis(out, 0, 1).reshape(Bn, L, Hq * d)


def dense_attention(q, k, v, k_ctx, v_ctx):
    Bn, L, Hq, d = q.shape
    hk = k.shape[2]
    g = Hq // hk
    nb = L // BLK
    k_all = jnp.concatenate([k_ctx, k], axis=1)
    v_all = jnp.concatenate([v_ctx, v], axis=1)
    qb = jnp.moveaxis(q.reshape(Bn, nb, BLK, hk, g, d), 1, 0) * (d ** -0.5)

    def one_block(qblk):
        s = jnp.einsum('bqhgd,bkhd->bhgqk', qblk, k_all).astype(jnp.float32)
        p = jax.nn.softmax(s, axis=-1).astype(v.dtype)
        return jnp.einsum('bhgqk,bkhd->bqhgd', p, v_all)

    out = lax.map(one_block, qb)
    return jnp.moveaxis(out, 0, 1).reshape(Bn, L, Hq * d)


def mixer(hl, hc, cos, sin, lb, p, ctx_out):
    dt = hl.dtype
    (ax_l, ay_l, bq_l, bff_l, bfb_l, bi_l, bg_l, cq_l, ck_l, cv_l, dq_l, dk_l, dv_l) = split_in(hl @ p['w_in'])
    (ax_c, ay_c, bq_c, bff_c, bfb_c, bi_c, bg_c, cq_c, ck_c, cv_c, dq_c, dk_c, dv_c) = split_in(hc @ p['w_in'])

    xa_l = conv_centred(ax_l, p['a_conv_w'], p['a_conv_b'])
    xa_c = conv_centred(ax_c, p['a_conv_w'], p['a_conv_b'])

    def a_dir(d, ins, h0):
        (xin,) = ins
        a, u = lru_coeffs(xin, p['a_gate_a_w'][d], p['a_gate_a_b'][d], p['a_gate_x_w'][d],
                          p['a_gate_x_b'][d], p['a_lambda'][d])
        if h0 is None:
            h0 = jnp.zeros_like(u[:, 0])
        h = linear_scan(a, u, h0)
        return h, h[:, -1]

    ha_c, ha_l = bidirectional(a_dir, [(xa_c,), (xa_c,)], [(xa_l,), (xa_l,)], ctx_out)
    ya_l = ha_l.astype(dt) * jax.nn.gelu(ay_l)

    def b_dir(d, ins, S0):
        q, k, v, g = ins
        if S0 is None:
            S0 = jnp.zeros((q.shape[0], B_HEADS, B_DK, B_DV), jnp.float32)
        return hgrn2_chunk_scan(q, k, v, g, S0)

    hb_c, hb_l = bidirectional(b_dir, hgrn_inputs(bq_c, bff_c, bfb_c, bi_c, lb),
                               hgrn_inputs(bq_l, bff_l, bfb_l, bi_l, lb), ctx_out)
    yb_l = hgrn_readout(hb_l, bg_l, p['b_onorm_w'])

    ck_ch, cv_ch = split_heads(ck_c, C_KV), split_heads(cv_c, C_KV)
    yc_l = window_attention(apply_rope(split_heads(cq_l, C_HEADS), cos, sin),
                            apply_rope(split_heads(ck_l, C_KV), cos, sin), split_heads(cv_l, C_KV),
                            ck_ch, cv_ch, p['c_sink'])

    dk_ch = rmsnorm(split_heads(dk_c, D_KV), p['d_knorm_w'])
    dv_ch = split_heads(dv_c, D_KV)
    yd_l = dense_attention(apply_rope(rmsnorm(split_heads(dq_l, D_HEADS), p['d_qnorm_w']), cos, sin),
                           apply_rope(rmsnorm(split_heads(dk_l, D_KV), p['d_knorm_w']), cos, sin),
                           split_heads(dv_l, D_KV), dk_ch, dv_ch)

    out_l = jnp.concatenate([ya_l, yb_l, yc_l, yd_l], axis=-1) @ p['w_out']
    if not ctx_out:
        return out_l, None
    ya_c = ha_c.astype(dt) * jax.nn.gelu(ay_c)
    yb_c = hgrn_readout(hb_c, bg_c, p['b_onorm_w'])
    yc_c = ctx_attention(split_heads(cq_c, C_HEADS), ck_ch, cv_ch, p['c_sink'])
    yd_c = ctx_attention(rmsnorm(split_heads(dq_c, D_HEADS), p['d_qnorm_w']), dk_ch, dv_ch, None)
    out_c = jnp.concatenate([ya_c, yb_c, yc_c, yd_c], axis=-1) @ p['w_out']
    return out_l, out_c


def expert_choice_ffn(h, w_router, w1, w3, w2):
    Bn, N, D = h.shape
    cap = max(1, CAP_FACTOR * N // N_EXPERTS)
    aff = jax.nn.softmax((h @ w_router).astype(jnp.float32), axis=-1)
    gate, idx = lax.top_k(jnp.swapaxes(aff, 1, 2), cap)
    xs = jax.vmap(lambda hb, ib: hb[ib])(h, idx)
    hid = jax.nn.silu(jnp.einsum('becd,edf->becf', xs, w1)) * jnp.einsum('becd,edf->becf', xs, w3)
    y = jnp.einsum('becf,efd->becd', hid, w2) * gate[..., None].astype(h.dtype)
    return jax.vmap(lambda yb, ib: jnp.zeros((N, D), yb.dtype).at[ib].add(yb))(y, idx)


def setup_inputs(seed: int = 0) -> dict:
    key = jax.random.key(seed)
    ks = list(jax.random.split(key, 32))

    def nrm(shape, scale):
        return jax.random.normal(ks.pop(), shape, jnp.float32) * scale

    a0 = jax.random.uniform(ks.pop(), (DEPTH, 2, GROUP_W), jnp.float32, minval=0.9, maxval=0.999)
    pa = a0 ** (1.0 / LRU_C)
    a_lambda = jnp.log(pa) - jnp.log1p(-pa)
    return {
        'x': nrm((BATCH, SEQ, D_MODEL), 1.0),
        'c': nrm((BATCH, D_MODEL), 1.0),
        'ctx': nrm((BATCH, CTX_LEN, D_MODEL), 1.0),
        'c_ctx': nrm((D_MODEL,), 1.0),
        'mod_w': nrm((DEPTH, D_MODEL, 6 * D_MODEL), 0.5 * D_MODEL ** -0.5),
        'mod_b': nrm((DEPTH, 6 * D_MODEL), 0.01),
        'norm1_w': 1.0 + nrm((DEPTH, D_MODEL), 0.02),
        'w_in': nrm((DEPTH, D_MODEL, D_IN), D_MODEL ** -0.5),
        'a_conv_w': nrm((DEPTH, CONV_W, GROUP_W), CONV_W ** -0.5),
        'a_conv_b': nrm((DEPTH, GROUP_W), 0.01),
        'a_gate_a_w': nrm((DEPTH, 2, A_BLOCKS, A_BLK, A_BLK), A_BLK ** -0.5),
        'a_gate_a_b': nrm((DEPTH, 2, GROUP_W), 0.01),
        'a_gate_x_w': nrm((DEPTH, 2, A_BLOCKS, A_BLK, A_BLK), A_BLK ** -0.5),
        'a_gate_x_b': nrm((DEPTH, 2, GROUP_W), 0.01),
        'a_lambda': a_lambda,
        'b_lb_logits': nrm((DEPTH, GROUP_W), 0.5),
        'b_onorm_w': 1.0 + nrm((DEPTH, B_DV), 0.02),
        'c_sink': nrm((DEPTH, C_HEADS), 0.5),
        'd_qnorm_w': 1.0 + nrm((DEPTH, HEAD_DIM), 0.02),
        'd_knorm_w': 1.0 + nrm((DEPTH, HEAD_DIM), 0.02),
        'w_out': nrm((DEPTH, D_MIX, D_MODEL), D_MIX ** -0.5),
        'norm2_w': 1.0 + nrm((DEPTH, D_MODEL), 0.02),
        'router_w': nrm((DEPTH, D_MODEL, N_EXPERTS), D_MODEL ** -0.5),
        'exp_w1': nrm((DEPTH, N_EXPERTS, D_MODEL, D_EXPERT), D_MODEL ** -0.5),
        'exp_w3': nrm((DEPTH, N_EXPERTS, D_MODEL, D_EXPERT), D_MODEL ** -0.5),
        'exp_w2': nrm((DEPTH, N_EXPERTS, D_EXPERT, D_MODEL), D_EXPERT ** -0.5),
        'final_norm_w': 1.0 + nrm((D_MODEL,), 0.02),
    }


def reference(x, c, ctx, c_ctx, mod_w, mod_b, norm1_w, w_in, a_conv_w, a_conv_b, a_gate_a_w, a_gate_a_b,
              a_gate_x_w, a_gate_x_b, a_lambda, b_lb_logits, b_onorm_w, c_sink, d_qnorm_w, d_knorm_w, w_out,
              norm2_w, router_w, exp_w1, exp_w3, exp_w2, final_norm_w):
    L = x.shape[1]
    ROWS = L // GRID_W
    cos, sin = axial_rope(ROWS)
    lb = jnp.cumsum(jax.nn.softmax(b_lb_logits.astype(jnp.float32), axis=0), axis=0)
    lb = lb - lb[0]
    s_lat = jax.nn.silu(c)[:, None, :]
    s_ctx = jax.nn.silu(c_ctx)[None, None, :]
    xl, xc = x, ctx
    for l in range(DEPTH):
        last = l == DEPTH - 1
        p = {'w_in': w_in[l], 'w_out': w_out[l], 'a_conv_w': a_conv_w[l], 'a_conv_b': a_conv_b[l],
             'a_gate_a_w': a_gate_a_w[l], 'a_gate_a_b': a_gate_a_b[l], 'a_gate_x_w': a_gate_x_w[l],
             'a_gate_x_b': a_gate_x_b[l], 'a_lambda': a_lambda[l], 'b_onorm_w': b_onorm_w[l],
             'c_sink': c_sink[l], 'd_qnorm_w': d_qnorm_w[l], 'd_knorm_w': d_knorm_w[l]}
        m_l = jnp.split(s_lat @ mod_w[l] + mod_b[l], 6, axis=-1)
        m_c = jnp.split(s_ctx @ mod_w[l] + mod_b[l], 6, axis=-1)
        hl = modulate(rmsnorm(xl, norm1_w[l]), m_l[0], m_l[1])
        hc = modulate(rmsnorm(xc, norm1_w[l]), m_c[0], m_c[1])
        ol, oc = mixer(hl, hc, cos, sin, lb[l], p, not last)
        xl = xl + m_l[2] * ol
        hl = modulate(rmsnorm(xl, norm2_w[l]), m_l[3], m_l[4])
        xl = xl + m_l[5] * expert_choice_ffn(hl, router_w[l], exp_w1[l], exp_w3[l], exp_w2[l])
        if not last:
            xc = xc + m_c[2] * oc
            hc = modulate(rmsnorm(xc, norm2_w[l]), m_c[3], m_c[4])
            xc = xc + m_c[5] * expert_choice_ffn(hc, router_w[l], exp_w1[l], exp_w3[l], exp_w2[l])
    return rmsnorm(xl, final_norm_w)
```

```cpp
#ifndef CPU_TEST
#include <hip/hip_runtime.h>
#include <cstdio>
#include <cstdint>
#define HD __device__ __forceinline__
#else
#include <cmath>
#include <cstdio>
#include <cstdint>
#include <cstring>
#define HD inline
#endif

#ifndef CFG_SEQ
#define CFG_SEQ 16384
#endif
#ifndef CFG_CTX
#define CFG_CTX 256
#endif

typedef unsigned short bf16_t;
typedef long long i64;

constexpr int NB = 2, L = CFG_SEQ, LC = CFG_CTX, D = 1024, DIN = 2816;
constexpr int NLAT = NB * L, NCTX = NB * LC, NR = NLAT + NCTX;
constexpr int NE = 16, CAP_L = 2 * L / NE, CAP_C = 2 * LC / NE;
constexpr int SLOTS_L = NB * CAP_L, SLOTS_ALL = NB * CAP_L + NB * CAP_C, SLOTS_PAD = ((SLOTS_ALL + 255) / 256) * 256;
constexpr int WINDOW = 128;
constexpr float EPS = 1e-6f;
constexpr int Z_AX = 0, Z_AY = 256, Z_BQ = 512, Z_BFF = 768, Z_BFB = 1024, Z_BI = 1280, Z_BG = 1536,
              Z_CQ = 1792, Z_CK = 2048, Z_CV = 2176, Z_DQ = 2304, Z_DK = 2560, Z_DV = 2688;

struct Params {
    const float *x, *c, *ctx, *c_ctx, *mod_w, *mod_b, *norm1_w, *w_in, *a_conv_w, *a_conv_b, *a_gate_a_w, *a_gate_a_b,
                *a_gate_x_w, *a_gate_x_b, *a_lambda, *b_lb_logits, *b_onorm_w, *c_sink, *d_qnorm_w, *d_knorm_w, *w_out,
                *norm2_w, *router_w, *exp_w1, *exp_w3, *exp_w2, *final_norm_w;
    float* out;
    unsigned* bar;
    float *MOD, *LB, *ROPE, *XC, *AFF, *GATE;
    int *ROWLIST, *INV;
    bf16_t *H, *Z, *YM, *HID, *Y;
    float *XA, *CA, *CU, *BQ, *BF, *BK, *HB;
};

struct Carver { char* base; size_t off; void* take(size_t bytes) { void* p = base + off; off += (bytes + 255) & ~(size_t)255; return p; } };
inline size_t carve(Params& P, char* ws) {
    Carver c{ws, 0};
    P.bar = (unsigned*)c.take(16384);
    P.MOD = (float*)c.take(sizeof(float) * 2 * 3 * 6 * D);
    P.LB = (float*)c.take(sizeof(float) * 2 * 256);
    P.ROPE = (float*)c.take(sizeof(float) * 256 * 16 * 2);
    P.XC = (float*)c.take(sizeof(float) * (size_t)NCTX * D);
    P.AFF = (float*)c.take(sizeof(float) * (size_t)4 * NE * L);
    P.GATE = (float*)c.take(sizeof(float) * (size_t)NE * SLOTS_PAD);
    P.ROWLIST = (int*)c.take(sizeof(int) * (size_t)NE * SLOTS_PAD);
    P.INV = (int*)c.take(sizeof(int) * (size_t)NR * NE);
    P.H = (bf16_t*)c.take(2 * (size_t)NR * D);
    P.YM = (bf16_t*)c.take(2 * (size_t)NR * D);
    const size_t zbytes = 2 * (size_t)NR * DIN, hidbytes = 2 * (size_t)NE * SLOTS_PAD * D;
    char* zreg = (char*)c.take(zbytes > hidbytes ? zbytes : hidbytes);
    P.Z = (bf16_t*)zreg; P.HID = (bf16_t*)zreg;
    const size_t f256 = sizeof(float) * (size_t)NR * 256;
    size_t tbytes = 7 * f256; if (tbytes < hidbytes) tbytes = hidbytes;
    char* treg = (char*)c.take(tbytes);
    P.XA = (float*)treg; P.CA = (float*)(treg + f256); P.CU = (float*)(treg + 3 * f256);
    P.BQ = (float*)treg; P.BF = (float*)(treg + f256); P.BK = (float*)(treg + 3 * f256); P.HB = (float*)(treg + 5 * f256);
    P.Y = (bf16_t*)treg;
    return c.off;
}

HD float bf2f(bf16_t v) { union { unsigned u; float f; } c; c.u = ((unsigned)v) << 16; return c.f; }
HD bf16_t f2bf(float f) { union { unsigned u; float f; } c; c.f = f; unsigned u = c.u; u += 0x7FFFu + ((u >> 16) & 1u); return (bf16_t)(u >> 16); }
HD float sigmoidf_(float x) { return 1.0f / (1.0f + expf(-x)); }
HD float siluf_(float x) { return x * sigmoidf_(x); }
HD float gelu_tanh_(float x) { return 0.5f * x * (1.0f + tanhf(0.7978845608028654f * (x + 0.044715f * x * x * x))); }

HD int row_who(int row) { return row < NLAT ? row / L : 2; }
HD int row_seg(int row) { return row < NLAT ? row / L : 2 + (row - NLAT) / LC; }
HD int seg_base(int seg) { return seg < 2 ? seg * L : NLAT + (seg - 2) * LC; }
HD int seg_len(int seg) { return seg < 2 ? L : LC; }
HD const float* modv(const Params& P, int l, int who, int part) { return P.MOD + ((size_t)(l * 3 + who) * 6 + part) * D; }
HD const float* xsrc_row(const Params& P, int l, int row) {
    if (row < NLAT) return (l == 0 ? P.x : P.out) + (size_t)row * D;
    return (l == 0 ? P.ctx : P.XC) + (size_t)(row - NLAT) * D;
}
HD float* xcur_row(const Params& P, int row) { return row < NLAT ? P.out + (size_t)row * D : P.XC + (size_t)(row - NLAT) * D; }
HD int nrows_out(int l) { return l == 0 ? NR : NLAT; }

HD void st_mod(const Params& P, i64 i) {
    const int n = (int)(i % (6 * D)), who = (int)((i / (6 * D)) % 3), l = (int)(i / (6 * D) / 3);
    const float* cv = who < 2 ? P.c + who * D : P.c_ctx;
    const float* w = P.mod_w + (size_t)l * D * 6 * D + n;
    float s = 0.f;
    for (int k = 0; k < D; ++k) s += siluf_(cv[k]) * w[(size_t)k * 6 * D];
    P.MOD[i] = s + P.mod_b[l * 6 * D + n];
}
HD void st_lb(const Params& P, i64 i) {
    const float a = P.b_lb_logits[i], b = P.b_lb_logits[256 + i], m = fmaxf(a, b);
    const float ea = expf(a - m), eb = expf(b - m), s0 = ea / (ea + eb), s1 = eb / (ea + eb);
    P.LB[i] = s0 - s0; P.LB[256 + i] = (s0 + s1) - s0;
}
HD void st_rope(const Params& P, i64 i) {
    const int f = (int)(i & 15), pos = (int)(i >> 4);
    const float inv = (float)exp(-(double)f / 16.0 * 9.210340371976184);
    const float ang = (float)pos * inv;
    double y = (double)ang;
    const double twopi = 6.283185307179586476925;
    y -= twopi * floor(y / twopi + 0.5);
    double s = 0.0, cc = 0.0, term = 1.0;
    for (int n = 0; n < 30; ++n) { if (n & 1) s += ((n >> 1) & 1) ? -term : term; else cc += ((n >> 1) & 1) ? -term : term; term *= y / (double)(n + 1); }
    P.ROPE[i * 2] = (float)cc; P.ROPE[i * 2 + 1] = (float)s;
}

HD void st_norm1(const Params& P, int l, i64 row) {
    const float* x = xsrc_row(P, l, (int)row);
    float ss = 0.f; for (int d = 0; d < D; ++d) ss += x[d] * x[d];
    const float rstd = 1.0f / sqrtf(ss * (1.0f / D) + EPS);
    const int who = row_who((int)row);
    const float *sh = modv(P, l, who, 0), *sc = modv(P, l, who, 1), *w = P.norm1_w + l * D;
    bf16_t* h = P.H + (size_t)row * D;
    for (int d = 0; d < D; ++d) h[d] = f2bf(x[d] * rstd * w[d] * (1.0f + sc[d]) + sh[d]);
}
HD void st_inproj(const Params& P, int l, i64 i) {
    const int n = (int)(i % DIN); const i64 row = i / DIN;
    const bf16_t* h = P.H + (size_t)row * D; const float* w = P.w_in + (size_t)l * D * DIN + n;
    float s = 0.f; for (int k = 0; k < D; ++k) s += bf2f(h[k]) * w[(size_t)k * DIN];
    P.Z[i] = f2bf(s);
}
HD void st_xa(const Params& P, int l, i64 i) {
    const int ch = (int)(i & 255), row = (int)(i >> 8), seg = row_seg(row), t = row - seg_base(seg), len = seg_len(seg);
    float s = P.a_conv_b[l * 256 + ch];
    for (int j = 0; j < 4; ++j) { const int tt = t + j - 2; if (tt >= 0 && tt < len) s += P.a_conv_w[(l * 4 + j) * 256 + ch] * bf2f(P.Z[(size_t)(row + j - 2) * DIN + Z_AX + ch]); }
    P.XA[i] = s;
}
HD void st_a_coef(const Params& P, int l, i64 i) {
    const int ch = (int)(i & 255); const i64 rr = i >> 8; const int row = (int)(rr % NR), dir = (int)(rr / NR);
    const int n = ch >> 6, j = ch & 63;
    const float* xa = P.XA + (size_t)row * 256 + n * 64;
    const float* wa = P.a_gate_a_w + ((size_t)((l * 2 + dir) * 4 + n) * 64) * 64 + j;
    const float* wx = P.a_gate_x_w + ((size_t)((l * 2 + dir) * 4 + n) * 64) * 64 + j;
    float ra = P.a_gate_a_b[(l * 2 + dir) * 256 + ch], ri = P.a_gate_x_b[(l * 2 + dir) * 256 + ch];
    for (int k = 0; k < 64; ++k) { ra += xa[k] * wa[k * 64]; ri += xa[k] * wx[k * 64]; }
    const float r = sigmoidf_(ra), ig = sigmoidf_(ri);
    const float lam = P.a_lambda[(l * 2 + dir) * 256 + ch];
    const float log_a = -8.0f * r * log1pf(expf(-lam));
    P.CA[i] = expf(log_a);
    P.CU[i] = sqrtf(-expm1f(2.0f * log_a)) * (ig * xa[j]);
}
HD void st_a_scan(const Params& P, int l, i64 i) {
    const int ch = (int)(i & 255), dir = (int)((i >> 8) & 1), b = (int)(i >> 9);
    float h = 0.f;
    for (int part = 0; part < 2; ++part) {
        const int seg = part == 0 ? 2 + b : b, base = seg_base(seg), len = seg_len(seg);
        for (int s = 0; s < len; ++s) { const int t = dir ? len - 1 - s : s; const size_t idx = ((size_t)dir * NR + base + t) * 256 + ch;
            h = P.CA[idx] * h + P.CU[idx]; P.CU[idx] = h; }
    }
}
HD void st_a_out(const Params& P, int l, i64 i) {
    const int ch = (int)(i & 255); const size_t row = (size_t)(i >> 8);
    const float ha = P.CU[row * 256 + ch] + P.CU[((size_t)NR + row) * 256 + ch];
    P.YM[row * D + ch] = f2bf(ha * gelu_tanh_(bf2f(P.Z[row * DIN + Z_AY + ch])));
}
HD void st_b_pre(const Params& P, int l, i64 i) {
    const int ch = (int)(i & 255); const size_t row = (size_t)(i >> 8);
    const float lb = P.LB[l * 256 + ch];
    P.BQ[i] = siluf_(bf2f(P.Z[row * DIN + Z_BQ + ch])) * 0.125f;
    for (int dir = 0; dir < 2; ++dir) { const float z = bf2f(P.Z[row * DIN + Z_BFF + dir * 256 + ch]);
        P.BF[(size_t)dir * NR * 256 + i] = lb + (1.0f - lb) * sigmoidf_(z); P.BK[(size_t)dir * NR * 256 + i] = (1.0f - lb) * sigmoidf_(-z); }
}
HD void st_b_scan(const Params& P, int l, i64 i) {
    const int v = (int)(i & 63), head = (int)((i >> 6) & 3), dir = (int)((i >> 8) & 1), b = (int)(i >> 9);
    float S[64];
#pragma unroll
    for (int k = 0; k < 64; ++k) S[k] = 0.f;
    for (int part = 0; part < 2; ++part) {
        const int seg = part == 0 ? 2 + b : b, base = seg_base(seg), len = seg_len(seg);
        for (int s = 0; s < len; ++s) { const int t = dir ? len - 1 - s : s; const size_t row = (size_t)(base + t);
            const float* f = P.BF + ((size_t)dir * NR + row) * 256 + head * 64; const float* kk = P.BK + ((size_t)dir * NR + row) * 256 + head * 64; const float* q = P.BQ + row * 256 + head * 64;
            const float vv = bf2f(P.Z[row * DIN + Z_BI + head * 64 + v]); float o = 0.f;
#pragma unroll
            for (int k = 0; k < 64; ++k) { S[k] = f[k] * S[k] + kk[k] * vv; o += q[k] * S[k]; }
            P.HB[((size_t)dir * NR + row) * 256 + head * 64 + v] = o; }
    }
}
HD void st_b_out(const Params& P, int l, i64 i) {
    const int head = (int)(i & 3); const size_t row = (size_t)(i >> 2);
    const float* o0 = P.HB + row * 256 + head * 64; const float* o1 = P.HB + ((size_t)NR + row) * 256 + head * 64;
    float ss = 0.f; for (int v = 0; v < 64; ++v) { const float o = o0[v] + o1[v]; ss += o * o; }
    const float rstd = 1.0f / sqrtf(ss * (1.0f / 64.0f) + EPS);
    for (int v = 0; v < 64; ++v) { const float o = o0[v] + o1[v];
        P.YM[row * D + 256 + head * 64 + v] = f2bf(o * rstd * P.b_onorm_w[l * 64 + v] * siluf_(bf2f(P.Z[row * DIN + Z_BG + head * 64 + v]))); }
}
HD void st_qkv_prep(const Params& P, int l, i64 i) {
    const int hs = (int)(i % 12), row = (int)(i / 12);
    const bool lat = row < NLAT;
    int col; const float* nw = nullptr;
    if (hs < 4) col = Z_CQ + hs * 64; else if (hs < 6) col = Z_CK + (hs - 4) * 64;
    else if (hs < 10) { col = Z_DQ + (hs - 6) * 64; nw = P.d_qnorm_w + l * 64; } else { col = Z_DK + (hs - 10) * 64; nw = P.d_knorm_w + l * 64; }
    if (!lat && !nw) return;
    bf16_t* p = P.Z + (size_t)row * DIN + col;
    float x[64];
#pragma unroll
    for (int e = 0; e < 64; ++e) x[e] = bf2f(p[e]);
    if (nw) { float ss = 0.f;
#pragma unroll
        for (int e = 0; e < 64; ++e) ss += x[e] * x[e];
        const float rstd = 1.0f / sqrtf(ss * (1.0f / 64.0f) + EPS);
#pragma unroll
        for (int e = 0; e < 64; ++e) x[e] = x[e] * rstd * nw[e]; }
    if (lat) { const int t = row % L, pr = t / 64, pc = t % 64;
#pragma unroll
        for (int f = 0; f < 16; ++f) {
            { const float c = P.ROPE[(pr * 16 + f) * 2], s = P.ROPE[(pr * 16 + f) * 2 + 1], x1 = x[f], x2 = x[16 + f]; x[f] = x1 * c - x2 * s; x[16 + f] = x2 * c + x1 * s; }
            { const float c = P.ROPE[(pc * 16 + f) * 2], s = P.ROPE[(pc * 16 + f) * 2 + 1], x1 = x[32 + f], x2 = x[48 + f]; x[32 + f] = x1 * c - x2 * s; x[48 + f] = x2 * c + x1 * s; } } }
#pragma unroll
    for (int e = 0; e < 64; ++e) p[e] = f2bf(x[e]);
}
HD void attn_sweep(const float (&q)[64], const bf16_t* Z, size_t row0, int nkeys, int kcol, int vcol, float& m, float& lsum, float (&acc)[64]) {
    for (int j = 0; j < nkeys; ++j) {
        const bf16_t* kp = Z + (row0 + j) * DIN + kcol; const bf16_t* vp = Z + (row0 + j) * DIN + vcol;
        float s = 0.f;
#pragma unroll
        for (int e = 0; e < 64; ++e) s += q[e] * bf2f(kp[e]);
        if (s > m) { const float sc = expf(m - s); lsum *= sc;
#pragma unroll
            for (int e = 0; e < 64; ++e) acc[e] *= sc;
            m = s; }
        const float p = expf(s - m); lsum += p;
#pragma unroll
        for (int e = 0; e < 64; ++e) acc[e] += p * bf2f(vp[e]);
    }
}
template <int WHICH  >
HD void st_attn(const Params& P, int l, i64 i) {
    const int nro = nrows_out(l); const int head = (int)(i / nro), row = (int)(i % nro), kv = head >> 1;
    const int qcol = (WHICH == 0 ? Z_CQ : Z_DQ) + head * 64, kcol = (WHICH == 0 ? Z_CK : Z_DK) + kv * 64, vcol = (WHICH == 0 ? Z_CV : Z_DV) + kv * 64;
    float q[64], acc[64];
#pragma unroll
    for (int e = 0; e < 64; ++e) { q[e] = bf2f(P.Z[(size_t)row * DIN + qcol + e]) * 0.125f; acc[e] = 0.f; }
    float m, lsum;
    if (WHICH == 0) { m = P.c_sink[l * 4 + head]; lsum = 1.0f; } else { m = -INFINITY; lsum = 0.f; }
    const int seg = row_seg(row), b = seg & 1;
    attn_sweep(q, P.Z, (size_t)seg_base(2 + b), LC, kcol, vcol, m, lsum, acc);
    if (row < NLAT) { const int t = row - b * L; int lo = 0, hi = L - 1;
        if (WHICH == 0) { lo = t - WINDOW < 0 ? 0 : t - WINDOW; hi = t + WINDOW > L - 1 ? L - 1 : t + WINDOW; }
        attn_sweep(q, P.Z, (size_t)b * L + lo, hi - lo + 1, kcol, vcol, m, lsum, acc); }
    const float inv = 1.0f / lsum;
    bf16_t* o = P.YM + (size_t)row * D + (WHICH == 0 ? 512 : 768) + head * 64;
#pragma unroll
    for (int e = 0; e < 64; ++e) o[e] = f2bf(acc[e] * inv);
}
HD void st_outproj(const Params& P, int l, i64 i) {
    const int n = (int)(i & (D - 1)), row = (int)(i >> 10);
    const bf16_t* y = P.YM + (size_t)row * D; const float* w = P.w_out + (size_t)l * D * D + n;
    float s = 0.f; for (int k = 0; k < D; ++k) s += bf2f(y[k]) * w[(size_t)k * D];
    xcur_row(P, row)[n] = xsrc_row(P, l, row)[n] + modv(P, l, row_who(row), 2)[n] * s;
}
HD void st_norm2(const Params& P, int l, i64 row_) {
    const int row = (int)row_; const float* x = xcur_row(P, row);
    float ss = 0.f; for (int d = 0; d < D; ++d) ss += x[d] * x[d];
    const float rstd = 1.0f / sqrtf(ss * (1.0f / D) + EPS);
    const int who = row_who(row);
    const float *sh = modv(P, l, who, 3), *sc = modv(P, l, who, 4), *w = P.norm2_w + l * D, *rw = P.router_w + (size_t)l * D * NE;
    float lg[16];
#pragma unroll
    for (int e = 0; e < 16; ++e) lg[e] = 0.f;
    bf16_t* h = P.H + (size_t)row * D;
    for (int d = 0; d < D; ++d) { const float hv = x[d] * rstd * w[d] * (1.0f + sc[d]) + sh[d]; h[d] = f2bf(hv);
#pragma unroll
        for (int e = 0; e < 16; ++e) lg[e] += hv * rw[d * NE + e]; }
    float mx = lg[0];
#pragma unroll
    for (int e = 1; e < 16; ++e) mx = fmaxf(mx, lg[e]);
    float sum = 0.f;
#pragma unroll
    for (int e = 0; e < 16; ++e) { lg[e] = expf(lg[e] - mx); sum += lg[e]; }
    const int seg = row_seg(row), t = row - seg_base(seg);
#pragma unroll
    for (int e = 0; e < 16; ++e) P.AFF[((size_t)seg * NE + e) * L + t] = lg[e] / sum;
}
HD unsigned f2key(float f) { union { unsigned u; float f; } c; c.f = f; return c.u; }
HD void st_topk(const Params& P, int l, i64 i) {
    const int e = (int)(i & 15), seg = (int)(i >> 4), N = seg_len(seg), cap = 2 * N / NE;
    const float* a = P.AFF + ((size_t)seg * NE + e) * L;
    unsigned lo = 0u, hi = 0x7f800001u;
    while (hi - lo > 1u) { const unsigned mid = lo + ((hi - lo) >> 1); int cnt = 0; for (int t = 0; t < N; ++t) cnt += f2key(a[t]) >= mid ? 1 : 0; if (cnt >= cap) lo = mid; else hi = mid; }
    int gt = 0; for (int t = 0; t < N; ++t) gt += f2key(a[t]) > lo ? 1 : 0;
    int ties = cap - gt, slot = (seg < 2 ? seg * CAP_L : 2 * CAP_L + (seg - 2) * CAP_C);
    const int base = seg_base(seg);
    for (int t = 0; t < N; ++t) { const unsigned k = f2key(a[t]); bool sel = k > lo; if (k == lo && ties > 0) { sel = true; --ties; }
        if (sel) { P.ROWLIST[e * SLOTS_PAD + slot] = base + t; P.GATE[e * SLOTS_PAD + slot] = a[t]; P.INV[(size_t)(base + t) * NE + e] = slot; ++slot; }
        else P.INV[(size_t)(base + t) * NE + e] = -1; }
}
HD int nslots(int l) { return l == 0 ? SLOTS_ALL : SLOTS_L; }
HD void st_moe1(const Params& P, int l, i64 i) {
    const int f = (int)(i & 1023); const i64 es = i >> 10; const int ns = nslots(l), slot = (int)(es % ns), e = (int)(es / ns);
    const int row = P.ROWLIST[e * SLOTS_PAD + slot];
    const bf16_t* h = P.H + (size_t)row * D;
    const float* w1 = P.exp_w1 + ((size_t)(l * NE + e) * D) * 1024 + f; const float* w3 = P.exp_w3 + ((size_t)(l * NE + e) * D) * 1024 + f;
    float a1 = 0.f, a3 = 0.f;
    for (int d = 0; d < D; ++d) { const float hv = bf2f(h[d]); a1 += hv * w1[(size_t)d * 1024]; a3 += hv * w3[(size_t)d * 1024]; }
    P.HID[((size_t)e * SLOTS_PAD + slot) * 1024 + f] = f2bf(siluf_(a1) * a3);
}
HD void st_moe2(const Params& P, int l, i64 i) {
    const int d = (int)(i & 1023); const i64 es = i >> 10; const int ns = nslots(l), slot = (int)(es % ns), e = (int)(es / ns);
    const bf16_t* hid = P.HID + ((size_t)e * SLOTS_PAD + slot) * 1024;
    const float* w2 = P.exp_w2 + ((size_t)(l * NE + e) * 1024) * D + d;
    float s = 0.f; for (int f = 0; f < 1024; ++f) s += bf2f(hid[f]) * w2[(size_t)f * D];
    P.Y[((size_t)e * SLOTS_PAD + slot) * D + d] = f2bf(s);
}
HD void st_moe_comb(const Params& P, int l, i64 i) {
    const int d = (int)(i & (D - 1)), row = (int)(i >> 10);
    float acc = 0.f;
    for (int e = 0; e < NE; ++e) { const int s = P.INV[(size_t)row * NE + e]; if (s >= 0) acc += P.GATE[e * SLOTS_PAD + s] * bf2f(P.Y[((size_t)e * SLOTS_PAD + s) * D + d]); }
    xcur_row(P, row)[d] += modv(P, l, row_who(row), 5)[d] * acc;
}
HD void st_final(const Params& P, i64 row) {
    float* x = P.out + (size_t)row * D;
    float ss = 0.f; for (int d = 0; d < D; ++d) ss += x[d] * x[d];
    const float rstd = 1.0f / sqrtf(ss * (1.0f / D) + EPS);
    for (int d = 0; d < D; ++d) x[d] = x[d] * rstd * P.final_norm_w[d];
}

template <class E> HD void pipeline(const Params& P, E& ex) {
    ex.run((i64)2 * 3 * 6 * D, [&](i64 i) { st_mod(P, i); });
    ex.run(256, [&](i64 i) { st_lb(P, i); });
    ex.run(256 * 16, [&](i64 i) { st_rope(P, i); });
    ex.sync();
    for (int l = 0; l < 2; ++l) {
        const int nro = nrows_out(l);
        ex.run(NR, [&](i64 i) { st_norm1(P, l, i); }); ex.sync();
        ex.run((i64)NR * DIN, [&](i64 i) { st_inproj(P, l, i); }); ex.sync();
        ex.run((i64)NR * 256, [&](i64 i) { st_xa(P, l, i); });
        ex.run((i64)NR * 12, [&](i64 i) { st_qkv_prep(P, l, i); }); ex.sync();
        ex.run((i64)2 * NR * 256, [&](i64 i) { st_a_coef(P, l, i); }); ex.sync();
        ex.run(2 * 2 * 256, [&](i64 i) { st_a_scan(P, l, i); });
        ex.run((i64)4 * nro, [&](i64 i) { st_attn<0>(P, l, i); });
        ex.run((i64)4 * nro, [&](i64 i) { st_attn<1>(P, l, i); }); ex.sync();
        ex.run((i64)nro * 256, [&](i64 i) { st_a_out(P, l, i); }); ex.sync();
        ex.run((i64)NR * 256, [&](i64 i) { st_b_pre(P, l, i); }); ex.sync();
        ex.run(2 * 2 * 4 * 64, [&](i64 i) { st_b_scan(P, l, i); }); ex.sync();
        ex.run((i64)nro * 4, [&](i64 i) { st_b_out(P, l, i); }); ex.sync();
        ex.run((i64)nro * D, [&](i64 i) { st_outproj(P, l, i); }); ex.sync();
        ex.run(nro, [&](i64 i) { st_norm2(P, l, i); }); ex.sync();
        ex.run((l == 0 ? 4 : 2) * 16, [&](i64 i) { st_topk(P, l, i); }); ex.sync();
        ex.run((i64)NE * nslots(l) * 1024, [&](i64 i) { st_moe1(P, l, i); }); ex.sync();
        ex.run((i64)NE * nslots(l) * 1024, [&](i64 i) { st_moe2(P, l, i); }); ex.sync();
        ex.run((i64)nro * D, [&](i64 i) { st_moe_comb(P, l, i); }); ex.sync();
    }
    ex.run(NLAT, [&](i64 i) { st_final(P, i); });
}

#ifndef CPU_TEST
#define XB_TMO      128
#define XB_XCNT(j)  (256  + 64 * (j))
#define XB_XSUB(j)  (1280 + 64 * (j))
#define XB_XGEN(j)  (2304 + 64 * (j))
#define XB_TOP      3328
#define XB_TOPGEN   3392
#define XCD_BAR_WORDS 3456
#define XB_SPIN_CAP (1u << 27)
#define LAS __attribute__((address_space(3)))

__device__ __forceinline__ unsigned xb_ld(unsigned* p)              { return __hip_atomic_load(p, __ATOMIC_RELAXED, __HIP_MEMORY_SCOPE_AGENT); }
__device__ __forceinline__ unsigned xb_add(unsigned* p, unsigned v) { return __hip_atomic_fetch_add(p, v, __ATOMIC_RELAXED, __HIP_MEMORY_SCOPE_AGENT); }
__device__ __forceinline__ unsigned xb_xcc_id() { return (unsigned)__builtin_amdgcn_s_getreg((3 << 11) | 20) & 0xFu; }
#define XB_SPIN(cond, bar) do { unsigned _sp = 0; while (cond) { __builtin_amdgcn_s_sleep(1); \
    if ((++_sp & 255u) == 0u) { if (xb_ld(&(bar)[XB_TMO])) break; if (_sp > XB_SPIN_CAP) { atomicAdd(&(bar)[XB_TMO], 1u); break; } } } } while (0)

struct XcdBarrier { unsigned* bar; unsigned x; volatile LAS unsigned* st; };

__device__ __forceinline__ XcdBarrier xcd_barrier_post(unsigned* bar, volatile LAS unsigned* st) {
    XcdBarrier b; b.bar = bar; b.x = xb_xcc_id(); b.st = st;
    if (threadIdx.x == 0) (void)xb_add(&bar[XB_XCNT(b.x)], 1u);
    return b;
}
__device__ __forceinline__ void xcd_barrier_complete(unsigned* bar, unsigned x, unsigned& nloc, unsigned& nx) {
    const unsigned G = gridDim.x * gridDim.y * gridDim.z;
    unsigned sum, cnt, mine, sp = 0u;
    for (;;) {
        sum = 0u; cnt = 0u; mine = 0u;
#pragma unroll
        for (unsigned j = 0; j < 16; ++j) { const unsigned c = xb_ld(&bar[XB_XCNT(j)]); sum += c; cnt += (c > 0u) ? 1u : 0u; mine = (j == x) ? c : mine; }
        if (sum == G) break;
        __builtin_amdgcn_s_sleep(1);
        if ((++sp & 255u) == 0u) { if (xb_ld(&bar[XB_TMO])) break; if (sp > XB_SPIN_CAP) { atomicAdd(&bar[XB_TMO], 1u); break; } }
    }
    nloc = mine > 0u ? mine : 1u; nx = cnt > 0u ? cnt : 1u;
}
__device__ __forceinline__ void xcd_barrier(const XcdBarrier& b) {
    asm volatile("s_waitcnt vmcnt(0)" ::: "memory");
    __syncthreads();
    if (threadIdx.x == 0) {
        unsigned* bar = b.bar;
        __builtin_amdgcn_s_waitcnt(0);
        unsigned nloc = b.st[0], nx = b.st[1];
        if (nloc == 0u) { xcd_barrier_complete(bar, b.x, nloc, nx); b.st[0] = nloc; b.st[1] = nx; }
        const unsigned old = xb_add(&bar[XB_XSUB(b.x)], 1u);
        const unsigned gen = old / nloc;
        if (old + 1u == (gen + 1u) * nloc) {
            __builtin_amdgcn_fence(__ATOMIC_RELEASE, "agent");
            asm volatile("s_waitcnt vmcnt(0)" ::: "memory");
            const unsigned og = xb_add(&bar[XB_TOP], 1u);
            const unsigned tg = og / nx;
            if (og + 1u == (tg + 1u) * nx) xb_add(&bar[XB_TOPGEN], 1u);
            else XB_SPIN(xb_ld(&bar[XB_TOPGEN]) == tg, bar);
            __builtin_amdgcn_fence(__ATOMIC_ACQUIRE, "agent");
            xb_add(&bar[XB_XGEN(b.x)], 1u);
            asm volatile("s_waitcnt vmcnt(0)" ::: "memory");
        } else {
            XB_SPIN(xb_ld(&bar[XB_XGEN(b.x)]) == gen, bar);
            __builtin_amdgcn_fence(__ATOMIC_ACQUIRE, "agent");
            asm volatile("s_waitcnt vmcnt(0)" ::: "memory");
        }
    }
    __syncthreads();
}

struct GpuExec {
    XcdBarrier bar; i64 gtid, gsz;
    template <class F> __device__ __forceinline__ void run(i64 n, F f) { for (i64 i = gtid; i < n; i += gsz) f(i); }
    __device__ __forceinline__ void sync() { xcd_barrier(bar); }
};

__global__ void __launch_bounds__(512, 2) mega_fwd(Params P) {
    __shared__ uint4 xb_words;
    if (threadIdx.x == 0) xb_words = make_uint4(0u, 0u, 0u, 0u);
    __syncthreads();
    GpuExec ex;
    ex.bar = xcd_barrier_post(P.bar, (volatile LAS unsigned*)&xb_words);
    ex.gtid = (i64)blockIdx.x * blockDim.x + threadIdx.x; ex.gsz = (i64)gridDim.x * blockDim.x;
    pipeline(P, ex);
}

extern "C" void kernel_launch(void* const* d_in, const int* in_sizes, int n_in, void* d_out, int out_size, void* d_ws, size_t ws_size, hipStream_t stream) {
    Params P{};
    const float** f = (const float**)&P;
    for (int i = 0; i < 27; ++i) f[i] = (const float*)d_in[i];
    P.out = (float*)d_out;
    const size_t need = carve(P, (char*)d_ws);
    if (need > ws_size) fprintf(stderr, "workspace too small: need %zu have %zu\n", need, ws_size);
    static int grid = 0;
    if (!grid) {
        int dev = 0, cus = 0, per_cu = 0;
        hipGetDevice(&dev);
        hipDeviceGetAttribute(&cus, hipDeviceAttributeMultiprocessorCount, dev);
        hipOccupancyMaxActiveBlocksPerMultiprocessor(&per_cu, mega_fwd, 512, 0);
        grid = cus * (per_cu < 1 ? per_cu : 1);
        if (grid <= 0) grid = 256;
    }
    hipMemsetAsync(P.bar, 0, XCD_BAR_WORDS * sizeof(unsigned), stream);
    hipLaunchKernelGGL(mega_fwd, dim3(grid), dim3(512), 0, stream, P);
}
#endif
```

```cpp
#ifndef CPU_TEST
#include <hip/hip_runtime.h>
#include <hip/hip_bf16.h>
#include <cstdio>
#include <cstdint>
#define HD __device__ __forceinline__
#else
#include <cmath>
#include <cstdio>
#include <cstdint>
#include <cstring>
#define HD inline
#endif

#ifndef CFG_SEQ
#define CFG_SEQ 16384
#endif
#ifndef CFG_CTX
#define CFG_CTX 256
#endif

typedef unsigned short bf16_t;
typedef long long i64;

constexpr int NB = 2, L = CFG_SEQ, LC = CFG_CTX, D = 1024, DIN = 2816;
constexpr int NLAT = NB * L, NCTX = NB * LC, NR = NLAT + NCTX;
constexpr int NE = 16, CAP_L = 2 * L / NE, CAP_C = 2 * LC / NE;
constexpr int SLOTS_L = NB * CAP_L, SLOTS_ALL = NB * CAP_L + NB * CAP_C, SLOTS_PAD = ((SLOTS_ALL + 255) / 256) * 256;
constexpr int WINDOW = 128;
constexpr int TOT = LC + L, NCH = 128, CL = TOT / NCH;
static_assert(TOT % NCH == 0, "chunking");
static_assert(NCH % 8 == 0, "scan2 batches");
constexpr float EPS = 1e-6f;
constexpr float QC2 = 0.125f * 1.4426950408889634f;
constexpr int Z_AX = 0, Z_AY = 256, Z_BQ = 512, Z_BFF = 768, Z_BFB = 1024, Z_BI = 1280, Z_BG = 1536,
              Z_CQ = 1792, Z_CK = 2048, Z_CV = 2176, Z_DQ = 2304, Z_DK = 2560, Z_DV = 2688;

struct Params {
    const float *x, *c, *ctx, *c_ctx, *mod_w, *mod_b, *norm1_w, *w_in, *a_conv_w, *a_conv_b, *a_gate_a_w, *a_gate_a_b,
                *a_gate_x_w, *a_gate_x_b, *a_lambda, *b_lb_logits, *b_onorm_w, *c_sink, *d_qnorm_w, *d_knorm_w, *w_out,
                *norm2_w, *router_w, *exp_w1, *exp_w3, *exp_w2, *final_norm_w;
    float* out;
    unsigned* bar;
    float *MOD, *LB, *ROPE, *XC, *AFF, *GATE, *SP8;
    int *ROWLIST, *INV, *FLAGS;
    bf16_t *H, *Z, *YM, *HID, *Y, *XS;
    bf16_t *WINT, *WOUTT, *W13T, *W2T;
    bf16_t *RWT;
    bf16_t *XAB, *WG;
    bf16_t *CA, *CU;
    float *BQ, *BF; bf16_t *HB;
    float *CRA, *CRH, *SST, *PST;
    bf16_t* XB;
};

struct Carver { char* base; size_t off; void* take(size_t bytes) { void* p = base + off; off += (bytes + 255) & ~(size_t)255; return p; } };
inline size_t carve(Params& P, char* ws) {
    Carver c{ws, 0};
    P.bar = (unsigned*)c.take(16384);
    P.MOD = (float*)c.take(sizeof(float) * 2 * 3 * 6 * D);
    P.LB = (float*)c.take(sizeof(float) * 2 * 256);
    P.SP8 = (float*)c.take(sizeof(float) * 2 * 2 * 256);
    P.ROPE = (float*)c.take(sizeof(float) * 256 * 16 * 2);
    P.XC = (float*)c.take(sizeof(float) * (size_t)NCTX * D);
    P.AFF = (float*)c.take(sizeof(float) * (size_t)4 * NE * L);
    P.GATE = (float*)c.take(sizeof(float) * (size_t)NE * SLOTS_PAD);
    P.ROWLIST = (int*)c.take(sizeof(int) * (size_t)NE * SLOTS_PAD);
    P.INV = (int*)c.take(sizeof(int) * (size_t)NR * NE);
    P.FLAGS = (int*)c.take(256);
    P.WINT = (bf16_t*)c.take(2 * (size_t)DIN * D);
    P.WOUTT = (bf16_t*)c.take(2 * (size_t)D * D);
    P.W13T = (bf16_t*)c.take(2 * (size_t)NE * 2048 * D);
    P.W2T = (bf16_t*)c.take(2 * (size_t)NE * D * 1024);
    P.WG = (bf16_t*)c.take(2 * (size_t)1024 * 256);
    P.RWT = (bf16_t*)c.take(2 * (size_t)256 * D);
    P.H = (bf16_t*)c.take(2 * (size_t)NR * D);
    P.YM = P.H;
    const size_t zbytes = 2 * (size_t)NR * DIN, hidbytes = 2 * (size_t)NE * SLOTS_PAD * D;
    char* zreg = (char*)c.take(zbytes > hidbytes ? zbytes : hidbytes);
    P.Z = (bf16_t*)zreg; P.HID = (bf16_t*)zreg;
    const size_t f256 = sizeof(float) * (size_t)NR * 256, h256 = f256 / 2;
    const size_t crbytes = sizeof(float) * 4 * NCH * 256, sstbytes = sizeof(float) * (size_t)16 * NCH * 4096, pstbytes = sizeof(float) * 16 * NCH * 64;
    size_t tbytes = 5 * h256 + 2 * h256 + 2 * crbytes + sstbytes + pstbytes; if (tbytes < hidbytes) tbytes = hidbytes;
    char* treg = (char*)c.take(tbytes);
    P.XAB = (bf16_t*)treg; P.CA = (bf16_t*)(treg + h256); P.CU = (bf16_t*)(treg + 3 * h256); P.HB = (bf16_t*)(treg + 5 * h256);
    { char* q = treg + 5 * h256 + 2 * h256; P.CRA = (float*)q; P.CRH = (float*)(q + crbytes); P.SST = (float*)(q + 2 * crbytes); P.PST = (float*)(q + 2 * crbytes + sstbytes); }
#ifdef CPU_TEST
    P.BQ = (float*)c.take(f256); P.BF = (float*)c.take(2 * f256);
#else
    P.BQ = nullptr; P.BF = nullptr;
#endif
    P.XS = (bf16_t*)treg; P.Y = (bf16_t*)treg;
    P.XB = (bf16_t*)c.take(2 * (size_t)NR * D);
    return c.off;
}

struct alignas(16) U4 { unsigned x, y, z, w; };
struct alignas(16) F4 { float x, y, z, w; };
HD F4 ldnt4(const float* p) {
#if defined(__HIP_DEVICE_COMPILE__)
    typedef float v4f_ __attribute__((ext_vector_type(4))); const v4f_ v = __builtin_nontemporal_load((const v4f_*)p); return F4{v.x, v.y, v.z, v.w};
#else
    return *(const F4*)p;
#endif
}
HD float bf_lo(unsigned u) { union { unsigned u; float f; } c; c.u = u << 16; return c.f; }
HD float bf_hi(unsigned u) { union { unsigned u; float f; } c; c.u = u & 0xffff0000u; return c.f; }
HD unsigned pk2(float lo, float hi);
HD void ld8(const bf16_t* p, float (&v)[8]) { const U4 u = *(const U4*)p; v[0] = bf_lo(u.x); v[1] = bf_hi(u.x); v[2] = bf_lo(u.y); v[3] = bf_hi(u.y); v[4] = bf_lo(u.z); v[5] = bf_hi(u.z); v[6] = bf_lo(u.w); v[7] = bf_hi(u.w); }
HD void ld8f(const float* p, float (&v)[8]) { const F4 a = *(const F4*)p, b = *(const F4*)(p + 4); v[0] = a.x; v[1] = a.y; v[2] = a.z; v[3] = a.w; v[4] = b.x; v[5] = b.y; v[6] = b.z; v[7] = b.w; }
HD void st8f(float* p, const float (&v)[8]) { *(F4*)p = F4{v[0], v[1], v[2], v[3]}; *(F4*)(p + 4) = F4{v[4], v[5], v[6], v[7]}; }
HD float bf2f(bf16_t v) { union { unsigned u; float f; } c; c.u = ((unsigned)v) << 16; return c.f; }
HD bf16_t f2bf(float f) { union { unsigned u; float f; } c; c.f = f; unsigned u = c.u; u += 0x7FFFu + ((u >> 16) & 1u); return (bf16_t)(u >> 16); }
HD unsigned pk2(float lo, float hi) { return (unsigned)f2bf(lo) | ((unsigned)f2bf(hi) << 16); }
HD void st8(bf16_t* p, const float (&v)[8]) { *(U4*)p = U4{pk2(v[0], v[1]), pk2(v[2], v[3]), pk2(v[4], v[5]), pk2(v[6], v[7])}; }
HD float sigmoidf_(float x) { return 1.0f / (1.0f + expf(-x)); }
HD float siluf_(float x) { return x * sigmoidf_(x); }
HD float gelu_tanh_(float x) { return 0.5f * x * (1.0f + tanhf(0.7978845608028654f * (x + 0.044715f * x * x * x))); }

HD int row_who(int row) { return row < NLAT ? row / L : 2; }
HD int row_seg(int row) { return row < NLAT ? row / L : 2 + (row - NLAT) / LC; }
HD int seg_base(int seg) { return seg < 2 ? seg * L : NLAT + (seg - 2) * LC; }
HD int seg_len(int seg) { return seg < 2 ? L : LC; }
HD const float* modv(const Params& P, int l, int who, int part) { return P.MOD + ((size_t)(l * 3 + who) * 6 + part) * D; }
HD const float* xsrc_row(const Params& P, int l, int row) {
    if (row < NLAT) return (l == 0 ? P.x : P.out) + (size_t)row * D;
    return (l == 0 ? P.ctx : P.XC) + (size_t)(row - NLAT) * D;
}
HD float* xcur_row(const Params& P, int row) { return row < NLAT ? P.out + (size_t)row * D : P.XC + (size_t)(row - NLAT) * D; }
HD int nrows_out(int l) { return l == 0 ? NR : NLAT; }
HD int nslots(int l) { return l == 0 ? SLOTS_ALL : SLOTS_L; }

HD void st_mod(const Params& P, i64 i) {
    const int n = (int)(i % (6 * D)), who = (int)((i / (6 * D)) % 3), l = (int)(i / (6 * D) / 3);
    const float* cv = who < 2 ? P.c + who * D : P.c_ctx;
    const float* w = P.mod_w + (size_t)l * D * 6 * D + n;
    float s = 0.f;
    for (int k = 0; k < D; ++k) s += siluf_(cv[k]) * w[(size_t)k * 6 * D];
    P.MOD[i] = s + P.mod_b[l * 6 * D + n];
}
HD void st_lb(const Params& P, i64 i) {
    const float a = P.b_lb_logits[i], b = P.b_lb_logits[256 + i], m = fmaxf(a, b);
    const float ea = expf(a - m), eb = expf(b - m), s0 = ea / (ea + eb), s1 = eb / (ea + eb);
    P.LB[i] = s0 - s0; P.LB[256 + i] = (s0 + s1) - s0;
}
HD void st_flags(const Params& P, i64 l) {
    float mq = 0.f, mk = 0.f; for (int e = 0; e < 64; ++e) { mq = fmaxf(mq, fabsf(P.d_qnorm_w[l * 64 + e])); mk = fmaxf(mk, fabsf(P.d_knorm_w[l * 64 + e])); }
    P.FLAGS[l] = (8.0f * 1.4426950408889634f * mq * mk <= 60.0f) ? 1 : 0;
}
HD void st_sp8(const Params& P, i64 i) {
    P.SP8[i] = -8.0f * log1pf(expf(-P.a_lambda[i]));
}
HD void st_rope(const Params& P, i64 i) {
    const int f = (int)(i & 15), pos = (int)(i >> 4);
    const float inv = (float)exp(-(double)f / 16.0 * 9.210340371976184);
    const float ang = (float)pos * inv;
    double y = (double)ang;
    const double twopi = 6.283185307179586476925;
    y -= twopi * floor(y / twopi + 0.5);
    double s = 0.0, cc = 0.0, term = 1.0;
    for (int n = 0; n < 30; ++n) { if (n & 1) s += ((n >> 1) & 1) ? -term : term; else cc += ((n >> 1) & 1) ? -term : term; term *= y / (double)(n + 1); }
    P.ROPE[i * 2] = (float)cc; P.ROPE[i * 2 + 1] = (float)s;
}

template <class RowFn> HD void cvt_tile(const float* src, size_t ld, int N, size_t K, i64 i, bf16_t* dst, RowFn dst_row) {
    const int li = (int)(i & 63); const i64 w = i >> 6; const int nq = li & 15, kq = li >> 4, ntl = N / 64, nt = (int)(w % ntl), kt = (int)(w / ntl);
    const int n0 = nt * 64 + nq * 4, k0 = kt * 64 + kq * 16;
    float v[16][4];
#pragma unroll
    for (int r = 0; r < 16; ++r) { const F4 t = ldnt4(src + (size_t)(k0 + r) * ld + n0); v[r][0] = t.x; v[r][1] = t.y; v[r][2] = t.z; v[r][3] = t.w; }
#pragma unroll
    for (int j = 0; j < 4; ++j) { bf16_t* d = dst + (size_t)dst_row(n0 + j) * K + k0; float a[8], b[8];
#pragma unroll
        for (int r = 0; r < 8; ++r) { a[r] = v[r][j]; b[r] = v[8 + r][j]; }
        st8(d, a); st8(d + 8, b); }
}
HD void st_cvt_win(const Params& P, int l, i64 i) {
    cvt_tile(P.w_in + (size_t)l * D * DIN, DIN, DIN, D, i, P.WINT, [](int n) { return n; });
}
HD void st_cvt_wout(const Params& P, int l, i64 i) {
    cvt_tile(P.w_out + (size_t)l * D * D, D, D, D, i, P.WOUTT, [](int n) { return n; });
}
HD void st_cvt_w13(const Params& P, int l, i64 i) {
    const int which = (int)((i >> 14) & 1), e = (int)(i >> 15);
    const float* src = (which ? P.exp_w3 : P.exp_w1) + (size_t)(l * NE + e) * D * 1024;
    cvt_tile(src, 1024, 1024, D, i & 16383, P.W13T + (size_t)e * 2048 * D, [which](int f) { return (f >> 7) * 256 + which * 128 + (f & 127); });
}
HD void st_cvt_w2(const Params& P, int l, i64 i) {
    const int e = (int)(i >> 14);
    cvt_tile(P.exp_w2 + (size_t)(l * NE + e) * 1024 * D, D, D, 1024, i & 16383, P.W2T + (size_t)e * D * 1024, [](int n) { return n; });
}

HD void st_norm1(const Params& P, int l, i64 row) {
    const float* x = xsrc_row(P, l, (int)row);
    float ss = 0.f; for (int d = 0; d < D; ++d) ss += x[d] * x[d];
    const float rstd = 1.0f / sqrtf(ss * (1.0f / D) + EPS);
    const int who = row_who((int)row);
    const float *sh = modv(P, l, who, 0), *sc = modv(P, l, who, 1), *w = P.norm1_w + l * D;
    bf16_t* h = P.H + (size_t)row * D;
    for (int d = 0; d < D; ++d) h[d] = f2bf(x[d] * rstd * w[d] * (1.0f + sc[d]) + sh[d]);
}
HD void st_inproj(const Params& P, int l, i64 i) {
    const int n = (int)(i % DIN); const i64 row = i / DIN;
    const bf16_t* h = P.H + (size_t)row * D; const bf16_t* w = P.WINT + (size_t)n * D;
    float s = 0.f; for (int k = 0; k < D; ++k) s += bf2f(h[k]) * bf2f(w[k]);
    P.Z[i] = f2bf(s);
}
HD void st_cvt_wg(const Params& P, int l, i64 i) {
    const int kb = (int)(i & 31), n = (int)(i >> 5), pn = n >> 8, r = n & 255, g = r >> 7, ch = (pn & 1) * 128 + (r & 127), dir = pn >> 1, blk = ch >> 6, j = ch & 63;
    const float* w = (g ? P.a_gate_x_w : P.a_gate_a_w) + ((size_t)((l * 2 + dir) * 4 + blk) * 64) * 64 + j;
    bf16_t* dst = P.WG + (size_t)n * 256 + kb * 8;
    for (int q = 0; q < 8; ++q) { const int k = kb * 8 + q; dst[q] = (k >> 6) == blk ? f2bf(w[(size_t)(k & 63) * 64]) : (bf16_t)0; }
}
HD void st_xa(const Params& P, int l, i64 i) {
    const int c8 = (int)(i & 31) * 8, row = (int)(i >> 5), seg = row_seg(row), t = row - seg_base(seg), len = seg_len(seg);
    float s[8]; ld8f(P.a_conv_b + l * 256 + c8, s);
    for (int j = 0; j < 4; ++j) { const int tt = t + j - 2; if (tt >= 0 && tt < len) { float w[8], x[8]; ld8f(P.a_conv_w + (l * 4 + j) * 256 + c8, w); ld8(P.Z + (size_t)(row + j - 2) * DIN + Z_AX + c8, x);
#pragma unroll
        for (int q = 0; q < 8; ++q) s[q] += w[q] * x[q]; } }
    st8(P.XAB + (size_t)row * 256 + c8, s);
}
HD void a_coef_elem(const Params& P, int l, int dir, float pa, float px, float xa, int ch, float& oma, float& u) {
    const float r = sigmoidf_(pa + P.a_gate_a_b[(l * 2 + dir) * 256 + ch]), ig = sigmoidf_(px + P.a_gate_x_b[(l * 2 + dir) * 256 + ch]);
    const float log_a = -8.0f * r * log1pf(expf(-P.a_lambda[(l * 2 + dir) * 256 + ch]));
    oma = -expm1f(log_a); u = sqrtf(-expm1f(2.0f * log_a)) * (ig * xa);
}
HD void st_a_coef(const Params& P, int l, i64 i) {
    const int ch = (int)(i & 255); const i64 rr = i >> 8; const int row = (int)(rr % NR), dir = (int)(rr / NR);
    const bf16_t* xa = P.XAB + (size_t)row * 256;
    const bf16_t* wa = P.WG + (size_t)((dir * 2 + (ch >> 7)) * 256 + (ch & 127)) * 256; const bf16_t* wx = wa + (size_t)128 * 256;
    float pa = 0.f, px = 0.f;
    for (int k = 0; k < 256; ++k) { const float x = bf2f(xa[k]); pa += x * bf2f(wa[k]); px += x * bf2f(wx[k]); }
    float oma, u; a_coef_elem(P, l, dir, pa, px, bf2f(xa[ch]), ch, oma, u); P.CA[i] = f2bf(oma); P.CU[i] = f2bf(u);
}
HD int scan_row(int b, int dir, int s) {
    if (s < LC) return NLAT + b * LC + (dir ? LC - 1 - s : s);
    const int t = s - LC; return b * L + (dir ? L - 1 - t : t);
}
constexpr int SB = (CL % 10 == 0) ? 10 : ((CL % 6 == 0) ? 6 : 1);
HD void st_a_scan1(const Params& P, int l, i64 i) {
    const int ch = (int)(i & 255), c = (int)((i >> 8) % NCH), bd = (int)((i >> 8) / NCH), dir = bd & 1, b = bd >> 1;
    float h = 0.f, A = 1.f;
    for (int s0 = c * CL; s0 < (c + 1) * CL; s0 += SB) { float av[SB], uv[SB];
#pragma unroll
        for (int q = 0; q < SB; ++q) { const size_t idx = ((size_t)dir * NR + scan_row(b, dir, s0 + q)) * 256 + ch; av[q] = 1.0f - bf2f(P.CA[idx]); uv[q] = bf2f(P.CU[idx]); }
#pragma unroll
        for (int q = 0; q < SB; ++q) { h = av[q] * h + uv[q]; A *= av[q]; } }
    P.CRA[i] = A; P.CRH[i] = h;
}
HD void st_a_scan2(const Params& P, int l, i64 i) {
    const int ch = (int)(i & 255), bd = (int)(i >> 8);
    float carry = 0.f;
    for (int c0 = 0; c0 < NCH; c0 += 8) { float Av[8], hv[8];
#pragma unroll
        for (int q = 0; q < 8; ++q) { const size_t k = ((size_t)bd * NCH + c0 + q) * 256 + ch; Av[q] = P.CRA[k]; hv[q] = P.CRH[k]; }
#pragma unroll
        for (int q = 0; q < 8; ++q) { const size_t k = ((size_t)bd * NCH + c0 + q) * 256 + ch; P.CRH[k] = carry; carry = Av[q] * carry + hv[q]; } }
}
HD void st_a_scan3(const Params& P, int l, i64 i) {
    const int ch = (int)(i & 255), c = (int)((i >> 8) % NCH), bd = (int)((i >> 8) / NCH), dir = bd & 1, b = bd >> 1;
    float h = 0.f;
    for (int c0 = 0; c0 < c; c0 += 8) { float Av[8], hv[8];
#pragma unroll
        for (int q = 0; q < 8; ++q) { const int cc = c0 + q < c ? c0 + q : c - 1; const size_t k = ((size_t)bd * NCH + cc) * 256 + ch; Av[q] = P.CRA[k]; hv[q] = P.CRH[k]; }
#pragma unroll
        for (int q = 0; q < 8; ++q) if (c0 + q < c) h = Av[q] * h + hv[q]; }
    for (int s0 = c * CL; s0 < (c + 1) * CL; s0 += SB) { float av[SB], uv[SB]; size_t ix[SB];
#pragma unroll
        for (int q = 0; q < SB; ++q) { ix[q] = ((size_t)dir * NR + scan_row(b, dir, s0 + q)) * 256 + ch; av[q] = 1.0f - bf2f(P.CA[ix[q]]); uv[q] = bf2f(P.CU[ix[q]]); }
#pragma unroll
        for (int q = 0; q < SB; ++q) { h = av[q] * h + uv[q]; P.CU[ix[q]] = f2bf(h); } }
}
HD void st_a_out(const Params& P, int l, i64 i) {
    const int c8 = (int)(i & 31) * 8; const size_t row = (size_t)(i >> 5);
    float h0[8], h1[8], ay[8], y[8]; ld8(P.CU + row * 256 + c8, h0); ld8(P.CU + ((size_t)NR + row) * 256 + c8, h1); ld8(P.Z + row * DIN + Z_AY + c8, ay);
#pragma unroll
    for (int q = 0; q < 8; ++q) y[q] = (h0[q] + h1[q]) * gelu_tanh_(ay[q]);
    st8(P.YM + row * D + c8, y);
}
HD void st_b_pre(const Params& P, int l, i64 i) {
    const int c8 = (int)(i & 31) * 8; const size_t row = (size_t)(i >> 5);
    float lb[8], q[8], z[8], o[8]; ld8f(P.LB + l * 256 + c8, lb); ld8(P.Z + row * DIN + Z_BQ + c8, q);
#pragma unroll
    for (int k = 0; k < 8; ++k) o[k] = siluf_(q[k]) * 0.125f;
    st8f(P.BQ + row * 256 + c8, o);
    for (int dir = 0; dir < 2; ++dir) { ld8(P.Z + row * DIN + Z_BFF + dir * 256 + c8, z);
#pragma unroll
        for (int k = 0; k < 8; ++k) o[k] = lb[k] + (1.0f - lb[k]) * sigmoidf_(z[k]);
        st8f(P.BF + ((size_t)dir * NR + row) * 256 + c8, o); }
}
HD void st_b_scan1(const Params& P, int l, i64 i) {
    const int v = (int)(i & 63); const i64 u = i >> 6; const int c = (int)(u % NCH), bdh = (int)(u / NCH), head = bdh & 3, dir = (bdh >> 2) & 1, b = bdh >> 3;
    float S[64];
#pragma unroll
    for (int k = 0; k < 64; ++k) S[k] = 0.f;
    float pr = 1.f;
    for (int s = c * CL; s < (c + 1) * CL; ++s) { const size_t row = (size_t)scan_row(b, dir, s);
        const float* f = P.BF + ((size_t)dir * NR + row) * 256 + head * 64; const float vv = bf2f(P.Z[row * DIN + Z_BI + head * 64 + v]);
        pr *= f[v];
#pragma unroll
        for (int k = 0; k < 64; ++k) S[k] = f[k] * (S[k] - vv) + vv; }
    float* sst = P.SST + (size_t)u * 4096;
#pragma unroll
    for (int k = 0; k < 64; ++k) sst[k * 64 + v] = S[k];
    P.PST[u * 64 + v] = pr;
}
template <int NCH_> HD void st_b_scan2(const Params& P, int l, i64 i) {
    constexpr int NCH = NCH_; static_assert(NCH_ % 8 == 0, "scan2 batches");
    const int kv = (int)(i & 4095), bdh = (int)(i >> 12), k = kv >> 6;
    float carry = 0.f;
    float locA[8], ppA[8], locB[8], ppB[8];
#define B2LD(LOC, PP, C0) do { _Pragma("unroll") for (int q = 0; q < 8; ++q) { const int cc = (C0) + q < NCH ? (C0) + q : NCH - 1; const size_t u = (size_t)bdh * NCH + cc; LOC[q] = P.SST[u * 4096 + kv]; PP[q] = P.PST[u * 64 + k]; } } while (0)
#define B2ST(LOC, PP, C0) do { _Pragma("unroll") for (int q = 0; q < 8; ++q) { const size_t u = (size_t)bdh * NCH + (C0) + q; P.SST[u * 4096 + kv] = carry; carry = PP[q] * carry + LOC[q]; } } while (0)
    B2LD(locA, ppA, 0);
    for (int c0 = 0; c0 < NCH; c0 += 16) {
        B2LD(locB, ppB, c0 + 8);
        B2ST(locA, ppA, c0);
        if (c0 + 8 < NCH) { B2LD(locA, ppA, c0 + 16); B2ST(locB, ppB, c0 + 8); }
    }
#undef B2LD
#undef B2ST
}
HD void st_b_scan3(const Params& P, int l, i64 i) {
    const int v = (int)(i & 63); const i64 u = i >> 6; const int c = (int)(u % NCH), bdh = (int)(u / NCH), head = bdh & 3, dir = (bdh >> 2) & 1, b = bdh >> 3;
    float S[64]; const float* sst = P.SST + (size_t)u * 4096;
#pragma unroll
    for (int k = 0; k < 64; ++k) S[k] = sst[k * 64 + v];
    for (int s = c * CL; s < (c + 1) * CL; ++s) { const size_t row = (size_t)scan_row(b, dir, s);
        const float* f = P.BF + ((size_t)dir * NR + row) * 256 + head * 64; const float* q = P.BQ + row * 256 + head * 64;
        const float vv = bf2f(P.Z[row * DIN + Z_BI + head * 64 + v]); float o = 0.f;
#pragma unroll
        for (int k = 0; k < 64; ++k) { S[k] = f[k] * (S[k] - vv) + vv; o += q[k] * S[k]; }
        P.HB[((size_t)dir * NR + row) * 256 + head * 64 + v] = f2bf(o); }
}
HD void st_b_out(const Params& P, int l, i64 i) {
    const int head = (int)(i & 3); const size_t row = (size_t)(i >> 2);
    const bf16_t* o0 = P.HB + row * 256 + head * 64; const bf16_t* o1 = P.HB + ((size_t)NR + row) * 256 + head * 64;
    float o[64]; float ss = 0.f;
#pragma unroll
    for (int g = 0; g < 8; ++g) { float a[8], b[8]; ld8(o0 + g * 8, a); ld8(o1 + g * 8, b);
#pragma unroll
        for (int q = 0; q < 8; ++q) { o[g * 8 + q] = a[q] + b[q]; ss += o[g * 8 + q] * o[g * 8 + q]; } }
    const float rstd = 1.0f / sqrtf(ss * (1.0f / 64.0f) + EPS);
#pragma unroll
    for (int g = 0; g < 8; ++g) { float w[8], gt[8], y[8]; ld8f(P.b_onorm_w + l * 64 + g * 8, w); ld8(P.Z + row * DIN + Z_BG + head * 64 + g * 8, gt);
#pragma unroll
        for (int q = 0; q < 8; ++q) y[q] = o[g * 8 + q] * rstd * w[q] * siluf_(gt[q]);
        st8(P.YM + row * D + 256 + head * 64 + g * 8, y); }
}
HD void st_qkv_prep_rh(const Params& P, int l, int row, int hs) {
    const bool lat = row < NLAT;
    int col; const float* nw = nullptr;
    if (hs < 4) col = Z_CQ + hs * 64; else if (hs < 6) col = Z_CK + (hs - 4) * 64;
    else if (hs < 10) { col = Z_DQ + (hs - 6) * 64; nw = P.d_qnorm_w + l * 64; } else { col = Z_DK + (hs - 10) * 64; nw = P.d_knorm_w + l * 64; }
    if (!lat && !nw && hs >= 4) return;
    bf16_t* p = P.Z + (size_t)row * DIN + col;
    float x[64];
#pragma unroll
    for (int g = 0; g < 8; ++g) { float t8[8]; ld8(p + g * 8, t8);
#pragma unroll
        for (int q = 0; q < 8; ++q) x[g * 8 + q] = t8[q]; }
    if (nw) { float ss = 0.f;
#pragma unroll
        for (int e = 0; e < 64; ++e) ss += x[e] * x[e];
        const float rstd = 1.0f / sqrtf(ss * (1.0f / 64.0f) + EPS);
#pragma unroll
        for (int e = 0; e < 64; ++e) x[e] = x[e] * rstd * nw[e]; }
    if (lat) { const int t = row % L, pr = t / 64, pc = t % 64;
#pragma unroll
        for (int f = 0; f < 16; ++f) {
            { const float c = P.ROPE[(pr * 16 + f) * 2], s = P.ROPE[(pr * 16 + f) * 2 + 1], x1 = x[f], x2 = x[16 + f]; x[f] = x1 * c - x2 * s; x[16 + f] = x2 * c + x1 * s; }
            { const float c = P.ROPE[(pc * 16 + f) * 2], s = P.ROPE[(pc * 16 + f) * 2 + 1], x1 = x[32 + f], x2 = x[48 + f]; x[32 + f] = x1 * c - x2 * s; x[48 + f] = x2 * c + x1 * s; } } }
    const float osc = (hs < 4 || (hs >= 6 && hs < 10)) ? QC2 : 1.0f;
#pragma unroll
    for (int g = 0; g < 8; ++g) { float t8[8];
#pragma unroll
        for (int q = 0; q < 8; ++q) t8[q] = x[g * 8 + q] * osc;
        st8(p + g * 8, t8); }
}
HD void st_qkv_prep(const Params& P, int l, i64 i) { st_qkv_prep_rh(P, l, (int)(i / 12), (int)(i % 12)); }
HD void st_qkv_prep_k(const Params& P, int l, i64 i) { const int kk = (int)(i & 3); st_qkv_prep_rh(P, l, (int)(i >> 2), kk < 2 ? 4 + kk : 8 + kk); }
template <bool LOG2> HD void attn_sweep(const float (&q)[64], const bf16_t* Z, size_t row0, int nkeys, int kcol, int vcol, float& m, float& lsum, float (&acc)[64]) {
    for (int j = 0; j < nkeys; ++j) {
        const U4* kp = (const U4*)(Z + (row0 + j) * DIN + kcol); const U4* vp = (const U4*)(Z + (row0 + j) * DIN + vcol);
        float s = 0.f;
#pragma unroll
        for (int e = 0; e < 8; ++e) { const U4 k4 = kp[e];
            s += q[8 * e] * bf_lo(k4.x) + q[8 * e + 1] * bf_hi(k4.x) + q[8 * e + 2] * bf_lo(k4.y) + q[8 * e + 3] * bf_hi(k4.y) + q[8 * e + 4] * bf_lo(k4.z) + q[8 * e + 5] * bf_hi(k4.z) + q[8 * e + 6] * bf_lo(k4.w) + q[8 * e + 7] * bf_hi(k4.w); }
        if (s > m) { const float sc = LOG2 ? exp2f(m - s) : expf(m - s); lsum *= sc;
#pragma unroll
            for (int e = 0; e < 64; ++e) acc[e] *= sc;
            m = s; }
        const float p = LOG2 ? exp2f(s - m) : expf(s - m); lsum += p;
#pragma unroll
        for (int e = 0; e < 8; ++e) { const U4 v4 = vp[e];
            acc[8 * e] += p * bf_lo(v4.x); acc[8 * e + 1] += p * bf_hi(v4.x); acc[8 * e + 2] += p * bf_lo(v4.y); acc[8 * e + 3] += p * bf_hi(v4.y);
            acc[8 * e + 4] += p * bf_lo(v4.z); acc[8 * e + 5] += p * bf_hi(v4.z); acc[8 * e + 6] += p * bf_lo(v4.w); acc[8 * e + 7] += p * bf_hi(v4.w); }
    }
}
template <int WHICH  >
HD void st_attn(const Params& P, int l, int head, int row) {
    const int kv = head >> 1;
    const int qcol = (WHICH == 0 ? Z_CQ : Z_DQ) + head * 64, kcol = (WHICH == 0 ? Z_CK : Z_DK) + kv * 64, vcol = (WHICH == 0 ? Z_CV : Z_DV) + kv * 64;
    float q[64], acc[64];
#pragma unroll
    for (int e = 0; e < 64; ++e) { q[e] = bf2f(P.Z[(size_t)row * DIN + qcol + e]); acc[e] = 0.f; }
    float m, lsum;
    if (WHICH == 0) { m = P.c_sink[l * 4 + head] * 1.4426950408889634f; lsum = 1.0f; } else { m = -INFINITY; lsum = 0.f; }
    const int seg = row_seg(row), b = seg & 1;
    attn_sweep<true>(q, P.Z, (size_t)seg_base(2 + b), LC, kcol, vcol, m, lsum, acc);
    if (row < NLAT) { const int t = row - b * L; int lo = 0, hi = L - 1;
        if (WHICH == 0) { lo = t - WINDOW < 0 ? 0 : t - WINDOW; hi = t + WINDOW > L - 1 ? L - 1 : t + WINDOW; }
        attn_sweep<true>(q, P.Z, (size_t)b * L + lo, hi - lo + 1, kcol, vcol, m, lsum, acc); }
    const float inv = 1.0f / lsum;
    bf16_t* o = P.YM + (size_t)row * D + (WHICH == 0 ? 512 : 768) + head * 64;
#pragma unroll
    for (int e = 0; e < 64; ++e) o[e] = f2bf(acc[e] * inv);
}
HD void st_outproj(const Params& P, int l, i64 i) {
    const int n = (int)(i & (D - 1)), row = (int)(i >> 10);
    const bf16_t* y = P.YM + (size_t)row * D; const bf16_t* w = P.WOUTT + (size_t)n * D;
    float s = 0.f; for (int k = 0; k < D; ++k) s += bf2f(y[k]) * bf2f(w[k]);
    xcur_row(P, row)[n] = xsrc_row(P, l, row)[n] + modv(P, l, row_who(row), 2)[n] * s;
}
HD void st_norm2(const Params& P, int l, i64 row_) {
    const int row = (int)row_; const float* x = xcur_row(P, row);
    float ss = 0.f; for (int d = 0; d < D; ++d) ss += x[d] * x[d];
    const float rstd = 1.0f / sqrtf(ss * (1.0f / D) + EPS);
    const int who = row_who(row);
    const float *sh = modv(P, l, who, 3), *sc = modv(P, l, who, 4), *w = P.norm2_w + l * D;
    bf16_t* h = P.H + (size_t)row * D;
    for (int d = 0; d < D; ++d) h[d] = f2bf(x[d] * rstd * w[d] * (1.0f + sc[d]) + sh[d]);
}
HD void st_cvt_rw(const Params& P, int l, i64 i) {
    const int kb = (int)(i & 127), n = (int)(i >> 7);
    bf16_t* dst = P.RWT + (size_t)n * D + kb * 8;
    for (int q = 0; q < 8; ++q) dst[q] = n < NE ? f2bf(P.router_w[((size_t)l * D + kb * 8 + q) * NE + n]) : (bf16_t)0;
}
HD void st_router(const Params& P, int l, i64 row_) {
    const int row = (int)row_; const bf16_t* h = P.H + (size_t)row * D;
    float lg[16];
#pragma unroll
    for (int e = 0; e < 16; ++e) { float a = 0.f; const bf16_t* w = P.RWT + (size_t)e * D; for (int d = 0; d < D; ++d) a += bf2f(h[d]) * bf2f(w[d]); lg[e] = a; }
    float mx = lg[0];
#pragma unroll
    for (int e = 1; e < 16; ++e) mx = fmaxf(mx, lg[e]);
    float sum = 0.f;
#pragma unroll
    for (int e = 0; e < 16; ++e) { lg[e] = expf(lg[e] - mx); sum += lg[e]; }
    const int seg = row_seg(row), t = row - seg_base(seg);
#pragma unroll
    for (int e = 0; e < 16; ++e) P.AFF[((size_t)seg * NE + e) * L + t] = lg[e] / sum;
}
HD unsigned f2key(float f) { union { unsigned u; float f; } c; c.f = f; return c.u; }
HD void st_topk(const Params& P, int l, i64 i) {
    const int e = (int)(i & 15), seg = (int)(i >> 4), N = seg_len(seg), cap = 2 * N / NE;
    const float* a = P.AFF + ((size_t)seg * NE + e) * L;
    unsigned lo = 0u, hi = 0x7f800001u;
    while (hi - lo > 1u) { const unsigned mid = lo + ((hi - lo) >> 1); int cnt = 0; for (int t = 0; t < N; ++t) cnt += f2key(a[t]) >= mid ? 1 : 0; if (cnt >= cap) lo = mid; else hi = mid; }
    int gt = 0; for (int t = 0; t < N; ++t) gt += f2key(a[t]) > lo ? 1 : 0;
    int ties = cap - gt, slot = (seg < 2 ? seg * CAP_L : 2 * CAP_L + (seg - 2) * CAP_C);
    const int base = seg_base(seg);
    for (int t = 0; t < N; ++t) { const unsigned k = f2key(a[t]); bool sel = k > lo; if (k == lo && ties > 0) { sel = true; --ties; }
        if (sel) { P.ROWLIST[e * SLOTS_PAD + slot] = base + t; P.GATE[e * SLOTS_PAD + slot] = a[t]; P.INV[(size_t)e * NR + base + t] = slot; ++slot; }
        else P.INV[(size_t)e * NR + base + t] = -1; }
}
HD void st_gather(const Params& P, int l, i64 i) {
    const int c = (int)(i & 127); const i64 es = i >> 7; const int ns = nslots(l), slot = (int)(es % ns), e = (int)(es / ns);
    const int row = P.ROWLIST[e * SLOTS_PAD + slot];
    const bf16_t* src = P.H + (size_t)row * D + c * 8; bf16_t* dst = P.XS + ((size_t)e * SLOTS_PAD + slot) * D + c * 8;
    *(U4*)dst = *(const U4*)src;
}
HD void st_moe1(const Params& P, int l, i64 i) {
    const int f = (int)(i & 1023); const i64 es = i >> 10; const int ns = nslots(l), slot = (int)(es % ns), e = (int)(es / ns);
    const bf16_t* h = P.H + (size_t)P.ROWLIST[e * SLOTS_PAD + slot] * D;
    const bf16_t* w1 = P.W13T + ((size_t)e * 2048 + (f >> 7) * 256 + (f & 127)) * D; const bf16_t* w3 = w1 + (size_t)128 * D;
    float a1 = 0.f, a3 = 0.f;
    for (int d = 0; d < D; ++d) { const float hv = bf2f(h[d]); a1 += hv * bf2f(w1[d]); a3 += hv * bf2f(w3[d]); }
    P.HID[((size_t)e * SLOTS_PAD + slot) * 1024 + f] = f2bf(siluf_(a1) * a3);
}
HD void st_moe2(const Params& P, int l, i64 i) {
    const int d = (int)(i & 1023); const i64 es = i >> 10; const int ns = nslots(l), slot = (int)(es % ns), e = (int)(es / ns);
    const bf16_t* hid = P.HID + ((size_t)e * SLOTS_PAD + slot) * 1024;
    const bf16_t* w2 = P.W2T + ((size_t)e * D + d) * 1024;
    float s = 0.f; for (int f = 0; f < 1024; ++f) s += bf2f(hid[f]) * bf2f(w2[f]);
    P.Y[((size_t)e * SLOTS_PAD + slot) * D + d] = f2bf(s);
}
HD void st_moe_comb(const Params& P, int l, i64 i) {
    const int d8 = (int)(i & 127) * 8, row = (int)(i >> 7);
    float acc[8];
#pragma unroll
    for (int q = 0; q < 8; ++q) acc[q] = 0.f;
    for (int e = 0; e < NE; ++e) { const int s = P.INV[(size_t)e * NR + row]; if (s >= 0) { const float g = P.GATE[e * SLOTS_PAD + s]; float y[8]; ld8(P.Y + ((size_t)e * SLOTS_PAD + s) * D + d8, y);
#pragma unroll
        for (int q = 0; q < 8; ++q) acc[q] += g * y[q]; } }
    float x[8], m[8]; float* xp = xcur_row(P, row) + d8; ld8f(xp, x); ld8f(modv(P, l, row_who(row), 5) + d8, m);
#pragma unroll
    for (int q = 0; q < 8; ++q) x[q] += m[q] * acc[q];
    st8f(xp, x);
}
HD void st_final(const Params& P, i64 row) {
    float* x = P.out + (size_t)row * D;
    float ss = 0.f; for (int d = 0; d < D; ++d) ss += x[d] * x[d];
    const float rstd = 1.0f / sqrtf(ss * (1.0f / D) + EPS);
    for (int d = 0; d < D; ++d) x[d] = x[d] * rstd * P.final_norm_w[d];
}

template <int LYR, class E> HD void layer_body(E& ex) {
    constexpr int l = LYR;
        const int nro = nrows_out(l);
        ex.run((i64)(D / 16) * (DIN / 4), [&](const Params& P, i64 i) { st_cvt_win(P, l, i); });
        ex.run((i64)(D / 16) * (D / 4), [&](const Params& P, i64 i) { st_cvt_wout(P, l, i); });
        ex.run((i64)1024 * 32, [&](const Params& P, i64 i) { st_cvt_wg(P, l, i); });
        ex.run((i64)256 * 128, [&](const Params& P, i64 i) { st_cvt_rw(P, l, i); });
        if (l == 0) ex.sync();
        ex.norm1(l); ex.sync();
        constexpr i64 n13 = (i64)NE * 2 * 16384, n2 = (i64)NE * 16384, NTC = n13 + n2, A1 = 162816, A2 = (l == 0) ? 380928 : 0;
        auto cvt_any = [&](const Params& P, i64 i) { if (i < n13) st_cvt_w13(P, l, i); else st_cvt_w2(P, l, i - n13); };
        ex.inproj(l); ex.run_from(150, A1, [&](const Params& P, i64 i) { cvt_any(P, i); }); ex.sync();
        ex.run((i64)NR * 32, [&](const Params& P, i64 i) { st_xa(P, l, i); });
        ex.qkv_prep(l);
        ex.b_pre(l); ex.sync();
        ex.a_coef(l); ex.b_scan(l, 1); ex.sync();
        if (l == 0) ex.run_skipctx((i64)2 * 2 * NCH * 256, [&](const Params& P, i64 i) { st_a_scan1(P, l, i); });
        else ex.run((i64)2 * 2 * NCH * 256, [&](const Params& P, i64 i) { st_a_scan1(P, l, i); });
        ex.b_scan(l, 2);
        ex.attn_win(l); ex.attn_dense(l); ex.sync();
        ex.run((i64)2 * 2 * NCH * 256, [&](const Params& P, i64 i) { st_a_scan3(P, l, i); });
        ex.b_scan(l, 3); ex.sync();
        ex.run((i64)nro * 32, [&](const Params& P, i64 i) { st_a_out(P, l, i); });
        ex.run((i64)nro * 4, [&](const Params& P, i64 i) { st_b_out(P, l, i); }); ex.sync();
        ex.outproj(l); if (l == 0) ex.run_from(8, A2, [&](const Params& P, i64 i) { cvt_any(P, A1 + i); }); ex.sync();
        ex.norm2(l);
        ex.run((i64)NE * SLOTS_PAD, [&](const Params& P, i64 i) { P.ROWLIST[i] = 0; }); ex.sync();
        constexpr i64 AR = 129024;
        ex.router(l); ex.run_from(130, AR, [&](const Params& P, i64 i) { cvt_any(P, A1 + A2 + i); }); ex.sync();
        ex.topk(l);
        { constexpr i64 B0 = A1 + A2 + AR, rest = NTC - B0, cap = ((NTC * 21 / 100) & ~(i64)63), A3 = rest < cap ? rest : cap; const int b0 = (l == 0 ? 4 : 2) * 16;
          ex.run_from(b0, A3, [&](const Params& P, i64 i) { cvt_any(P, B0 + i); });
          ex.run(rest - A3, [&](const Params& P, i64 i) { cvt_any(P, B0 + A3 + i); }); }
        ex.sync();
        ex.moe1(l); ex.sync();
        ex.moe2(l); ex.sync();
        ex.comb(l); ex.sync_soft();
}
template <class E> HD void pipeline(E& ex) {
    {
    ex.mod();
    ex.run(256, [&](const Params& P, i64 i) { st_lb(P, i); });
    ex.run(2, [&](const Params& P, i64 i) { st_flags(P, i); });
    ex.run(2 * 2 * 256, [&](const Params& P, i64 i) { st_sp8(P, i); });
    ex.run(256 * 16, [&](const Params& P, i64 i) { st_rope(P, i); });
    }
    layer_body<0>(ex);
    layer_body<1>(ex);
    ex.final_norm();
}
template <class E> HD void naive_inproj(int l, E& ex) { ex.run((i64)NR * DIN, [&](const Params& P, i64 i) { st_inproj(P, l, i); }); }
template <class E> HD void naive_outproj(int l, E& ex) { ex.run((i64)nrows_out(l) * D, [&](const Params& P, i64 i) { st_outproj(P, l, i); }); }
template <class E> HD void naive_moe1(int l, E& ex) { ex.run((i64)NE * nslots(l) * 1024, [&](const Params& P, i64 i) { st_moe1(P, l, i); }); }
template <class E> HD void naive_attn_win(int l, E& ex, int row0, int nrows) { ex.run((i64)4 * nrows, [&](const Params& P, i64 i) { st_attn<0>(P, l, (int)(i / nrows), row0 + (int)(i % nrows)); }); }
template <class E> HD void naive_attn_dense(int l, E& ex, int row0, int nrows) { ex.run((i64)4 * nrows, [&](const Params& P, i64 i) { st_attn<1>(P, l, (int)(i / nrows), row0 + (int)(i % nrows)); }); }
template <class E> HD void naive_qkv_prep(int l, E& ex) { ex.run((i64)NR * 12, [&](const Params& P, i64 i) { st_qkv_prep(P, l, i); }); }
template <class E> HD void naive_b_pre(int l, E& ex) { ex.run((i64)NR * 32, [&](const Params& P, i64 i) { st_b_pre(P, l, i); }); }
template <class E> HD void naive_b_scan(int l, int ph, E& ex) { if (ph == 2) ex.run((i64)2 * 2 * 4 * 4096, [&](const Params& P, i64 i) { st_b_scan2<NCH>(P, l, i); }); else if (ph == 1) ex.run((i64)2 * 2 * 4 * NCH * 64, [&](const Params& P, i64 i) { st_b_scan1(P, l, i); }); else ex.run((i64)2 * 2 * 4 * NCH * 64, [&](const Params& P, i64 i) { st_b_scan3(P, l, i); }); }
template <class E> HD void naive_a_coef(int l, E& ex) { ex.run((i64)2 * NR * 256, [&](const Params& P, i64 i) { st_a_coef(P, l, i); }); }
template <class E> HD void naive_comb(int l, E& ex) { ex.run((i64)nrows_out(l) * 128, [&](const Params& P, i64 i) { st_moe_comb(P, l, i); }); }
template <class E> HD void naive_mod(E& ex) { ex.run((i64)2 * 3 * 6 * D, [&](const Params& P, i64 i) { st_mod(P, i); }); }
template <class E> HD void naive_norm1(int l, E& ex) { ex.run(NR, [&](const Params& P, i64 i) { st_norm1(P, l, i); }); }
template <class E> HD void naive_norm2(int l, E& ex) { ex.run(nrows_out(l), [&](const Params& P, i64 i) { st_norm2(P, l, i); }); }
template <class E> HD void naive_router(int l, E& ex) { ex.run(nrows_out(l), [&](const Params& P, i64 i) { st_router(P, l, i); }); }
template <class E> HD void naive_topk(int l, E& ex) { ex.run((l == 0 ? 4 : 2) * 16, [&](const Params& P, i64 i) { st_topk(P, l, i); }); }
template <class E> HD void naive_final(E& ex) { ex.run(NLAT, [&](const Params& P, i64 i) { st_final(P, i); }); }
template <class E> HD void naive_moe2(int l, E& ex) { ex.run((i64)NE * nslots(l) * 1024, [&](const Params& P, i64 i) { st_moe2(P, l, i); }); }

#ifndef CPU_TEST
__device__ __forceinline__ int lane_id() { int l; asm volatile("v_mbcnt_lo_u32_b32 %0, -1, 0\n\tv_mbcnt_hi_u32_b32 %0, -1, %0" : "=v"(l)); return l; }
__device__ __forceinline__ int grid_dim() { int g = (int)gridDim.x; asm volatile("" : "+s"(g)); return g; }
__device__ __forceinline__ int block_id() { int b = (int)blockIdx.x; asm volatile("" : "+s"(b)); return b; }
#define XB_TMO      128
#define XB_XCNT(j)  (256  + 64 * (j))
#define XB_XSUB(j)  (1280 + 64 * (j))
#define XB_XGEN(j)  (2304 + 64 * (j))
#define XB_TOP      3328
#define XB_TOPGEN   3392
#define XCD_BAR_WORDS 3456
#define XB_SPIN_CAP (1u << 27)
#define LAS __attribute__((address_space(3)))

__device__ __forceinline__ unsigned xb_ld(unsigned* p)              { return __hip_atomic_load(p, __ATOMIC_RELAXED, __HIP_MEMORY_SCOPE_AGENT); }
__device__ __forceinline__ unsigned xb_add(unsigned* p, unsigned v) { return __hip_atomic_fetch_add(p, v, __ATOMIC_RELAXED, __HIP_MEMORY_SCOPE_AGENT); }
__device__ __forceinline__ unsigned xb_xcc_id() { return (unsigned)__builtin_amdgcn_s_getreg((3 << 11) | 20) & 0xFu; }
#define XB_SPIN(cond, bar) do { unsigned _sp = 0; while (cond) { __builtin_amdgcn_s_sleep(1); \
    if ((++_sp & 255u) == 0u) { if (xb_ld(&(bar)[XB_TMO])) break; if (_sp > XB_SPIN_CAP) { atomicAdd(&(bar)[XB_TMO], 1u); break; } } } } while (0)

struct XcdBarrier { unsigned* bar; unsigned x; volatile LAS unsigned* st; };

__device__ __forceinline__ XcdBarrier xcd_barrier_post(unsigned* bar, volatile LAS unsigned* st, bool leader) {
    XcdBarrier b; b.bar = bar; b.x = xb_xcc_id(); b.st = st;
    if (leader) (void)xb_add(&bar[XB_XCNT(b.x)], 1u);
    return b;
}
__device__ __forceinline__ void xcd_barrier_complete(unsigned* bar, unsigned x, unsigned& nloc, unsigned& nx) {
    const unsigned G = gridDim.x * gridDim.y * gridDim.z;
    unsigned sum, cnt, mine, sp = 0u;
    for (;;) {
        sum = 0u; cnt = 0u; mine = 0u;
#pragma unroll
        for (unsigned j = 0; j < 16; ++j) { const unsigned c = xb_ld(&bar[XB_XCNT(j)]); sum += c; cnt += (c > 0u) ? 1u : 0u; mine = (j == x) ? c : mine; }
        if (sum == G) break;
        __builtin_amdgcn_s_sleep(1);
        if ((++sp & 255u) == 0u) { if (xb_ld(&bar[XB_TMO])) break; if (sp > XB_SPIN_CAP) { atomicAdd(&bar[XB_TMO], 1u); break; } }
    }
    nloc = mine > 0u ? mine : 1u; nx = cnt > 0u ? cnt : 1u;
}
__device__ __forceinline__ void xcd_barrier(const XcdBarrier& b, bool leader) {
    asm volatile("s_waitcnt vmcnt(0)" ::: "memory");
    __syncthreads();
    if (leader) {
        unsigned* bar = b.bar;
        __builtin_amdgcn_s_waitcnt(0);
        unsigned nloc = b.st[0], nx = b.st[1];
        if (nloc == 0u) { xcd_barrier_complete(bar, b.x, nloc, nx); b.st[0] = nloc; b.st[1] = nx; }
        const unsigned old = xb_add(&bar[XB_XSUB(b.x)], 1u);
        const unsigned gen = old / nloc;
        if (old + 1u == (gen + 1u) * nloc) {
            __builtin_amdgcn_fence(__ATOMIC_RELEASE, "agent");
            asm volatile("s_waitcnt vmcnt(0)" ::: "memory");
            const unsigned og = xb_add(&bar[XB_TOP], 1u);
            const unsigned tg = og / nx;
            if (og + 1u == (tg + 1u) * nx) xb_add(&bar[XB_TOPGEN], 1u);
            else XB_SPIN(xb_ld(&bar[XB_TOPGEN]) == tg, bar);
            __builtin_amdgcn_fence(__ATOMIC_ACQUIRE, "agent");
            xb_add(&bar[XB_XGEN(b.x)], 1u);
            asm volatile("s_waitcnt vmcnt(0)" ::: "memory");
        } else {
            XB_SPIN(xb_ld(&bar[XB_XGEN(b.x)]) == gen, bar);
            __builtin_amdgcn_fence(__ATOMIC_ACQUIRE, "agent");
            asm volatile("s_waitcnt vmcnt(0)" ::: "memory");
        }
    }
    __syncthreads();
}

namespace pg8 {
#define PG8_LAS __attribute__((address_space(3)))
typedef unsigned short bf16_t;
typedef short bf16x8 __attribute__((ext_vector_type(8)));
typedef float f32x4 __attribute__((ext_vector_type(4)));
typedef unsigned u32x4 __attribute__((ext_vector_type(4)));
constexpr int BM = 256, BK = 64, HALF = 128, HTB = HALF * BK * 2  , STAGE_BYTES = 8 * HTB, NXCD = 8, WGM = 8;

__host__ __device__ __forceinline__ int lds_byte(int r, int c) { const int st = (r >> 4) * 2 + (c >> 5), rr = r & 15, cc = c & 31, ob = rr * 64 + cc * 2; return st * 1024 + (ob ^ (((ob >> 9) & 1) << 5)); }
__host__ __device__ __forceinline__ void stage_rc(int b, int& R, int& C) { const int st = b / 1024, sb = b % 1024, swz = sb ^ (((sb >> 9) & 1) << 5); R = (st >> 1) * 16 + swz / 64; C = (st & 1) * 32 + (swz % 64) / 2; }
__host__ __device__ __forceinline__ int perm32(int rho) { const int n = rho >> 4, i = rho & 15; return 8 * (i >> 2) + 4 * n + (i & 3); }

struct Unit { int pm, pn; };
struct Gemm { const bf16_t* A; const bf16_t* Bt; int M, N, K; };

struct StaticOrder {
    int nM, nN, nwg, G, c;
    __host__ __device__ void init(int M, int N, int G_, int c_) { nM = M / BM; nN = N / BM; nwg = nM * nN; G = G_; c = c_; }
    __host__ __device__ bool next(int i, Unit& u) const {
        const long L = (long)i * G + c; if (L >= nwg) return false;
        int wgid = (int)L; { const int q = nwg / NXCD, r = nwg % NXCD, xcd = wgid % NXCD, off = wgid / NXCD; wgid = (xcd < r ? xcd * (q + 1) : r * (q + 1) + (xcd - r) * q) + off; }
        const int nig = WGM * nN, gid = wgid / nig, fm = gid * WGM, gsz = (nM - fm) < WGM ? (nM - fm) : WGM;
        u.pm = fm + ((wgid % nig) % gsz); u.pn = (wgid % nig) / gsz; return true;
    }
    __device__ __forceinline__ void a_ready(const Unit&) const {}
    __device__ __forceinline__ void done(const Unit&) const {}
};
__device__ __forceinline__ unsigned cvt_pk_bf16(float lo, float hi) { unsigned r; asm volatile("v_cvt_pk_bf16_f32 %0, %1, %2" : "=v"(r) : "v"(lo), "v"(hi)); return r; }
typedef float f32x2 __attribute__((ext_vector_type(2)));
template <class Epi, class Sched, bool STAMP = false, bool GATHER = false, bool HALFU = false>
__device__ __forceinline__ void gemm_phase(PG8_LAS unsigned char* lds, const Gemm g, const Sched& S, const Epi& E, unsigned long long* stamps, int wv, const int* rowlist = nullptr) {
    int tid_ = wv * 64 + lane_id(); asm volatile("" : "+v"(tid_));
    const int tid = tid_, wid = __builtin_amdgcn_readfirstlane(tid >> 6), lane = tid & 63, wr = wid >> 2, wc = wid & 3, fr = lane & 15, fq = lane >> 4;
    const int K = g.K, nt = K / BK;
    int ts_lo = 0, ts_hi = 0, nts = 0; const unsigned long long rt_entry = STAMP ? (unsigned long long)wall_clock64() : 0ull;
#define PG8_STAMP() do { if (STAMP && wid == 0 && nts < 64) { const unsigned long long _c = (unsigned long long)clock64(); \
        ts_lo = (lane == nts) ? (int)(unsigned)_c : ts_lo; ts_hi = (lane == nts) ? (int)(unsigned)(_c >> 32) : ts_hi; ++nts; } } while (0)
    PG8_STAMP();
    unsigned voffA[2], voffB[2]; int RA[2]; unsigned CBy[2];
#pragma unroll
    for (int i = 0; i < 2; ++i) { int R, C; stage_rc(tid * 16 + i * 8192, R, C); const int Rb = Epi::PERM ? ((R & ~31) + perm32(R & 31)) : R;
        voffA[i] = (unsigned)(R * K + C) * 2u; voffB[i] = (unsigned)(Rb * K + C) * 2u; RA[i] = R; CBy[i] = (unsigned)C * 2u; }
    unsigned goff[2][2] = {{0u, 0u}, {0u, 0u}}, noff[2][2] = {{0u, 0u}, {0u, 0u}};
#define PG8_LOADOFF(dst, U) do { if (GATHER) { _Pragma("unroll") for (int h_ = 0; h_ < 2; ++h_) _Pragma("unroll") for (int i_ = 0; i_ < 2; ++i_) \
        dst[h_][i_] = (unsigned)rowlist[(U).pm * BM + h_ * HALF + RA[i_]] * (unsigned)(K * 2) + CBy[i_]; } } while (0)
#define PG8_STAGE_A(bufoff, base, h, nx) do { if (GATHER) { const unsigned so_[2] = {(nx) ? noff[h][0] : goff[h][0], (nx) ? noff[h][1] : goff[h][1]}; PG8_STAGE(bufoff, base, so_); } \
        else PG8_STAGE(bufoff, (base) + ((h) ? hstep : 0), voffA); } while (0)
    const size_t kstep = (size_t)(BK * 2);
    const size_t hstep = (size_t)HALF * K * 2;
    const size_t tstep = 2 * hstep;
    const unsigned ldsw = (unsigned)wid * 1024u;
    const int aoff = lds_byte(wr * 64 + fr, fq * 8), boff = lds_byte(wc * 32 + fr, fq * 8);
#define PG8_SA(b, h) (((b) * 2 + (h)) * HTB)
#define PG8_SB(b, h) ((4 + (b) * 2 + (h)) * HTB)
#define PG8_STAGE(bufoff, gbase, voff) do { _Pragma("unroll") for (int _i = 0; _i < 2; ++_i) \
        __builtin_amdgcn_global_load_lds((const unsigned*)((const char*)(gbase) + (voff)[_i]), (PG8_LAS unsigned*)(lds + (bufoff) + ldsw + _i * 8192), 16, 0, 0); } while (0)
#define PG8_LDA(dst, b, h) do { _Pragma("unroll") for (int m = 0; m < 4; ++m) _Pragma("unroll") for (int k = 0; k < 2; ++k) dst[m][k] = *(const PG8_LAS bf16x8*)(lds + PG8_SA(b, h) + aoff + m * 2048 + k * 1024); } while (0)
#define PG8_LDB(dst, b, h) do { _Pragma("unroll") for (int n = 0; n < 2; ++n) _Pragma("unroll") for (int k = 0; k < 2; ++k) dst[n][k] = *(const PG8_LAS bf16x8*)(lds + PG8_SB(b, h) + boff + n * 2048 + k * 1024); } while (0)
#define PG8_MMA(ai, bj, At, Bt) do { __builtin_amdgcn_s_setprio(1); _Pragma("unroll") for (int m = 0; m < 4; ++m) _Pragma("unroll") for (int n = 0; n < 2; ++n) _Pragma("unroll") for (int k = 0; k < 2; ++k) \
        acc[ai][bj][m][n] = __builtin_amdgcn_mfma_f32_16x16x32_bf16(Bt[n][k], At[m][k], acc[ai][bj][m][n], 0, 0, 0); __builtin_amdgcn_s_setprio(0); } while (0)
#define PG8_WAIT_V(n) asm volatile("s_waitcnt vmcnt(" #n ")" ::: "memory")
#define PG8_WAIT_L(n) asm volatile("s_waitcnt lgkmcnt(" #n ")" ::: "memory")
#define PG8_BAR __builtin_amdgcn_s_barrier()
#define PG8_SCHED __builtin_amdgcn_sched_barrier(0)
    Unit cur, nxt; int ui = 0;
    if (!S.next(0, cur)) return;
    f32x4 acc[2][2][4][2];
#pragma unroll
    for (int a = 0; a < 2; ++a)
#pragma unroll
        for (int b = 0; b < 2; ++b)
#pragma unroll
            for (int m = 0; m < 4; ++m)
#pragma unroll
                for (int n = 0; n < 2; ++n) acc[a][b][m][n] = (f32x4){0.f, 0.f, 0.f, 0.f};
    bf16x8 At[4][2], B0[2][2], B1[2][2];
    const char* cA = (const char*)g.A + (GATHER ? (size_t)0 : (size_t)cur.pm * tstep); const char* cB = (const char*)g.Bt + (size_t)cur.pn * tstep;
    PG8_LOADOFF(goff, cur);
    S.a_ready(cur);
    PG8_STAGE(PG8_SB(0, 0), cB, voffB); PG8_STAGE_A(PG8_SA(0, 0), cA, 0, false); PG8_STAGE(PG8_SB(0, 1), cB + hstep, voffB); PG8_STAGE_A(PG8_SA(0, 1), cA, 1, false);
    if (wr == 1) PG8_BAR;
    PG8_WAIT_V(4); PG8_BAR;
    PG8_STAGE(PG8_SB(1, 0), cB + kstep, voffB); PG8_STAGE_A(PG8_SA(1, 0), cA + kstep, 0, false); PG8_STAGE(PG8_SB(1, 1), cB + hstep + kstep, voffB);
    PG8_WAIT_V(6); PG8_BAR;
    PG8_STAMP();
    for (;;) {
        const bool has_next = S.next(ui + 1, nxt);
        bool hu = false; if constexpr (HALFU) hu = S.is_half(cur);
        const char* nA = (has_next && !GATHER) ? (const char*)g.A + (size_t)nxt.pm * tstep : cA; const char* nB = has_next ? (const char*)g.Bt + (size_t)nxt.pn * tstep : cB;
        if (GATHER) { if (has_next) PG8_LOADOFF(noff, nxt); else { noff[0][0] = goff[0][0]; noff[0][1] = goff[0][1]; noff[1][0] = goff[1][0]; noff[1][1] = goff[1][1]; } }
        for (int t = 0; t < nt; t += 2) {
            const bool last = (t == nt - 2);
            const char* a1 = cA + (size_t)(t + 1) * kstep;
            const char* a2 = last ? nA : cA + (size_t)(t + 2) * kstep; const char* b2 = last ? nB : cB + (size_t)(t + 2) * kstep;
            const char* a3 = a2 + kstep; const char* b3 = b2 + kstep;
            if (last && has_next) S.a_ready(nxt);
            PG8_LDB(B0, 0, 0); PG8_SCHED; PG8_LDA(At, 0, 0); PG8_STAGE_A(PG8_SA(1, 1), a1, 1, false);
            PG8_WAIT_L(8); PG8_BAR; PG8_WAIT_L(0); PG8_MMA(0, 0, At, B0); PG8_BAR; PG8_SCHED;
            PG8_LDB(B1, 0, 1); PG8_STAGE(PG8_SB(0, 0), b2, voffB);
            PG8_BAR; PG8_WAIT_L(0); PG8_MMA(0, 1, At, B1); PG8_BAR;
            if (!hu) PG8_LDA(At, 0, 1); PG8_STAGE_A(PG8_SA(0, 0), a2, 0, last);
            PG8_BAR; PG8_WAIT_L(0); if (!hu) PG8_MMA(1, 0, At, B0); PG8_BAR; PG8_SCHED;
            PG8_STAGE(PG8_SB(0, 1), b2 + hstep, voffB);
            PG8_WAIT_V(6); PG8_BAR; if (!hu) PG8_MMA(1, 1, At, B1); PG8_BAR;
            PG8_LDB(B0, 1, 0); PG8_SCHED; PG8_LDA(At, 1, 0); PG8_STAGE_A(PG8_SA(0, 1), a2, 1, last);
            PG8_WAIT_L(8); PG8_BAR; PG8_WAIT_L(0); PG8_MMA(0, 0, At, B0); PG8_BAR; PG8_SCHED;
            PG8_LDB(B1, 1, 1); PG8_STAGE(PG8_SB(1, 0), b3, voffB);
            PG8_BAR; PG8_WAIT_L(0); PG8_MMA(0, 1, At, B1); PG8_BAR;
            if (!hu) PG8_LDA(At, 1, 1); PG8_STAGE_A(PG8_SA(1, 0), a3, 0, last);
            PG8_BAR; PG8_WAIT_L(0); if (!hu) PG8_MMA(1, 0, At, B0); PG8_BAR; PG8_SCHED;
            PG8_STAGE(PG8_SB(1, 1), b3 + hstep, voffB);
            PG8_WAIT_V(6); PG8_BAR; if (!hu) PG8_MMA(1, 1, At, B1); PG8_BAR;
        }
        PG8_STAMP();
        if constexpr (!Epi::AFTER_DRAIN) { E(acc, cur, wr, wc, fr, fq); S.done(cur); }
        PG8_STAMP();
        if (!has_next) break;
#pragma unroll
        for (int a = 0; a < 2; ++a)
#pragma unroll
            for (int b = 0; b < 2; ++b)
#pragma unroll
                for (int m = 0; m < 4; ++m)
#pragma unroll
                    for (int n = 0; n < 2; ++n) acc[a][b][m][n] = (f32x4){0.f, 0.f, 0.f, 0.f};
        cur = nxt; cA = nA; cB = nB; ++ui;
        if (GATHER) { goff[0][0] = noff[0][0]; goff[0][1] = noff[0][1]; goff[1][0] = noff[1][0]; goff[1][1] = noff[1][1]; }
    }
    PG8_WAIT_V(0);
    if (wr == 0) PG8_BAR;
    PG8_BAR;
    if constexpr (Epi::AFTER_DRAIN) { E.fused(acc, cur, wr, wc, fr, fq, lds, wid, lane); S.done(cur); }
    PG8_STAMP();
    if (STAMP && wid == 0) { stamps[lane] = lane < nts ? (((unsigned long long)(unsigned)ts_hi << 32) | (unsigned)ts_lo) : 0ull;
        if (lane == 62) stamps[62] = rt_entry; if (lane == 63) stamps[63] = (unsigned long long)wall_clock64(); }
#undef PG8_STAMP
#undef PG8_SA
#undef PG8_SB
#undef PG8_STAGE
#undef PG8_STAGE_A
#undef PG8_LOADOFF
#undef PG8_LDA
#undef PG8_LDB
#undef PG8_MMA
#undef PG8_WAIT_V
#undef PG8_WAIT_L
#undef PG8_BAR
#undef PG8_SCHED
}
}

namespace pg8 {
constexpr int TPE = SLOTS_PAD / 256;
struct EpiZ {
    static constexpr bool PERM = true, AFTER_DRAIN = false;
    bf16_t* O; int ldc;
    __device__ __forceinline__ void operator()(const f32x4 (&acc)[2][2][4][2], const Unit& u, int wr, int wc, int fr, int fq) const {
        const int row0 = u.pm * BM + wr * 64 + fr, col0 = u.pn * BM + wc * 32 + 8 * fq;
#pragma unroll
        for (int ai = 0; ai < 2; ++ai)
#pragma unroll
            for (int m = 0; m < 4; ++m) { bf16_t* rowp = O + (size_t)(row0 + ai * HALF + m * 16) * ldc + col0;
#pragma unroll
                for (int bj = 0; bj < 2; ++bj) { const f32x4 v0 = acc[ai][bj][m][0], v1 = acc[ai][bj][m][1];
                    u32x4 w; w.x = cvt_pk_bf16(v0[0], v0[1]); w.y = cvt_pk_bf16(v0[2], v0[3]); w.z = cvt_pk_bf16(v1[0], v1[1]); w.w = cvt_pk_bf16(v1[2], v1[3]);
                    *(u32x4*)(rowp + bj * HALF) = w; } }
    }
};
template <bool SRC16> struct EpiOut {
    static constexpr bool PERM = true, AFTER_DRAIN = false;
    const float* src_lat; const float* src_ctx; const bf16_t* srcb; bf16_t* dst; const float* mod;
    __device__ __forceinline__ void operator()(const f32x4 (&acc)[2][2][4][2], const Unit& u, int wr, int wc, int fr, int fq) const {
        const bool lat = u.pm < NLAT / BM; const int who = lat ? u.pm / (L / BM) : 2;
        const int row0 = u.pm * BM + wr * 64 + fr, col0 = u.pn * BM + wc * 32 + 8 * fq;
        const float* mv = mod + (size_t)(who * 6 + 2) * D;
        f32x4 m4[2][2];
#pragma unroll
        for (int bj = 0; bj < 2; ++bj)
#pragma unroll
            for (int n = 0; n < 2; ++n) m4[bj][n] = *(const f32x4*)(mv + col0 + bj * HALF + n * 4);
#pragma unroll
        for (int ai = 0; ai < 2; ++ai)
#pragma unroll
            for (int m = 0; m < 4; ++m) { const size_t grow = (size_t)(row0 + ai * HALF + m * 16);
#pragma unroll
                for (int bj = 0; bj < 2; ++bj) { const int c = col0 + bj * HALF; f32x4 x0, x1;
                    if (SRC16) { const u32x4 w = *(const u32x4*)(srcb + grow * D + c); x0 = (f32x4){bf_lo(w.x), bf_hi(w.x), bf_lo(w.y), bf_hi(w.y)}; x1 = (f32x4){bf_lo(w.z), bf_hi(w.z), bf_lo(w.w), bf_hi(w.w)}; }
                    else { const float* sp = (lat ? src_lat + grow * D : src_ctx + (grow - NLAT) * D) + c; x0 = __builtin_nontemporal_load((const f32x4*)sp); x1 = __builtin_nontemporal_load((const f32x4*)(sp + 4)); }
                    const f32x4 y0 = x0 + m4[bj][0] * acc[ai][bj][m][0], y1 = x1 + m4[bj][1] * acc[ai][bj][m][1];
                    u32x4 o; o.x = cvt_pk_bf16(y0[0], y0[1]); o.y = cvt_pk_bf16(y0[2], y0[3]); o.z = cvt_pk_bf16(y1[0], y1[1]); o.w = cvt_pk_bf16(y1[2], y1[3]);
                    *(u32x4*)(dst + grow * D + c) = o; } }
    }
};
__device__ __forceinline__ float silu_fast(float x) { return x * __builtin_amdgcn_rcpf(1.0f + __expf(-x)); }
struct EpiHid {
    static constexpr bool PERM = true, AFTER_DRAIN = false;
    bf16_t* O;
    __device__ __forceinline__ void operator()(const f32x4 (&acc)[2][2][4][2], const Unit& u, int wr, int wc, int fr, int fq) const {
        const int row0 = u.pm * BM + wr * 64 + fr, col0 = (u.pn & 7) * 128 + wc * 32 + 8 * fq;
#pragma unroll
        for (int ai = 0; ai < 2; ++ai)
#pragma unroll
            for (int m = 0; m < 4; ++m) { float h[8];
#pragma unroll
                for (int n = 0; n < 2; ++n)
#pragma unroll
                    for (int j = 0; j < 4; ++j) h[n * 4 + j] = silu_fast(acc[ai][0][m][n][j]) * acc[ai][1][m][n][j];
                u32x4 w; w.x = cvt_pk_bf16(h[0], h[1]); w.y = cvt_pk_bf16(h[2], h[3]); w.z = cvt_pk_bf16(h[4], h[5]); w.w = cvt_pk_bf16(h[6], h[7]);
                *(u32x4*)(O + (size_t)(row0 + ai * HALF + m * 16) * 1024 + col0) = w; }
    }
};
struct EpiY {
    static constexpr bool PERM = true, AFTER_DRAIN = false;
    bf16_t* O;
    __device__ __forceinline__ void operator()(const f32x4 (&acc)[2][2][4][2], const Unit& u, int wr, int wc, int fr, int fq) const {
        const int row0 = u.pm * BM + wr * 64 + fr, col0 = (u.pn & 3) * BM + wc * 32 + 8 * fq;
#pragma unroll
        for (int ai = 0; ai < 2; ++ai)
#pragma unroll
            for (int m = 0; m < 4; ++m) { bf16_t* rowp = O + (size_t)(row0 + ai * HALF + m * 16) * D + col0;
#pragma unroll
                for (int bj = 0; bj < 2; ++bj) { const f32x4 v0 = acc[ai][bj][m][0], v1 = acc[ai][bj][m][1];
                    u32x4 w; w.x = cvt_pk_bf16(v0[0], v0[1]); w.y = cvt_pk_bf16(v0[2], v0[3]); w.z = cvt_pk_bf16(v1[0], v1[1]); w.w = cvt_pk_bf16(v1[2], v1[3]);
                    *(u32x4*)(rowp + bj * HALF) = w; } }
    }
};
struct EpiCoef {
    static constexpr bool PERM = true, AFTER_DRAIN = false;
    const Params* P; int l;
    __device__ __forceinline__ void operator()(const f32x4 (&acc)[2][2][4][2], const Unit& u, int wr, int wc, int fr_, int fq_) const {
        int fr = fr_, fq = fq_; asm volatile("" : "+v"(fr), "+v"(fq));
        const int dir = u.pn >> 1, ch0 = (u.pn & 1) * 128 + wc * 32 + 8 * fq, row0 = u.pm * BM + wr * 64 + fr;
        const float* gb = P->a_gate_a_b + (l * 2 + dir) * 256 + ch0; const float* gx = P->a_gate_x_b + (l * 2 + dir) * 256 + ch0; const float* gs = P->SP8 + (l * 2 + dir) * 256 + ch0;
        bool small = true;
#pragma unroll
        for (int q = 0; q < 8; ++q) small = small && (gs[q] >= -0.5f);
        const bool poly = __all(small);
#pragma unroll
        for (int ai = 0; ai < 2; ++ai)
#pragma unroll
            for (int m = 0; m < 4; ++m) { const size_t row = (size_t)(row0 + ai * HALF + m * 16);
                const u32x4 xw = *(const u32x4*)(P->XAB + row * 256 + ch0); const unsigned xr[4] = {xw.x, xw.y, xw.z, xw.w};
                float om8[8], u8[8];
#pragma unroll
                for (int n = 0; n < 2; ++n)
#pragma unroll
                    for (int j = 0; j < 4; ++j) { const int q = n * 4 + j; const float xa = (q & 1) ? bf_hi(xr[q >> 1]) : bf_lo(xr[q >> 1]);
                        const float r = __builtin_amdgcn_rcpf(1.0f + __expf(-(acc[ai][0][m][n][j] + gb[q]))), ig = __builtin_amdgcn_rcpf(1.0f + __expf(-(acc[ai][1][m][n][j] + gx[q])));
                        const float y = r * gs[q];
                        float oma = -y * (1.0f + y * (0.5f + y * (0.16666667f + y * (0.041666667f + y * 0.0083333333f))));
                        if (!poly) oma = y > -0.5f ? oma : 1.0f - __expf(y);
                        om8[q] = oma; u8[q] = sqrtf(oma * (2.0f - oma)) * (ig * xa); }
                u32x4 wa, wu; wa.x = cvt_pk_bf16(om8[0], om8[1]); wa.y = cvt_pk_bf16(om8[2], om8[3]); wa.z = cvt_pk_bf16(om8[4], om8[5]); wa.w = cvt_pk_bf16(om8[6], om8[7]);
                wu.x = cvt_pk_bf16(u8[0], u8[1]); wu.y = cvt_pk_bf16(u8[2], u8[3]); wu.z = cvt_pk_bf16(u8[4], u8[5]); wu.w = cvt_pk_bf16(u8[6], u8[7]);
                *(u32x4*)(P->CA + ((size_t)dir * NR + row) * 256 + ch0) = wa; *(u32x4*)(P->CU + ((size_t)dir * NR + row) * 256 + ch0) = wu; }
    }
};
struct EpiRouter {
    static constexpr bool PERM = false, AFTER_DRAIN = false;
    float* AFF;
    __device__ __forceinline__ void operator()(const f32x4 (&acc)[2][2][4][2], const Unit& u, int wr, int wc, int fr_, int fq_) const {
        if (wc != 0) return;
        int fr = fr_, fq = fq_; asm volatile("" : "+v"(fr), "+v"(fq));
        const int lane = fq * 16 + fr;
#pragma unroll
        for (int ai = 0; ai < 2; ++ai)
#pragma unroll
            for (int m = 0; m < 4; ++m) { const f32x4 v = acc[ai][0][m][0];
                float mx = fmaxf(fmaxf(v[0], v[1]), fmaxf(v[2], v[3]));
                mx = fmaxf(mx, __int_as_float(__builtin_amdgcn_ds_bpermute((lane ^ 16) << 2, __float_as_int(mx)))); mx = fmaxf(mx, __int_as_float(__builtin_amdgcn_ds_bpermute((lane ^ 32) << 2, __float_as_int(mx))));
                const float e0 = __expf(v[0] - mx), e1 = __expf(v[1] - mx), e2 = __expf(v[2] - mx), e3 = __expf(v[3] - mx);
                float sm = (e0 + e1) + (e2 + e3);
                sm += __int_as_float(__builtin_amdgcn_ds_bpermute((lane ^ 16) << 2, __float_as_int(sm))); sm += __int_as_float(__builtin_amdgcn_ds_bpermute((lane ^ 32) << 2, __float_as_int(sm)));
                const float inv = 1.0f / sm;
                const int row = u.pm * BM + ai * HALF + wr * 64 + m * 16 + fr, seg = row_seg(row), t = row - seg_base(seg);
                float* o = AFF + ((size_t)seg * NE + 4 * fq) * L + t;
                o[0] = e0 * inv; o[(size_t)L] = e1 * inv; o[(size_t)2 * L] = e2 * inv; o[(size_t)3 * L] = e3 * inv; }
    }
};
struct GroupOrder {
    StaticOrder so; int tf, nNl, nsh, G, c;
    __device__ void init(int nsl, int nNl_, int G_, int c_) { const int tv = (nsl + 255) / 256, rem = nsl & 255; const bool sh = rem != 0 && rem <= 128; tf = sh ? tv - 1 : tv; nNl = nNl_; nsh = sh ? NE * nNl_ : 0; G = G_; c = c_;
        so.init(NE * tf * BM, nNl_ * BM, G_, c_); }
    __device__ bool next(int i, Unit& u) const {
        if (so.next(i, u)) { const int e = u.pm / tf; u.pm = e * TPE + (u.pm - e * tf); u.pn += e * nNl; return true; }
        const long j = (long)i * G + c - so.nwg; if (j >= nsh) return false;
        const int e = (int)j / nNl; u.pm = e * TPE + tf; u.pn = (int)j; return true;
    }
    __device__ __forceinline__ bool is_half(const Unit& u) const { return nsh != 0 && (u.pm % TPE) == tf; }
    __device__ __forceinline__ void a_ready(const Unit&) const {}
    __device__ __forceinline__ void done(const Unit&) const {}
};
}

namespace attn_body {
using bf16=__hip_bfloat16;
using bf16x8=__attribute__((ext_vector_type(8)))short;
using s16x4=__attribute__((ext_vector_type(4)))short;
using f32x16=__attribute__((ext_vector_type(16)))float;
using u32x4=__attribute__((ext_vector_type(4)))unsigned;
constexpr int D=64,ZP=DIN,OP=1024,NTC=LC/64;
constexpr int NW=8,QBLK=32,QB=QBLK*NW,KVBLK=64,NQB=L/QB;
__device__ __forceinline__ int crow(int r,int hi){return (r&3)+8*(r>>2)+4*hi;}
#define SBAR() __builtin_amdgcn_sched_barrier(0)
constexpr int NSLOT=3, SLOTB=8192;
constexpr int LDS_K=0, LDS_V=NSLOT*SLOTB, LDS_WS=2*NSLOT*SLOTB, LDS_OST=LDS_WS+NW*64*4, LDS_BYTES=LDS_OST+NW*4096;
constexpr float C2=0.125f*1.4426950408889634f;
__device__ __forceinline__ void glds16(const void*sbase,unsigned voff,unsigned lds_dst){unsigned keep;
  asm volatile("s_mov_b32 %0, m0\n\ts_mov_b32 m0, %3\n\ts_nop 0\n\tglobal_load_lds_dwordx4 %1, %2\n\ts_mov_b32 m0, %0":"=&s"(keep):"v"(voff),"s"(sbase),"s"(lds_dst):"memory");}
__device__ __forceinline__ float max3f(float a,float b,float c){float r;asm("v_max3_f32 %0, %1, %2, %3":"=v"(r):"v"(a),"v"(b),"v"(c));return r;}
__device__ __forceinline__ float max2f(float a,float b){float r;asm("v_max_f32_e32 %0, %1, %2":"=v"(r):"v"(a),"v"(b));return r;}
__device__ __forceinline__ float fadd_s(float a,float b){float r;asm("v_add_f32_e32 %0, %1, %2":"=v"(r):"v"(a),"v"(b));return r;}
__device__ __forceinline__ float fsub_s(float a,float b){float r;asm("v_sub_f32_e32 %0, %1, %2":"=v"(r):"v"(a),"v"(b));return r;}
typedef float f32x2_t __attribute__((ext_vector_type(2))); typedef __bf16 bf16x2_t __attribute__((ext_vector_type(2)));
__device__ __forceinline__ unsigned cvtpk_s(float lo,float hi){f32x2_t v={lo,hi};bf16x2_t b=__builtin_convertvector(v,bf16x2_t);return __builtin_bit_cast(unsigned,b);}
#define WAIT_BAR(N) asm volatile("s_waitcnt vmcnt(" #N ") lgkmcnt(0)\n\ts_barrier":::"memory")

__device__ __forceinline__ void qkt(f32x16&p0,f32x16&p1,const char*Kslot,const bf16x8*qr,const f32x16&negm,int r32,int hi){
  const char*kb=Kslot+hi*1024+r32*16;
  #pragma unroll
  for(int d0=0;d0<4;++d0){
    const bf16x8 b0=*reinterpret_cast<const bf16x8*>(kb+d0*2048);
    const bf16x8 b1=*reinterpret_cast<const bf16x8*>(kb+d0*2048+512);
    if(d0==0){p0=__builtin_amdgcn_mfma_f32_32x32x16_bf16(b0,qr[0],negm,0,0,0);p1=__builtin_amdgcn_mfma_f32_32x32x16_bf16(b1,qr[0],negm,0,0,0);}
    else{p0=__builtin_amdgcn_mfma_f32_32x32x16_bf16(b0,qr[d0],p0,0,0,0);p1=__builtin_amdgcn_mfma_f32_32x32x16_bf16(b1,qr[d0],p1,0,0,0);}}
}
typedef __attribute__((address_space(3))) const char* lds_cptr;
typedef short v4i16_t __attribute__((ext_vector_type(4)));
__device__ __forceinline__ void kload8(bf16x8*kf,lds_cptr kp){
  kf[0]=*(const __attribute__((address_space(3))) bf16x8*)(kp);      kf[1]=*(const __attribute__((address_space(3))) bf16x8*)(kp+512);
  kf[2]=*(const __attribute__((address_space(3))) bf16x8*)(kp+2048); kf[3]=*(const __attribute__((address_space(3))) bf16x8*)(kp+2560);
  kf[4]=*(const __attribute__((address_space(3))) bf16x8*)(kp+4096); kf[5]=*(const __attribute__((address_space(3))) bf16x8*)(kp+4608);
  kf[6]=*(const __attribute__((address_space(3))) bf16x8*)(kp+6144); kf[7]=*(const __attribute__((address_space(3))) bf16x8*)(kp+6656);
}
__device__ __forceinline__ void kload2(bf16x8*kf,lds_cptr kp,int j){ kf[2*j]=*(const __attribute__((address_space(3))) bf16x8*)(kp+j*2048); kf[2*j+1]=*(const __attribute__((address_space(3))) bf16x8*)(kp+j*2048+512); }
__device__ __forceinline__ s16x4 vtr(lds_cptr p){ return __builtin_bit_cast(s16x4,__builtin_amdgcn_ds_read_tr16_b64_v4i16((__attribute__((address_space(3))) v4i16_t*)p)); }
__device__ __forceinline__ float rowmax(const f32x16&p0,const f32x16&p1){
  float a=max3f(p0[0],p0[1],p1[0]),b=max3f(p0[2],p0[3],p1[1]);a=max3f(a,p1[2],p1[3]);
  #pragma unroll
  for(int r=4;r<16;r+=4){a=max3f(a,p0[r],p0[r+1]);b=max3f(b,p0[r+2],p0[r+3]);a=max3f(a,p1[r],p1[r+1]);b=max3f(b,p1[r+2],p1[r+3]);}
  const float m=max2f(a,b);
  auto rr=__builtin_amdgcn_permlane32_swap(__float_as_uint(m),__float_as_uint(m),false,false);
  return max2f(__uint_as_float(rr[0]),__uint_as_float(rr[1]));
}
__device__ __forceinline__ void pv(f32x16*o,int vb,bf16x8 pa0,bf16x8 pa1,bf16x8 pa2,bf16x8 pa3){
  #pragma unroll
  for(int d0=0;d0<2;++d0){s16x4 lo[4],hi[4];
    #pragma unroll
    for(int ks=0;ks<4;++ks){
      asm volatile("ds_read_b64_tr_b16 %0,%1 offset:%c2":"=&v"(lo[ks]):"v"(vb),"i"(d0*4096+ks*1024):"memory");
      asm volatile("ds_read_b64_tr_b16 %0,%1 offset:%c2":"=&v"(hi[ks]):"v"(vb),"i"(d0*4096+ks*1024+512):"memory");}
    asm volatile("s_waitcnt lgkmcnt(0)":::"memory");SBAR();
    #define PK(k) (bf16x8){lo[k][0],lo[k][1],lo[k][2],lo[k][3],hi[k][0],hi[k][1],hi[k][2],hi[k][3]}
    o[d0]=__builtin_amdgcn_mfma_f32_32x32x16_bf16(pa0,PK(0),o[d0],0,0,0);
    o[d0]=__builtin_amdgcn_mfma_f32_32x32x16_bf16(pa1,PK(1),o[d0],0,0,0);
    o[d0]=__builtin_amdgcn_mfma_f32_32x32x16_bf16(pa2,PK(2),o[d0],0,0,0);
    o[d0]=__builtin_amdgcn_mfma_f32_32x32x16_bf16(pa3,PK(3),o[d0],0,0,0);
    #undef PK
  }
}

#ifndef ATTN_STORE16
#define ATTN_STORE16(p,v) (*(u32x4*)(p)=(v))
#endif
__device__ __forceinline__ void wmask(f32x16&p0,f32x16&p1,int s0,int tq,int hi){
  const float NEG=-INFINITY;
  #pragma unroll
  for(int r=0;r<16;++r){ const int s=s0+4*hi+(r&3)+8*(r>>2); const int d0=tq-s,d1=d0-32;
    if(!(s>=0&&s<L&&d0<=WINDOW&&d0>=-WINDOW))p0[r]=NEG; if(!(s+32>=0&&s+32<L&&d1<=WINDOW&&d1>=-WINDOW))p1[r]=NEG; }
}
template<int MODE,int THRL,bool FAST> __device__ __forceinline__ void attn_unit(int b,int h,int qb,const bf16*__restrict__ Z,bf16*O,char*shm,int wv,float sinkl2,const float*qnw,const float*rope){
  constexpr bool ISC=(MODE==1||MODE==2),CTXQ=(MODE>=2),WIN=(MODE==1);
  constexpr int QCOL=ISC?Z_CQ:Z_DQ,KCOL=ISC?Z_CK:Z_DK,VCOL=ISC?Z_CV:Z_DV,OCOL=ISC?512:768;
  static_assert(!CTXQ||LC==QB,"context queries: one 256-row unit per (batch, head)");
  const int lane=lane_id(),r32=lane&31,hi=lane>>5; const int wid=wv;
  const long rowbase=CTXQ?(long)NLAT+(long)b*LC:(long)b*L; const int q0=CTXQ?0:qb*QB; const int kvh=h>>1;
  const bf16*Qw=Z+(rowbase+q0+wid*QBLK)*ZP+QCOL+h*D;
  const bf16*Zk=Z+KCOL+kvh*D,*Zv=Z+VCOL+kvh*D; const int crow0=NLAT+b*LC,lrow0=b*L;
  const int kt0=WIN?q0/KVBLK-2-NTC:-NTC;
  #define TROW(t) __builtin_amdgcn_readfirstlane((t)<NTC?crow0+(t)*KVBLK:lrow0+(CTXQ?0:(WIN?min(max(kt0+(t),0),L/KVBLK-1):kt0+(t)))*KVBLK)
  const unsigned lds0=(unsigned)(uintptr_t)shm;
  float*wsf=(float*)(shm+LDS_WS)+wid*64;
  const unsigned koff=(unsigned)(lane*ZP+wid*8)*2u, voff=(unsigned)((16*(wid&3)+(lane>>2))*ZP+(wid>>2)*32+(lane&3)*8)*2u;
  const unsigned kdst=lds0+LDS_K+wid*1024, vdst=lds0+LDS_V+wid*1024;
  #define DMA_K(t,slot) glds16(Zk+(long)TROW(t)*ZP,koff,(unsigned)__builtin_amdgcn_readfirstlane(kdst+(slot)))
  #define DMA_V(t,slot) glds16(Zv+(long)TROW(t)*ZP,voff,(unsigned)__builtin_amdgcn_readfirstlane(vdst+(slot)))
  const int vb0=(int)(lds0+LDS_V)+((lane>>4)&1)*32+(lane&3)*8+(4*hi+((lane&15)>>2))*64;
  const char*Kbase=shm+LDS_K; bf16x8 kf[8];
  const lds_cptr shm3=(lds_cptr)shm; const lds_cptr kp0=shm3+LDS_K+hi*1024+r32*16; const lds_cptr vp0=shm3+LDS_V+((lane>>4)&1)*32+(lane&3)*8+(4*hi+((lane&15)>>2))*64;
  constexpr int NT=CTXQ?NTC+2:(WIN?NTC+8:(LC+L)/KVBLK);
  DMA_K(0,0);DMA_V(0,0);DMA_K(1,SLOTB);
  bf16x8 qr[4];
  #pragma unroll
  for(int d0=0;d0<4;++d0)qr[d0]=*reinterpret_cast<const bf16x8*>(&Qw[(long)r32*ZP+d0*16+hi*8]);
  { float xq[4][8];
    #pragma unroll
    for(int d0=0;d0<4;++d0){
      #pragma unroll
      for(int j=0;j<8;++j)xq[d0][j]=__uint_as_float(((unsigned)(unsigned short)qr[d0][j])<<16); }
    if(!ISC){ float ss=0.f;
      #pragma unroll
      for(int d0=0;d0<4;++d0){
        #pragma unroll
        for(int j=0;j<8;++j)ss+=xq[d0][j]*xq[d0][j]; }
      {auto rr=__builtin_amdgcn_permlane32_swap(__float_as_uint(ss),__float_as_uint(ss),false,false);ss=__uint_as_float(rr[0])+__uint_as_float(rr[1]);}
      const float rstd=1.0f/sqrtf(ss*(1.0f/64.0f)+EPS);
      #pragma unroll
      for(int d0=0;d0<4;++d0){
        #pragma unroll
        for(int j=0;j<8;++j)xq[d0][j]=xq[d0][j]*rstd*qnw[16*d0+8*hi+j]; } }
    if(!CTXQ){ const int tpos=q0+wid*QBLK+r32,pr=tpos>>6,pc=tpos&63;
      #pragma unroll
      for(int j=0;j<8;++j){ const int f=8*hi+j;
        { const float c=rope[(pr*16+f)*2],s_=rope[(pr*16+f)*2+1],x1=xq[0][j],x2=xq[1][j]; xq[0][j]=x1*c-x2*s_; xq[1][j]=x2*c+x1*s_; }
        { const float c=rope[(pc*16+f)*2],s_=rope[(pc*16+f)*2+1],x1=xq[2][j],x2=xq[3][j]; xq[2][j]=x1*c-x2*s_; xq[3][j]=x2*c+x1*s_; } } }
    #pragma unroll
    for(int d0=0;d0<4;++d0){ const u32x4 w=(u32x4){cvtpk_s(xq[d0][0]*QC2,xq[d0][1]*QC2),cvtpk_s(xq[d0][2]*QC2,xq[d0][3]*QC2),cvtpk_s(xq[d0][4]*QC2,xq[d0][5]*QC2),cvtpk_s(xq[d0][6]*QC2,xq[d0][7]*QC2)}; qr[d0]=__builtin_bit_cast(bf16x8,w); } }
  float mhat=0.f,l_reg=0.f;f32x16 o[2];o[0]=f32x16{};o[1]=f32x16{};const f32x16 negm=f32x16{};
  const int tq=q0+wid*QBLK+r32;
  #define CMASK(P0,P1,t) do{ if(MODE&&(t)>=NTC)wmask(P0,P1,CTXQ?-(1<<24):(kt0+(t))*KVBLK,tq,hi); }while(0)
  bool resc=false;
  #define START(P0,P1) do{ resc=false; \
    if(!FAST){ const float rm=rowmax(P0,P1); const float dl=rm; mhat=fadd_s(mhat,dl); \
      _Pragma("unroll") for(int r=0;r<16;++r){P0[r]=fsub_s(P0[r],dl);P1[r]=fsub_s(P1[r],dl);} } \
    _Pragma("unroll") for(int r=0;r<16;++r)P0[r]=__builtin_amdgcn_exp2f(P0[r]); }while(0)
  #define RESC() do{ if(!FAST&&resc){ asm volatile("s_waitcnt lgkmcnt(0)":::"memory"); \
      _Pragma("unroll") for(int d_=0;d_<2;++d_) _Pragma("unroll") for(int r=0;r<16;++r)o[d_][r]*=wsf[crow(r,hi)]; } }while(0)
  f32x16 pA0,pA1,pB0,pB1;
  int sl_prev=0,sl_cur=0,sl_next=SLOTB;
  #define ROT() do{sl_prev=sl_cur;sl_cur=sl_next;sl_next=(sl_next==(NSLOT-1)*SLOTB)?0:sl_next+SLOTB;}while(0)
  DMA_K(2,2*SLOTB);
  WAIT_BAR(3);
  qkt(pA0,pA1,Kbase,qr,negm,r32,hi);asm volatile("s_nop 15\n\ts_nop 7":"+v"(pA0),"+v"(pA1));CMASK(pA0,pA1,0);
  START(pA0,pA1);
  _Pragma("unroll") for(int r=0;r<16;++r)pA1[r]=__builtin_amdgcn_exp2f(pA1[r]);
  WAIT_BAR(0);
  DMA_K(3,0);DMA_V(1,SLOTB);
  ROT();
  kload8(kf,kp0+sl_cur);
  WAIT_BAR(2);
  s16x4 vlo[8],vhi[8]; u32x4 pw0,pw1,pw2,pw3;
  #define PKW(P,B) cvtpk_s(P[B],P[B+1])
  #define PAF(k) __builtin_bit_cast(bf16x8,pw##k)
  #define VFR(i) (bf16x8){vlo[i][0],vlo[i][1],vlo[i][2],vlo[i][3],vhi[i][0],vhi[i][1],vhi[i][2],vhi[i][3]}
  #define PIN(x) asm volatile("":"+v"(x))
  #define MX3(a,b,c) __builtin_fmaxf(__builtin_fmaxf((a),(b)),(c))
  #define GAPA(MF,A0,A1,A2,A3,W0,W1,PW) do{ MF; sacc+=A0; sacc+=A1; sacc+=A2; sacc+=A3; PIN(sacc); W0; W1; PIN(PW); SBAR(); }while(0)
  #define EX(v) __builtin_amdgcn_exp2f(v)
  #define SH(v) (FAST?(v):(v)-mhat)
  #define GAPB(MF,X,B) do{ MF; X[B]=EX(SH(X[B])); X[B+1]=EX(SH(X[B+1])); X[B+2]=EX(SH(X[B+2])); X[B+3]=EX(SH(X[B+3])); PIN(X); SBAR(); }while(0)
  #define VRD(i) do{ vlo[i]=vtr(vp_+(((i)>>2)*4096+((i)&3)*1024)); vhi[i]=vtr(vp_+(((i)>>2)*4096+((i)&3)*1024+512)); }while(0)
  #define KRD(G,j) do{ if(G){ kload2(kf,kp0+sl_next,j); SBAR(); } }while(0)
  #define STEP(C0,C1,P0,P1,t,GK,GV,GL) do{ SBAR(); \
    const lds_cptr vp_=vp0+sl_prev; \
    VRD(0); SBAR(); float sacc=(P0[0]+P0[1]); \
    GAPA(C0=__builtin_amdgcn_mfma_f32_32x32x16_bf16(kf[0],qr[0],negm,0,0,0), P0[2],P0[3],P0[4],P0[5],     pw0[0]=PKW(P0,0), pw0[1]=PKW(P0,2), pw0); \
    VRD(4); SBAR(); GAPA(C1=__builtin_amdgcn_mfma_f32_32x32x16_bf16(kf[1],qr[0],negm,0,0,0), P0[6],P0[7],P0[8],P0[9],     pw0[2]=PKW(P0,4), pw0[3]=PKW(P0,6), pw0); \
    VRD(1); SBAR(); GAPA(C0=__builtin_amdgcn_mfma_f32_32x32x16_bf16(kf[2],qr[1],C0,0,0,0),   P0[10],P0[11],P0[12],P0[13], pw1[0]=PKW(P0,8), pw1[1]=PKW(P0,10), pw1); \
    VRD(5); SBAR(); GAPA(C1=__builtin_amdgcn_mfma_f32_32x32x16_bf16(kf[3],qr[1],C1,0,0,0),   P0[14],P0[15],P1[0],P1[1],   pw1[2]=PKW(P0,12),pw1[3]=PKW(P0,14), pw1); \
    VRD(2); SBAR(); GAPA(C0=__builtin_amdgcn_mfma_f32_32x32x16_bf16(kf[4],qr[2],C0,0,0,0),   P1[2],P1[3],P1[4],P1[5],     pw2[0]=PKW(P1,0), pw2[1]=PKW(P1,2), pw2); \
    VRD(6); SBAR(); GAPA(C1=__builtin_amdgcn_mfma_f32_32x32x16_bf16(kf[5],qr[2],C1,0,0,0),   P1[6],P1[7],P1[8],P1[9],     pw2[2]=PKW(P1,4), pw2[3]=PKW(P1,6), pw2); \
    VRD(3); SBAR(); GAPA(C0=__builtin_amdgcn_mfma_f32_32x32x16_bf16(kf[6],qr[3],C0,0,0,0),   P1[10],P1[11],P1[12],P1[13], pw3[0]=PKW(P1,8), pw3[1]=PKW(P1,10), pw3); \
    VRD(7); SBAR(); GAPA(C1=__builtin_amdgcn_mfma_f32_32x32x16_bf16(kf[7],qr[3],C1,0,0,0),   P1[14],P1[15],0.f,0.f,       pw3[2]=PKW(P1,12),pw3[3]=PKW(P1,14), pw3); \
    l_reg+=sacc; \
    if(GK){DMA_K((t)+3,sl_cur);} if(GV){DMA_V((t)+1,sl_next);} \
    CMASK(C0,C1,t); \
    if(!FAST){ float a=MX3(C0[0],C0[1],C1[0]),b=MX3(C0[2],C0[3],C1[1]); a=MX3(a,C1[2],C1[3]); \
      _Pragma("unroll") for(int r=4;r<16;r+=4){a=MX3(a,C0[r],C0[r+1]);b=MX3(b,C0[r+2],C0[r+3]);a=MX3(a,C1[r],C1[r+1]);b=MX3(b,C1[r+2],C1[r+3]);} \
      float rm=__builtin_fmaxf(a,b); { auto rr=__builtin_amdgcn_permlane32_swap(__float_as_uint(rm),__float_as_uint(rm),false,false); rm=__builtin_fmaxf(__uint_as_float(rr[0]),__uint_as_float(rr[1])); } \
      rm-=mhat;   \
      resc=false; \
      if(__builtin_expect(__any(rm>(float)THRL),0)){ const float dl=__builtin_fmaxf(rm,0.f); mhat+=dl; \
        const float f=__builtin_amdgcn_exp2f(-dl); l_reg*=f; if(hi==0)wsf[r32]=f; resc=true; } } \
    SBAR(); \
    GAPB(o[0]=__builtin_amdgcn_mfma_f32_32x32x16_bf16(PAF(0),VFR(0),o[0],0,0,0), C0,0); \
    GAPB(o[1]=__builtin_amdgcn_mfma_f32_32x32x16_bf16(PAF(0),VFR(4),o[1],0,0,0), C0,4); \
    KRD(GL,0); GAPB(o[0]=__builtin_amdgcn_mfma_f32_32x32x16_bf16(PAF(1),VFR(1),o[0],0,0,0), C0,8); \
    KRD(GL,1); GAPB(o[1]=__builtin_amdgcn_mfma_f32_32x32x16_bf16(PAF(1),VFR(5),o[1],0,0,0), C0,12); \
    KRD(GL,2); GAPB(o[0]=__builtin_amdgcn_mfma_f32_32x32x16_bf16(PAF(2),VFR(2),o[0],0,0,0), C1,0); \
    KRD(GL,3); GAPB(o[1]=__builtin_amdgcn_mfma_f32_32x32x16_bf16(PAF(2),VFR(6),o[1],0,0,0), C1,4); \
    GAPB(o[0]=__builtin_amdgcn_mfma_f32_32x32x16_bf16(PAF(3),VFR(3),o[0],0,0,0), C1,8); \
    GAPB(o[1]=__builtin_amdgcn_mfma_f32_32x32x16_bf16(PAF(3),VFR(7),o[1],0,0,0), C1,12); \
    }while(0)
  int t=1;
  for(;t+5<NT;t+=2){
    STEP(pB0,pB1,pA0,pA1,t,true,true,true);     WAIT_BAR(2); RESC(); ROT();
    STEP(pA0,pA1,pB0,pB1,t+1,true,true,true);   WAIT_BAR(2); RESC(); ROT();
  }
  #define ENDW(tt) do{ if((tt)+3<NT){WAIT_BAR(2);} else if((tt)+2<NT){WAIT_BAR(1);} else {WAIT_BAR(0);} }while(0)
  for(;t+1<NT;t+=2){
    STEP(pB0,pB1,pA0,pA1,t,(t+3<NT),(t+1<NT),(t+1<NT));       ENDW(t);   RESC(); ROT();
    STEP(pA0,pA1,pB0,pB1,t+1,(t+4<NT),(t+2<NT),(t+2<NT));     ENDW(t+1); RESC(); ROT();
  }
  STEP(pB0,pB1,pA0,pA1,NT-1,false,false,false); RESC();
  { float sacc=pB0[0]+pB0[1]; _Pragma("unroll") for(int r=2;r<16;++r)sacc+=pB0[r]; _Pragma("unroll") for(int r=0;r<16;++r)sacc+=pB1[r]; l_reg+=sacc;
    pw0=(u32x4){PKW(pB0,0),PKW(pB0,2),PKW(pB0,4),PKW(pB0,6)};pw1=(u32x4){PKW(pB0,8),PKW(pB0,10),PKW(pB0,12),PKW(pB0,14)};pw2=(u32x4){PKW(pB1,0),PKW(pB1,2),PKW(pB1,4),PKW(pB1,6)};pw3=(u32x4){PKW(pB1,8),PKW(pB1,10),PKW(pB1,12),PKW(pB1,14)};
    SBAR(); pv(o,vb0+sl_cur,PAF(0),PAF(1),PAF(2),PAF(3)); }
  #undef PKW
  #undef PAF
  #undef VFR
  #undef PIN
  #undef MX3
  #undef GAPA
  #undef GAPB
  #undef SH
  #undef EX
  #undef VRD
  #undef KRD
  #undef STEP
  #undef ENDW
  {auto rr=__builtin_amdgcn_permlane32_swap(__float_as_uint(l_reg),__float_as_uint(l_reg),false,false);l_reg=__uint_as_float(rr[0])+__uint_as_float(rr[1]);}
  if(ISC)l_reg+=__builtin_amdgcn_exp2f(sinkl2-mhat);
  if(hi==0)wsf[32+r32]=l_reg;asm volatile("s_waitcnt lgkmcnt(0)":::"memory");
  float rli[16];
  #pragma unroll
  for(int r=0;r<16;++r)rli[r]=__builtin_amdgcn_rcpf(wsf[32+crow(r,hi)]);
  bf16*Ow=O+(rowbase+q0+wid*QBLK)*OP+OCOL+h*D;
  { bf16*stg=(bf16*)(shm+LDS_OST)+wid*2048;
    #pragma unroll
    for(int r=0;r<16;++r){const int orow=crow(r,hi);
      #pragma unroll
      for(int d0=0;d0<2;++d0)stg[orow*64+d0*32+r32]=__float2bfloat16(o[d0][r]*rli[r]);}
    asm volatile("s_waitcnt lgkmcnt(0)":::"memory");
    #pragma unroll
    for(int i=0;i<4;++i){const int row=i*8+(lane>>3),ch=lane&7; const u32x4 v=*(const u32x4*)(stg+row*64+ch*8); ATTN_STORE16(Ow+(long)row*OP+ch*8,v);} }
  asm volatile("s_waitcnt lgkmcnt(0)\n\ts_barrier":::"memory");
  #undef DMA_K
  #undef DMA_V
  #undef TROW
  #undef CMASK
  #undef START
  #undef RESC
  #undef ROT
}
constexpr int ATTN_LDS_BYTES=LDS_BYTES;
template<int MODE,int THRL=8,bool FAST=false> __device__ __forceinline__ void attn_phase(char*lds,const bf16*Z,bf16*O,int wv,const float*sink,const float*qnw,const float*rope){
  const int G=grid_dim(), bid=block_id(), vcu=(G%8==0)?(bid%8)*(G/8)+bid/8:bid; constexpr int NQ=(MODE>=2)?1:NQB, NU=NB*4*NQ;
  const int upc=(NU+G-1)/G;
  const int voff=(MODE==3&&G>=2*NU)?NU:0;
  for(int i=0;i<upc;++i){ const int u=(vcu-voff)*upc+i; if(u<0||u>=NU)break; const int qb=u%NQ,bh=u/NQ; attn_unit<MODE,THRL,FAST>(bh>>2,bh&3,qb,Z,O,lds,wv,(MODE==1||MODE==2)?sink[bh&3]*1.4426950408889634f:0.f,qnw,rope); }
}
#undef SBAR
#undef WAIT_BAR
}

constexpr int LDS_BYTES = pg8::STAGE_BYTES + 16;
static_assert(attn_body::ATTN_LDS_BYTES <= pg8::STAGE_BYTES, "attention LDS");

typedef const __attribute__((address_space(4))) Params* KParams;
__device__ __forceinline__ const Params& fresh_params() { KParams p = (KParams)__builtin_amdgcn_kernarg_segment_ptr(); asm volatile("" : "+s"(p)); return *(const Params*)p; }


typedef float f4_t __attribute__((ext_vector_type(4)));
typedef unsigned u2_t __attribute__((ext_vector_type(2)));
__device__ __forceinline__ float lane_read(float v, int src) { return __int_as_float(__builtin_amdgcn_ds_bpermute(src << 2, __float_as_int(v))); }
__device__ __forceinline__ unsigned lane_read(unsigned v, int src) { return (unsigned)__builtin_amdgcn_ds_bpermute(src << 2, (int)v); }
__device__ __forceinline__ float wave_sum(float v, int lane) {
#pragma unroll
    for (int o = 32; o >= 1; o >>= 1) v += lane_read(v, lane ^ o);
    return v;
}
__device__ __forceinline__ unsigned pk_bf16(float lo, float hi) { return (unsigned)f2bf(lo) | ((unsigned)f2bf(hi) << 16); }
__device__ __forceinline__ void norm_mod_row(const float* x, const float* w, const float* sc, const float* sh, bf16_t* h, int lane, f4_t (&hv)[4]) {
    f4_t xv[4]; float ss = 0.f;
#pragma unroll
    for (int j = 0; j < 4; ++j) { xv[j] = ((const f4_t*)x)[j * 64 + lane]; ss += xv[j][0] * xv[j][0] + xv[j][1] * xv[j][1] + xv[j][2] * xv[j][2] + xv[j][3] * xv[j][3]; }
    ss = wave_sum(ss, lane);
    const float rstd = 1.0f / sqrtf(ss * (1.0f / D) + EPS);
#pragma unroll
    for (int j = 0; j < 4; ++j) { const f4_t wv4 = ((const f4_t*)w)[j * 64 + lane], s4 = ((const f4_t*)sc)[j * 64 + lane], b4 = ((const f4_t*)sh)[j * 64 + lane];
        hv[j] = xv[j] * rstd * wv4 * (1.0f + s4) + b4;
        u2_t o; o.x = pk_bf16(hv[j][0], hv[j][1]); o.y = pk_bf16(hv[j][2], hv[j][3]); ((u2_t*)h)[j * 64 + lane] = o; }
}
template <int NR_, class XF, class HF> __device__ __forceinline__ void norm_rows(const Params& P, int l, int which  , int r0, int dr, int n, int lane, XF xrow, HF hrow) {
    f4_t xv[NR_][4];
#pragma unroll
    for (int q = 0; q < NR_; ++q) { const int r = r0 + q * dr; if (r < n) { const float* x = xrow(r);
#pragma unroll
        for (int j = 0; j < 4; ++j) xv[q][j] = __builtin_nontemporal_load((const f4_t*)x + j * 64 + lane); } }
    f4_t gv[4], sv[4]; int wcur = -1;
#pragma unroll
    for (int q = 0; q < NR_; ++q) { const int r = r0 + q * dr; if (r < n) { float ss = 0.f;
#pragma unroll
        for (int j = 0; j < 4; ++j) ss += xv[q][j][0] * xv[q][j][0] + xv[q][j][1] * xv[q][j][1] + xv[q][j][2] * xv[q][j][2] + xv[q][j][3] * xv[q][j][3];
        ss = wave_sum(ss, lane);
        const float rstd = 1.0f / sqrtf(ss * (1.0f / D) + EPS); const int who = row_who(r);
        if (who != wcur) { wcur = who; const float* sc = modv(P, l, who, which == 1 ? 1 : 4); const float* sh = modv(P, l, who, which == 1 ? 0 : 3);
#pragma unroll
            for (int j = 0; j < 4; ++j) { gv[j] = ((const f4_t*)sc)[j * 64 + lane]; sv[j] = ((const f4_t*)sh)[j * 64 + lane]; } }
        bf16_t* h = hrow(r);
#pragma unroll
        for (int j = 0; j < 4; ++j) { const f4_t hv = xv[q][j] * rstd * gv[j] + sv[j];
            u2_t o; o.x = pk_bf16(hv[0], hv[1]); o.y = pk_bf16(hv[2], hv[3]); ((u2_t*)h)[j * 64 + lane] = o; } } }
}
template <int NR_, class HF> __device__ __forceinline__ void norm_rows16(const Params& P, int l, int r0, int dr, int n, int lane, HF hrow) {
    u2_t xr[NR_][4];
#pragma unroll
    for (int q = 0; q < NR_; ++q) { const int r = r0 + q * dr; if (r < n) { const u2_t* x = (const u2_t*)(P.XB + (size_t)r * D);
#pragma unroll
        for (int j = 0; j < 4; ++j) xr[q][j] = x[j * 64 + lane]; } }
    f4_t gv[4], sv[4]; int wcur = -1;
#pragma unroll
    for (int q = 0; q < NR_; ++q) { const int r = r0 + q * dr; if (r < n) { float ss = 0.f; f4_t xv[4];
#pragma unroll
        for (int j = 0; j < 4; ++j) { xv[j] = (f4_t){bf_lo(xr[q][j].x), bf_hi(xr[q][j].x), bf_lo(xr[q][j].y), bf_hi(xr[q][j].y)}; ss += xv[j][0] * xv[j][0] + xv[j][1] * xv[j][1] + xv[j][2] * xv[j][2] + xv[j][3] * xv[j][3]; }
        ss = wave_sum(ss, lane);
        const float rstd = 1.0f / sqrtf(ss * (1.0f / D) + EPS); const int who = row_who(r);
        if (who != wcur) { wcur = who; const float* sc = modv(P, l, who, 4); const float* sh = modv(P, l, who, 3);
#pragma unroll
            for (int j = 0; j < 4; ++j) { gv[j] = ((const f4_t*)sc)[j * 64 + lane]; sv[j] = ((const f4_t*)sh)[j * 64 + lane]; } }
        bf16_t* h = hrow(r);
#pragma unroll
        for (int j = 0; j < 4; ++j) { const f4_t hv = xv[j] * rstd * gv[j] + sv[j];
            u2_t o; o.x = pk_bf16(hv[0], hv[1]); o.y = pk_bf16(hv[2], hv[3]); ((u2_t*)h)[j * 64 + lane] = o; } } }
}
__device__ __forceinline__ void mod_wave(const Params& P, int w, int lane) {
    const int nb = w % 96, who = (w / 96) % 3, l = w / 288, n = nb * 64 + lane;
    const float* cv = who < 2 ? P.c + who * D : P.c_ctx; const float* wp = P.mod_w + (size_t)l * D * 6 * D + n;
    float acc = 0.f;
    for (int j = 0; j < 16; ++j) { const float x = cv[j * 64 + lane], sv = x * __builtin_amdgcn_rcpf(1.0f + __expf(-x));
#pragma unroll
        for (int kk = 0; kk < 64; ++kk) acc += __int_as_float(__builtin_amdgcn_readlane(__float_as_int(sv), kk)) * wp[(size_t)(j * 64 + kk) * 6 * D]; }
    float v = acc + P.mod_b[l * 6 * D + n];
    { const int part = nb >> 4, col = n & (D - 1);
      if (part == 1) v = (1.0f + v) * P.norm1_w[l * D + col]; else if (part == 4) v = (1.0f + v) * P.norm2_w[l * D + col]; }
    P.MOD[(size_t)(l * 3 + who) * 6 * D + n] = v;
}
template <int LYR> __device__ __forceinline__ void comb_wave(const Params& P, int row, int lane) {
    const int who = row_who(row); u2_t* xb = (u2_t*)(P.XB + (size_t)row * D);
    int inv[16];
#pragma unroll
    for (int e = 0; e < NE; ++e) inv[e] = P.INV[(size_t)e * NR + row];
    f4_t acc[4];
#pragma unroll
    for (int j = 0; j < 4; ++j) acc[j] = (f4_t){0.f, 0.f, 0.f, 0.f};
#pragma unroll
    for (int e = 0; e < NE; ++e) { const int sl = __builtin_amdgcn_readfirstlane(inv[e]);
        if (sl >= 0) { const float g = P.GATE[e * SLOTS_PAD + sl]; const u2_t* yr = (const u2_t*)(P.Y + ((size_t)e * SLOTS_PAD + sl) * D);
#pragma unroll
            for (int j = 0; j < 4; ++j) { const u2_t w = yr[j * 64 + lane]; acc[j] += g * (f4_t){bf_lo(w.x), bf_hi(w.x), bf_lo(w.y), bf_hi(w.y)}; } } }
    const float* m5 = modv(P, LYR, who, 5);
    f4_t xv[4]; float ss = 0.f;
#pragma unroll
    for (int j = 0; j < 4; ++j) { const u2_t xw = xb[j * 64 + lane]; xv[j] = (f4_t){bf_lo(xw.x), bf_hi(xw.x), bf_lo(xw.y), bf_hi(xw.y)} + ((const f4_t*)m5)[j * 64 + lane] * acc[j];
        ss += xv[j][0] * xv[j][0] + xv[j][1] * xv[j][1] + xv[j][2] * xv[j][2] + xv[j][3] * xv[j][3]; }
    ss = wave_sum(ss, lane);
    const float rstd = 1.0f / sqrtf(ss * (1.0f / D) + EPS);
    if (LYR == 0) {
        const float *w = P.norm1_w + D, *sc = modv(P, 1, who, 1), *sh = modv(P, 1, who, 0); bf16_t* h = P.H + (size_t)row * D;
#pragma unroll
        for (int j = 0; j < 4; ++j) { u2_t xo; xo.x = pk_bf16(xv[j][0], xv[j][1]); xo.y = pk_bf16(xv[j][2], xv[j][3]); xb[j * 64 + lane] = xo;
            const f4_t hv = xv[j] * rstd * ((const f4_t*)sc)[j * 64 + lane] + ((const f4_t*)sh)[j * 64 + lane];
            u2_t o; o.x = pk_bf16(hv[0], hv[1]); o.y = pk_bf16(hv[2], hv[3]); ((u2_t*)h)[j * 64 + lane] = o; }
    } else {
        float* x = P.out + (size_t)row * D;
#pragma unroll
        for (int j = 0; j < 4; ++j) __builtin_nontemporal_store(xv[j] * rstd * ((const f4_t*)P.final_norm_w)[j * 64 + lane], (f4_t*)x + j * 64 + lane);
    }
}
__device__ __forceinline__ unsigned block_excl_scan(unsigned v, unsigned* wsum, int wv, int lane, unsigned& total) {
    unsigned inc = v;
#pragma unroll
    for (int o = 1; o < 64; o <<= 1) { const unsigned t = lane_read(inc, (lane - o) & 63); if (lane >= o) inc += t; }
    __syncthreads();
    if (lane == 63) wsum[wv] = inc;
    __syncthreads();
    unsigned off = 0, tot = 0;
#pragma unroll
    for (int w = 0; w < 8; ++w) { const unsigned t = wsum[w]; off += (w < wv) ? t : 0u; tot += t; }
    total = tot; return off + inc - v;
}
__device__ __forceinline__ void topk_block(const Params& P, int item, int wv, int lane, unsigned* lds) {
    const int e = item & 15, seg = item >> 4, N = seg_len(seg), cap = 2 * N / NE, tid = wv * 64 + lane, base = seg_base(seg);
    const float* a = P.AFF + ((size_t)seg * NE + e) * L;
    unsigned* K = lds; unsigned* hist = lds + 16896; unsigned* sh = hist + 16 * 256; unsigned* wsum = sh + 8;
#define KP(i) ((i) + ((i) >> 5))
    { const int n4 = N >> 2; f4_t v[8];
#pragma unroll
        for (int j = 0; j < 8; ++j) { const int q = tid + 512 * j; if (q < n4) v[j] = ((const f4_t*)a)[q]; }
#pragma unroll
        for (int j = 0; j < 8; ++j) { const int q = tid + 512 * j; if (q < n4) { const int p = KP(4 * q); K[p] = __float_as_uint(v[j][0]); K[p + 1] = __float_as_uint(v[j][1]); K[p + 2] = __float_as_uint(v[j][2]); K[p + 3] = __float_as_uint(v[j][3]); } } }
    if (tid == 0) { sh[0] = 0u; sh[1] = (unsigned)cap; }
    __syncthreads();
    for (int pass = 3; pass >= 0; --pass) {
        const int shift = pass * 8; const unsigned maskhi = pass == 3 ? 0u : (0xFFFFFFFFu << (shift + 8));
        for (int i = tid; i < 16 * 256; i += 512) hist[i] = 0u;
        __syncthreads();
        const unsigned prefix = sh[0];
        for (int i = tid; i < N; i += 512) { const unsigned k = K[KP(i)]; if ((k & maskhi) == prefix) atomicAdd(&hist[(lane & 15) * 256 + ((k >> shift) & 255u)], 1u); }
        __syncthreads();
        if (wv == 0) {
            unsigned c[4]; unsigned tot = 0;
#pragma unroll
            for (int j = 0; j < 4; ++j) { unsigned a = 0;
#pragma unroll
                for (int q = 0; q < 16; ++q) a += hist[q * 256 + 4 * lane + j];
                c[j] = a; tot += a; }
            unsigned inc = tot;
#pragma unroll
            for (int o = 1; o < 64; o <<= 1) { const unsigned t = lane_read(inc, (lane + o) & 63); if (lane + o < 64) inc += t; }
            unsigned cum = inc - tot; const unsigned rem = sh[1];
#pragma unroll
            for (int j = 3; j >= 0; --j) { if (cum < rem && rem <= cum + c[j]) { sh[0] = prefix | ((unsigned)(4 * lane + j) << shift); sh[1] = rem - cum; } cum += c[j]; }
        }
        __syncthreads();
    }
    const unsigned kstar = sh[0], need = sh[1];
    const int per = (N + 511) / 512, i0 = tid * per; const bool act = i0 < N;
    unsigned gt = 0, eq = 0;
    if (act) for (int j = 0; j < per; ++j) { const unsigned k = K[KP(i0 + j)]; gt += k > kstar ? 1u : 0u; eq += k == kstar ? 1u : 0u; }
    unsigned tot;
    const unsigned eqb = block_excl_scan(eq, wsum, wv, lane, tot);
    const unsigned take = eqb >= need ? 0u : (need - eqb < eq ? need - eqb : eq);
    unsigned slot = block_excl_scan(gt + take, wsum, wv, lane, tot) + (unsigned)(seg < 2 ? seg * CAP_L : 2 * CAP_L + (seg - 2) * CAP_C);
    unsigned tie = eqb;
    if (act) for (int j = 0; j < per; ++j) { const int i = i0 + j; const unsigned k = K[KP(i)]; bool sel = k > kstar; if (k == kstar) { sel = tie < need; ++tie; }
        if (sel) { P.ROWLIST[e * SLOTS_PAD + slot] = base + i; P.GATE[e * SLOTS_PAD + slot] = __uint_as_float(k); K[KP(i)] = slot; ++slot; }
        else K[KP(i)] = 0xFFFFFFFFu; }
    __syncthreads();
    { const int n4 = N >> 2; int4* dst = (int4*)(P.INV + (size_t)e * NR + base);
        for (int q = tid; q < n4; q += 512) { const int p = KP(4 * q); int4 o; o.x = (int)K[p]; o.y = (int)K[p + 1]; o.z = (int)K[p + 2]; o.w = (int)K[p + 3]; dst[q] = o; } }
#undef KP
    __syncthreads();
}

extern __shared__ __attribute__((aligned(16))) unsigned char shm[];

namespace hg {
typedef short bf16x8 __attribute__((ext_vector_type(8)));
typedef float f32x16 __attribute__((ext_vector_type(16)));
typedef unsigned u32x2 __attribute__((ext_vector_type(2)));
typedef unsigned u32x4 __attribute__((ext_vector_type(4)));
typedef float f32x4_t __attribute__((ext_vector_type(4)));
constexpr int CLB = 160, NCHB = TOT / CLB, NBLK = CLB / 32;
constexpr int KTP = 80, QP = 144, OFF_KT = 0, OFF_QL = 64 * KTP, OFF_KL = OFF_QL + 32 * QP, OFF_LAM = OFF_KL + 32 * QP, WAVE_LDS = OFF_LAM + 256;
static_assert(8 * WAVE_LDS <= pg8::STAGE_BYTES, "hgrn LDS");
__device__ __forceinline__ unsigned pkbf(float lo, float hi) { unsigned r; asm volatile("v_cvt_pk_bf16_f32 %0, %1, %2" : "=v"(r) : "v"(lo), "v"(hi)); return r; }
__device__ __forceinline__ bf16x8 frag2(u32x2 a, u32x2 b) { u32x4 w = {a.x, a.y, b.x, b.y}; return __builtin_bit_cast(bf16x8, w); }
__device__ __forceinline__ bf16x8 accfrag(const f32x16& x, int s2) { u32x4 w = {pkbf(x[8 * s2], x[8 * s2 + 1]), pkbf(x[8 * s2 + 2], x[8 * s2 + 3]), pkbf(x[8 * s2 + 4], x[8 * s2 + 5]), pkbf(x[8 * s2 + 6], x[8 * s2 + 7])}; return __builtin_bit_cast(bf16x8, w); }
template <int PH> __device__ __forceinline__ void b_mfma_wave(const Params& P, int l, int u, int lane, int wv) {
    const int c = u % NCHB, bdh = u / NCHB, head = bdh & 3, dir = (bdh >> 2) & 1, b = bdh >> 3, sgn = dir ? -1 : 1;
    PG8_LAS unsigned char* wl = (PG8_LAS unsigned char*)shm + wv * WAVE_LDS;
    const int kk = lane & 31, h = lane >> 5;
    const float lb = P.LB[l * 256 + head * 64 + lane];
    f32x16 S[2][2];
    float* sst = P.SST + (size_t)u * 4096 + h * 256 + kk;
#pragma unroll
    for (int mt = 0; mt < 2; ++mt)
#pragma unroll
        for (int nt = 0; nt < 2; ++nt)
#pragma unroll
            for (int r = 0; r < 16; ++r) S[mt][nt][r] = PH == 1 ? 0.f : sst[(32 * mt + (r & 3) + 8 * (r >> 2)) * 64 + 32 * nt];
    float ptot = 1.f;
    for (int jb = 0; jb < NBLK; ++jb) {
        const int rbase = scan_row(b, dir, c * CLB + 32 * jb);
        bf16x8 vf[2][2]; const int vlane = sgn * 4 * h * DIN + kk;
#pragma unroll
        for (int s2 = 0; s2 < 2; ++s2)
#pragma unroll
            for (int nt = 0; nt < 2; ++nt) { unsigned w[4];
#pragma unroll
                for (int jp = 0; jp < 4; ++jp) { const int tu = 16 * s2 + 8 * (jp >> 1) + 2 * (jp & 1);
                    const bf16_t* vu = P.Z + ((long)rbase + (long)sgn * tu) * DIN + Z_BI + head * 64 + 32 * nt;
                    w[jp] = (unsigned)vu[vlane] | ((unsigned)vu[vlane + sgn * DIN] << 16); }
                vf[s2][nt] = __builtin_bit_cast(bf16x8, (u32x4){w[0], w[1], w[2], w[3]}); }
        { float lam = 1.f; unsigned ktw[4];
          const bf16_t* zf = P.Z + (size_t)rbase * DIN + Z_BFF + dir * 256 + head * 64 + lane; const bf16_t* zq = P.Z + (size_t)rbase * DIN + Z_BQ + head * 64 + lane;
#pragma unroll
          for (int t = 0; t < 32; ++t) { const long ro = (long)sgn * t * DIN;
              const float z = bf2f(zf[ro]), e = __expf(-z), sg = __builtin_amdgcn_rcpf(1.0f + e), f = lb + (1.0f - lb) * sg, om = (1.0f - lb) * e * sg;
              lam = fmaxf(lam * f, 1e-30f);
              const float kt = om * __builtin_amdgcn_rcpf(lam);
              if (t & 1) { ktw[(t >> 1) & 3] = ((unsigned)f2bf(kt) << 16) | ktw[(t >> 1) & 3]; } else ktw[(t >> 1) & 3] = (unsigned)f2bf(kt);
              if ((t & 7) == 7) *(PG8_LAS u32x4*)(wl + OFF_KT + lane * KTP + (t >> 3) * 16) = (u32x4){ktw[0], ktw[1], ktw[2], ktw[3]};
              if (PH == 3) { const float zqv = bf2f(zq[ro]), q = zqv * __builtin_amdgcn_rcpf(1.0f + __expf(-zqv)) * 0.125f;
                  *(PG8_LAS bf16_t*)(wl + OFF_QL + t * QP + lane * 2) = f2bf(q * lam); *(PG8_LAS bf16_t*)(wl + OFF_KL + t * QP + lane * 2) = f2bf(kt); } }
          *(PG8_LAS float*)(wl + OFF_LAM + lane * 4) = lam; ptot *= lam; }
        asm volatile("s_waitcnt lgkmcnt(0)" ::: "memory");
        if (PH == 3) {
            bf16x8 qf[4], kf[4];
#pragma unroll
            for (int sl = 0; sl < 4; ++sl) { const int o = (16 * sl + 4 * h) * 2;
                qf[sl] = frag2(*(PG8_LAS u32x2*)(wl + OFF_QL + kk * QP + o), *(PG8_LAS u32x2*)(wl + OFF_QL + kk * QP + o + 16));
                kf[sl] = frag2(*(PG8_LAS u32x2*)(wl + OFF_KL + kk * QP + o), *(PG8_LAS u32x2*)(wl + OFF_KL + kk * QP + o + 16)); }
            f32x16 ct = {};
#pragma unroll
            for (int sl = 0; sl < 4; ++sl) ct = __builtin_amdgcn_mfma_f32_32x32x16_bf16(kf[sl], qf[sl], ct, 0, 0, 0);
#pragma unroll
            for (int r = 0; r < 16; ++r) { const int sr = (r & 3) + 8 * (r >> 2) + 4 * h; if (sr > kk) ct[r] = 0.f; }
            const bf16x8 af0 = accfrag(ct, 0), af1 = accfrag(ct, 1);
            f32x16 o[2] = {{}, {}};
#pragma unroll
            for (int nt = 0; nt < 2; ++nt) {
#pragma unroll
                for (int sl = 0; sl < 4; ++sl) o[nt] = __builtin_amdgcn_mfma_f32_32x32x16_bf16(qf[sl], accfrag(S[sl >> 1][nt], sl & 1), o[nt], 0, 0, 0);
                o[nt] = __builtin_amdgcn_mfma_f32_32x32x16_bf16(af0, vf[0][nt], o[nt], 0, 0, 0);
                o[nt] = __builtin_amdgcn_mfma_f32_32x32x16_bf16(af1, vf[1][nt], o[nt], 0, 0, 0); }
#pragma unroll
            for (int nt = 0; nt < 2; ++nt)
#pragma unroll
                for (int r = 0; r < 16; ++r) { bf16_t* hu = P.HB + ((long)dir * NR + rbase + (long)sgn * ((r & 3) + 8 * (r >> 2))) * 256 + head * 64 + 32 * nt;
                    hu[sgn * 4 * h * 256 + kk] = f2bf(o[nt][r]); }
        }
#pragma unroll
        for (int mt = 0; mt < 2; ++mt) {
            bf16x8 a0, a1; { const int ro = (32 * mt + kk) * KTP + 4 * h * 2;
                a0 = frag2(*(PG8_LAS u32x2*)(wl + OFF_KT + ro), *(PG8_LAS u32x2*)(wl + OFF_KT + ro + 16));
                a1 = frag2(*(PG8_LAS u32x2*)(wl + OFF_KT + ro + 32), *(PG8_LAS u32x2*)(wl + OFF_KT + ro + 48)); }
#pragma unroll
            for (int nt = 0; nt < 2; ++nt) { S[mt][nt] = __builtin_amdgcn_mfma_f32_32x32x16_bf16(a0, vf[0][nt], S[mt][nt], 0, 0, 0); S[mt][nt] = __builtin_amdgcn_mfma_f32_32x32x16_bf16(a1, vf[1][nt], S[mt][nt], 0, 0, 0); }
#pragma unroll
            for (int g = 0; g < 4; ++g) { const f32x4_t lm = *(PG8_LAS f32x4_t*)(wl + OFF_LAM + (32 * mt + 8 * g + 4 * h) * 4);
#pragma unroll
                for (int nt = 0; nt < 2; ++nt) { S[mt][nt][4 * g] *= lm[0]; S[mt][nt][4 * g + 1] *= lm[1]; S[mt][nt][4 * g + 2] *= lm[2]; S[mt][nt][4 * g + 3] *= lm[3]; } } }
        asm volatile("s_waitcnt lgkmcnt(0)" ::: "memory");
    }
    if (PH == 1) {
#pragma unroll
        for (int mt = 0; mt < 2; ++mt)
#pragma unroll
            for (int nt = 0; nt < 2; ++nt)
#pragma unroll
                for (int r = 0; r < 16; ++r) sst[(32 * mt + (r & 3) + 8 * (r >> 2)) * 64 + 32 * nt] = S[mt][nt][r];
        P.PST[(size_t)u * 64 + lane] = ptot; }
}
}

struct GpuExec {
    int wv;
    __device__ __forceinline__ PG8_LAS unsigned char* lds() const { return (PG8_LAS unsigned char*)shm; }
    template <class F> __device__ __forceinline__ void run(i64 n, F f) { const Params& P = fresh_params(); const int G = grid_dim(); const i64 gsz = (i64)G * 512; for (i64 i = ((i64)wv * G + block_id()) * 64 + lane_id(); i < n; i += gsz) f(P, i); }
    __device__ __forceinline__ void sync_soft() {}
    template <class F> __device__ __forceinline__ void run_skipctx(i64 n, F f) { const Params& P = fresh_params(); const int G = grid_dim(), bid = block_id();
        if (G != 256) { for (i64 i = ((i64)wv * G + bid) * 64 + lane_id(); i < n; i += (i64)G * 512) f(P, i); return; }
        if (bid < 128 && (bid & 7) == 0) return;
        const int G2 = 240, rk = bid >= 128 ? bid - 16 : bid - (bid >> 3) - 1;
        for (i64 i = ((i64)wv * G2 + rk) * 64 + lane_id(); i < n; i += (i64)G2 * 512) f(P, i); }
    __device__ __forceinline__ void sync() { XcdBarrier b; b.bar = fresh_params().bar; b.x = xb_xcc_id(); b.st = (volatile LAS unsigned*)(lds() + pg8::STAGE_BYTES); xcd_barrier(b, wv == 0 && lane_id() == 0); }
    template <class F> __device__ __forceinline__ void run_from(int b0, i64 n, F f) {
        const Params& P = fresh_params(); const int G = grid_dim(), bid = block_id(), o = G > b0 ? b0 : 0, G2 = G - o; if (bid < o) return;
        const i64 gsz = (i64)G2 * 512; for (i64 i = ((i64)wv * G2 + (bid - o)) * 64 + lane_id(); i < n; i += gsz) f(P, i); }
    template <class F> __device__ __forceinline__ void run_wave_from(int b0, int n, F f) { const Params& P = fresh_params(); const int lane = lane_id(), G = grid_dim(), bid = block_id(), o = G > 2 * b0 ? b0 : 0, G2 = G - o; if (bid < o) return;
        for (int r = wv * G2 + (bid - o); r < n; r += G2 * 8) f(P, r, lane); }
    template <class F> __device__ __forceinline__ void run_wave(int n, F f) { const Params& P = fresh_params(); const int lane = lane_id(), G = grid_dim(), nw = G * 8; for (int r = wv * G + block_id(); r < n; r += nw) f(P, r, lane); }
    __device__ __forceinline__ void mod() { run_wave(2 * 3 * 96, [&](const Params& P, int w, int lane) { mod_wave(P, w, lane); }); }
    template <int WHICH> __device__ __forceinline__ void norm_phase(int l, int n) { const Params& P = fresh_params(); const int lane = lane_id(), G = grid_dim(), nw = G * 8;
        for (int r = wv * G + block_id(); r < n; r += 4 * nw) norm_rows<4>(P, l, WHICH, r, nw, n, lane, [&](int rr) { return WHICH == 1 ? xsrc_row(P, l, rr) : (const float*)xcur_row(P, rr); }, [&](int rr) { return P.H + (size_t)rr * D; }); }
    __device__ __forceinline__ void norm1(int l) { if (l == 0) norm_phase<1>(l, NR); }
    __device__ __forceinline__ void comb(int l) { if (l == 0) run_wave(NR, [&](const Params& P, int r, int lane) { comb_wave<0>(P, r, lane); }); else run_wave(NLAT, [&](const Params& P, int r, int lane) { comb_wave<1>(P, r, lane); }); }
    __device__ __forceinline__ void norm2(int l) { const Params& P = fresh_params(); const int lane = lane_id(), G = grid_dim(), nw = G * 8, n = nrows_out(l);
        for (int r = wv * G + block_id(); r < n; r += 8 * nw) norm_rows16<8>(P, l, r, nw, n, lane, [&](int rr) { return P.H + (size_t)rr * D; }); }
    __device__ __forceinline__ void final_norm() {}
    __device__ __forceinline__ void qkv_prep(int l) { run((i64)NR * 4, [&](const Params& P, i64 i) { st_qkv_prep_k(P, l, i); }); }
    __device__ __forceinline__ void b_pre(int l) {}
    __device__ __forceinline__ void b_scan(int l, int ph) {
        if (ph == 1) run_wave_from(8, 16 * hg::NCHB, [&](const Params& P, int u, int lane) { hg::b_mfma_wave<1>(P, l, u, lane, wv); });
        else if (ph == 2) { if (l == 0) run_skipctx((i64)2 * 2 * 4 * 4096, [&](const Params& P, i64 i) { st_b_scan2<hg::NCHB>(P, l, i); }); else run((i64)2 * 2 * 4 * 4096, [&](const Params& P, i64 i) { st_b_scan2<hg::NCHB>(P, l, i); }); }
        else run_wave(16 * hg::NCHB, [&](const Params& P, int u, int lane) { hg::b_mfma_wave<3>(P, l, u, lane, wv); });
    }
    __device__ __forceinline__ void topk(int l) { const Params& P = fresh_params(); const int lane = lane_id(); for (int it = block_id(); it < (l == 0 ? 4 : 2) * 16; it += grid_dim()) topk_block(P, it, wv, lane, (unsigned*)shm); }
    __device__ __forceinline__ void inproj(int l) {
        const Params& P = fresh_params();
        pg8::StaticOrder S; S.init(NR, DIN, grid_dim(), block_id());
        pg8::EpiZ E{P.Z, DIN};
        pg8::gemm_phase<pg8::EpiZ, pg8::StaticOrder, false>(lds(), pg8::Gemm{P.H, P.WINT, NR, DIN, D}, S, E, nullptr, wv);
    }
    __device__ __forceinline__ void a_coef(int l) {
        const Params& P = fresh_params();
        pg8::StaticOrder S; S.init(NR, 1024, grid_dim(), block_id());
        pg8::EpiCoef E{&P, l};
        pg8::gemm_phase<pg8::EpiCoef, pg8::StaticOrder, false>(lds(), pg8::Gemm{P.XAB, P.WG, NR, 1024, 256}, S, E, nullptr, wv);
    }
    __device__ __forceinline__ void router(int l) {
        const Params& P = fresh_params();
        pg8::StaticOrder S; S.init(nrows_out(l), 256, grid_dim(), block_id());
        pg8::EpiRouter E{P.AFF};
        pg8::gemm_phase<pg8::EpiRouter, pg8::StaticOrder, false>(lds(), pg8::Gemm{P.H, P.RWT, nrows_out(l), 256, D}, S, E, nullptr, wv);
    }
    __device__ __forceinline__ void outproj(int l) {
        const Params& P = fresh_params();
        pg8::StaticOrder S; S.init(nrows_out(l), D, grid_dim(), block_id());
        if (l == 0) { pg8::EpiOut<false> E{P.x, P.ctx, nullptr, P.XB, P.MOD + (size_t)l * 3 * 6 * D};
            pg8::gemm_phase<pg8::EpiOut<false>, pg8::StaticOrder, false>(lds(), pg8::Gemm{P.YM, P.WOUTT, nrows_out(l), D, D}, S, E, nullptr, wv); }
        else { pg8::EpiOut<true> E{nullptr, nullptr, P.XB, P.XB, P.MOD + (size_t)l * 3 * 6 * D};
            pg8::gemm_phase<pg8::EpiOut<true>, pg8::StaticOrder, false>(lds(), pg8::Gemm{P.YM, P.WOUTT, nrows_out(l), D, D}, S, E, nullptr, wv); }
    }
    __device__ __forceinline__ void attn_dense(int l) {
        const Params& P = fresh_params();
        if (P.FLAGS[l]) {
            attn_body::attn_phase<0, 8, true>((char*)shm, (const attn_body::bf16*)P.Z, (attn_body::bf16*)P.YM, wv, nullptr, P.d_qnorm_w + l * 64, P.ROPE);
            if (l == 0) attn_body::attn_phase<3, 8, true>((char*)shm, (const attn_body::bf16*)P.Z, (attn_body::bf16*)P.YM, wv, nullptr, P.d_qnorm_w + l * 64, P.ROPE);
        } else {
            attn_body::attn_phase<0, 8>((char*)shm, (const attn_body::bf16*)P.Z, (attn_body::bf16*)P.YM, wv, nullptr, P.d_qnorm_w + l * 64, P.ROPE);
            if (l == 0) attn_body::attn_phase<3, 8>((char*)shm, (const attn_body::bf16*)P.Z, (attn_body::bf16*)P.YM, wv, nullptr, P.d_qnorm_w + l * 64, P.ROPE);
        }
    }
    __device__ __forceinline__ void attn_win(int l) {
        const Params& P = fresh_params();
        attn_body::attn_phase<1, 8>((char*)shm, (const attn_body::bf16*)P.Z, (attn_body::bf16*)P.YM, wv, P.c_sink + l * 4, nullptr, P.ROPE);
        if (l == 0) attn_body::attn_phase<2, 8>((char*)shm, (const attn_body::bf16*)P.Z, (attn_body::bf16*)P.YM, wv, P.c_sink + l * 4, nullptr, P.ROPE);
    }
    __device__ __forceinline__ void moe1(int l) {
        const Params& P = fresh_params();
        pg8::GroupOrder S; S.init(nslots(l), 8, grid_dim(), block_id());
        pg8::EpiHid E{P.HID};
        pg8::gemm_phase<pg8::EpiHid, pg8::GroupOrder, false, true, true>(lds(), pg8::Gemm{P.H, P.W13T, NE * SLOTS_PAD, NE * 2048, D}, S, E, nullptr, wv, P.ROWLIST);
    }
    __device__ __forceinline__ void moe2(int l) {
        const Params& P = fresh_params();
        pg8::GroupOrder S; S.init(nslots(l), 4, grid_dim(), block_id());
        pg8::EpiY E{P.Y};
        pg8::gemm_phase<pg8::EpiY, pg8::GroupOrder, false, false, true>(lds(), pg8::Gemm{P.HID, P.W2T, NE * SLOTS_PAD, NE * 1024, 1024}, S, E, nullptr, wv);
    }
};

__global__ void __launch_bounds__(512, 2) mega_fwd(Params P) {
    GpuExec ex; ex.wv = __builtin_amdgcn_readfirstlane((int)threadIdx.x >> 6);
    volatile LAS unsigned* xbw = (volatile LAS unsigned*)(ex.lds() + pg8::STAGE_BYTES);
    if (threadIdx.x < 4) xbw[threadIdx.x] = 0u;
    __syncthreads();
    (void)xcd_barrier_post(fresh_params().bar, xbw, threadIdx.x == 0);
    pipeline(ex);
}

extern "C" void kernel_launch(void* const* d_in, const int* in_sizes, int n_in, void* d_out, int out_size, void* d_ws, size_t ws_size, hipStream_t stream) {
    Params P{};
    const float** f = (const float**)&P;
    for (int i = 0; i < 27; ++i) f[i] = (const float*)d_in[i];
    P.out = (float*)d_out;
    const size_t need = carve(P, (char*)d_ws);
    if (need > ws_size) fprintf(stderr, "workspace too small: need %zu have %zu\n", need, ws_size);
    static int grid = 0;
    if (!grid) {
        int dev = 0, cus = 0, per_cu = 0;
        (void)hipGetDevice(&dev);
        (void)hipDeviceGetAttribute(&cus, hipDeviceAttributeMultiprocessorCount, dev);
        (void)hipFuncSetAttribute((const void*)mega_fwd, hipFuncAttributeMaxDynamicSharedMemorySize, LDS_BYTES);
        (void)hipOccupancyMaxActiveBlocksPerMultiprocessor(&per_cu, mega_fwd, 512, LDS_BYTES);
        grid = cus * (per_cu < 1 ? per_cu : 1);
        if (grid <= 0) grid = 256;
    }
    (void)hipMemsetAsync(P.bar, 0, XCD_BAR_WORDS * sizeof(unsigned), stream);
    hipLaunchKernelGGL(mega_fwd, dim3(grid), dim3(512), LDS_BYTES, stream, P);
}
#endif
```

```cpp
#ifndef CPU_TEST
#include <hip/hip_runtime.h>
#include <hip/hip_bf16.h>
#include <cstdio>
#include <cstdint>
#define HD __device__ __forceinline__
#else
#include <cmath>
#include <cstdio>
#include <cstdint>
#include <cstring>
#define HD inline
#endif

#ifndef CFG_SEQ
#define CFG_SEQ 16384
#endif
#ifndef CFG_CTX
#define CFG_CTX 256
#endif

typedef unsigned short bf16_t;
typedef long long i64;

constexpr int NB = 2, L = CFG_SEQ, LC = CFG_CTX, D = 1024, DIN = 2816;
constexpr int NLAT = NB * L, NCTX = NB * LC, NR = NLAT + NCTX;
constexpr int NE = 16, CAP_L = 2 * L / NE, CAP_C = 2 * LC / NE;
constexpr int SLOTS_L = NB * CAP_L, SLOTS_ALL = NB * CAP_L + NB * CAP_C, SLOTS_PAD = ((SLOTS_ALL + 255) / 256) * 256;
constexpr int WINDOW = 128;
constexpr int TOT = LC + L, NCH = 128, CL = TOT / NCH;
static_assert(TOT % NCH == 0, "chunking");
static_assert(NCH % 8 == 0, "scan2 batches");
constexpr float EPS = 1e-6f;
constexpr float QC2 = 0.125f * 1.4426950408889634f;
constexpr int Z_AX = 0, Z_AY = 256, Z_BQ = 512, Z_BFF = 768, Z_BFB = 1024, Z_BI = 1280, Z_BG = 1536,
              Z_CQ = 1792, Z_CK = 2048, Z_CV = 2176, Z_DQ = 2304, Z_DK = 2560, Z_DV = 2688;

struct Params {
    const float *x, *c, *ctx, *c_ctx, *mod_w, *mod_b, *norm1_w, *w_in, *a_conv_w, *a_conv_b, *a_gate_a_w, *a_gate_a_b,
                *a_gate_x_w, *a_gate_x_b, *a_lambda, *b_lb_logits, *b_onorm_w, *c_sink, *d_qnorm_w, *d_knorm_w, *w_out,
                *norm2_w, *router_w, *exp_w1, *exp_w3, *exp_w2, *final_norm_w;
    float* out;
    unsigned* bar;
    float *MOD, *LB, *ROPE, *XC, *AFF, *GATE, *SP8;
    int *ROWLIST, *INV, *FLAGS;
    bf16_t *H, *Z, *YM, *HID, *Y, *XS;
    bf16_t *WINT, *WOUTT, *W13T, *W2T;
    bf16_t *RWT;
    bf16_t *XAB, *WG;
    bf16_t *CA, *CU;
    float *BQ, *BF; bf16_t *HB;
    float *CRA, *CRH, *SST, *PST;
    bf16_t* XB;
};

struct Carver { char* base; size_t off; void* take(size_t bytes) { void* p = base + off; off += (bytes + 255) & ~(size_t)255; return p; } };
inline size_t carve(Params& P, char* ws) {
    Carver c{ws, 0};
    P.bar = (unsigned*)c.take(16384);
    P.MOD = (float*)c.take(sizeof(float) * 2 * 3 * 6 * D);
    P.LB = (float*)c.take(sizeof(float) * 2 * 256);
    P.SP8 = (float*)c.take(sizeof(float) * 2 * 2 * 256);
    P.ROPE = (float*)c.take(sizeof(float) * 256 * 16 * 2);
    P.XC = (float*)c.take(sizeof(float) * (size_t)NCTX * D);
    P.AFF = (float*)c.take(sizeof(float) * (size_t)4 * NE * L);
    P.GATE = (float*)c.take(sizeof(float) * (size_t)NE * SLOTS_PAD);
    P.ROWLIST = (int*)c.take(sizeof(int) * (size_t)NE * SLOTS_PAD);
    P.INV = (int*)c.take(sizeof(int) * (size_t)NR * NE);
    P.FLAGS = (int*)c.take(256);
    P.WINT = (bf16_t*)c.take(2 * (size_t)DIN * D);
    P.WOUTT = (bf16_t*)c.take(2 * (size_t)D * D);
    P.W13T = (bf16_t*)c.take(2 * (size_t)NE * 2048 * D);
    P.W2T = (bf16_t*)c.take(2 * (size_t)NE * D * 1024);
    P.WG = (bf16_t*)c.take(2 * (size_t)1024 * 256);
    P.RWT = (bf16_t*)c.take(2 * (size_t)256 * D);
    P.H = (bf16_t*)c.take(2 * (size_t)NR * D);
    P.YM = P.H;
    const size_t zbytes = 2 * (size_t)NR * DIN, hidbytes = 2 * (size_t)NE * SLOTS_PAD * D;
    char* zreg = (char*)c.take(zbytes > hidbytes ? zbytes : hidbytes);
    P.Z = (bf16_t*)zreg; P.HID = (bf16_t*)zreg;
    const size_t f256 = sizeof(float) * (size_t)NR * 256, h256 = f256 / 2;
    const size_t crbytes = sizeof(float) * 4 * NCH * 256, sstbytes = sizeof(float) * (size_t)16 * NCH * 4096, pstbytes = sizeof(float) * 16 * NCH * 64;
    size_t tbytes = 5 * h256 + 2 * h256 + 2 * crbytes + sstbytes + pstbytes; if (tbytes < hidbytes) tbytes = hidbytes;
    char* treg = (char*)c.take(tbytes);
    P.XAB = (bf16_t*)treg; P.CA = (bf16_t*)(treg + h256); P.CU = (bf16_t*)(treg + 3 * h256); P.HB = (bf16_t*)(treg + 5 * h256);
    { char* q = treg + 5 * h256 + 2 * h256; P.CRA = (float*)q; P.CRH = (float*)(q + crbytes); P.SST = (float*)(q + 2 * crbytes); P.PST = (float*)(q + 2 * crbytes + sstbytes); }
#ifdef CPU_TEST
    P.BQ = (float*)c.take(f256); P.BF = (float*)c.take(2 * f256);
#else
    P.BQ = nullptr; P.BF = nullptr;
#endif
    P.XS = (bf16_t*)treg; P.Y = (bf16_t*)treg;
    P.XB = (bf16_t*)c.take(2 * (size_t)NR * D);
    return c.off;
}

struct alignas(16) U4 { unsigned x, y, z, w; };
struct alignas(16) F4 { float x, y, z, w; };
HD F4 ldnt4(const float* p) {
#if defined(__HIP_DEVICE_COMPILE__)
    typedef float v4f_ __attribute__((ext_vector_type(4))); const v4f_ v = __builtin_nontemporal_load((const v4f_*)p); return F4{v.x, v.y, v.z, v.w};
#else
    return *(const F4*)p;
#endif
}
HD float bf_lo(unsigned u) { union { unsigned u; float f; } c; c.u = u << 16; return c.f; }
HD float bf_hi(unsigned u) { union { unsigned u; float f; } c; c.u = u & 0xffff0000u; return c.f; }
HD unsigned pk2(float lo, float hi);
HD void ld8(const bf16_t* p, float (&v)[8]) { const U4 u = *(const U4*)p; v[0] = bf_lo(u.x); v[1] = bf_hi(u.x); v[2] = bf_lo(u.y); v[3] = bf_hi(u.y); v[4] = bf_lo(u.z); v[5] = bf_hi(u.z); v[6] = bf_lo(u.w); v[7] = bf_hi(u.w); }
HD void ld8f(const float* p, float (&v)[8]) { const F4 a = *(const F4*)p, b = *(const F4*)(p + 4); v[0] = a.x; v[1] = a.y; v[2] = a.z; v[3] = a.w; v[4] = b.x; v[5] = b.y; v[6] = b.z; v[7] = b.w; }
HD void st8f(float* p, const float (&v)[8]) { *(F4*)p = F4{v[0], v[1], v[2], v[3]}; *(F4*)(p + 4) = F4{v[4], v[5], v[6], v[7]}; }
HD float bf2f(bf16_t v) { union { unsigned u; float f; } c; c.u = ((unsigned)v) << 16; return c.f; }
HD bf16_t f2bf(float f) { union { unsigned u; float f; } c; c.f = f; unsigned u = c.u; u += 0x7FFFu + ((u >> 16) & 1u); return (bf16_t)(u >> 16); }
HD unsigned pk2(float lo, float hi) { return (unsigned)f2bf(lo) | ((unsigned)f2bf(hi) << 16); }
HD void st8(bf16_t* p, const float (&v)[8]) { *(U4*)p = U4{pk2(v[0], v[1]), pk2(v[2], v[3]), pk2(v[4], v[5]), pk2(v[6], v[7])}; }
HD float sigmoidf_(float x) { return 1.0f / (1.0f + expf(-x)); }
HD float siluf_(float x) { return x * sigmoidf_(x); }
HD float gelu_tanh_(float x) { return 0.5f * x * (1.0f + tanhf(0.7978845608028654f * (x + 0.044715f * x * x * x))); }

HD int row_who(int row) { return row < NLAT ? row / L : 2; }
HD int row_seg(int row) { return row < NLAT ? row / L : 2 + (row - NLAT) / LC; }
HD int seg_base(int seg) { return seg < 2 ? seg * L : NLAT + (seg - 2) * LC; }
HD int seg_len(int seg) { return seg < 2 ? L : LC; }
HD const float* modv(const Params& P, int l, int who, int part) { return P.MOD + ((size_t)(l * 3 + who) * 6 + part) * D; }
HD const float* xsrc_row(const Params& P, int l, int row) {
    if (row < NLAT) return (l == 0 ? P.x : P.out) + (size_t)row * D;
    return (l == 0 ? P.ctx : P.XC) + (size_t)(row - NLAT) * D;
}
HD float* xcur_row(const Params& P, int row) { return row < NLAT ? P.out + (size_t)row * D : P.XC + (size_t)(row - NLAT) * D; }
HD int nrows_out(int l) { return l == 0 ? NR : NLAT; }
HD int nslots(int l) { return l == 0 ? SLOTS_ALL : SLOTS_L; }

HD void st_mod(const Params& P, i64 i) {
    const int n = (int)(i % (6 * D)), who = (int)((i / (6 * D)) % 3), l = (int)(i / (6 * D) / 3);
    const float* cv = who < 2 ? P.c + who * D : P.c_ctx;
    const float* w = P.mod_w + (size_t)l * D * 6 * D + n;
    float s = 0.f;
    for (int k = 0; k < D; ++k) s += siluf_(cv[k]) * w[(size_t)k * 6 * D];
    P.MOD[i] = s + P.mod_b[l * 6 * D + n];
}
HD void st_lb(const Params& P, i64 i) {
    const float a = P.b_lb_logits[i], b = P.b_lb_logits[256 + i], m = fmaxf(a, b);
    const float ea = expf(a - m), eb = expf(b - m), s0 = ea / (ea + eb), s1 = eb / (ea + eb);
    P.LB[i] = s0 - s0; P.LB[256 + i] = (s0 + s1) - s0;
}
HD void st_flags(const Params& P, i64 l) {
    float mq = 0.f, mk = 0.f; for (int e = 0; e < 64; ++e) { mq = fmaxf(mq, fabsf(P.d_qnorm_w[l * 64 + e])); mk = fmaxf(mk, fabsf(P.d_knorm_w[l * 64 + e])); }
    P.FLAGS[l] = (8.0f * 1.4426950408889634f * mq * mk <= 60.0f) ? 1 : 0;
}
HD void st_sp8(const Params& P, i64 i) {
    P.SP8[i] = -8.0f * log1pf(expf(-P.a_lambda[i]));
}
HD void st_rope(const Params& P, i64 i) {
    const int f = (int)(i & 15), pos = (int)(i >> 4);
    const float inv = (float)exp(-(double)f / 16.0 * 9.210340371976184);
    const float ang = (float)pos * inv;
    double y = (double)ang;
    const double twopi = 6.283185307179586476925;
    y -= twopi * floor(y / twopi + 0.5);
    double s = 0.0, cc = 0.0, term = 1.0;
    for (int n = 0; n < 30; ++n) { if (n & 1) s += ((n >> 1) & 1) ? -term : term; else cc += ((n >> 1) & 1) ? -term : term; term *= y / (double)(n + 1); }
    P.ROPE[i * 2] = (float)cc; P.ROPE[i * 2 + 1] = (float)s;
}

template <class RowFn> HD void cvt_tile(const float* src, size_t ld, int N, size_t K, i64 i, bf16_t* dst, RowFn dst_row) {
    const int li = (int)(i & 63); const i64 w = i >> 6; const int nq = li & 15, kq = li >> 4, ntl = N / 64, nt = (int)(w % ntl), kt = (int)(w / ntl);
    const int n0 = nt * 64 + nq * 4, k0 = kt * 64 + kq * 16;
    float v[16][4];
#pragma unroll
    for (int r = 0; r < 16; ++r) { const F4 t = ldnt4(src + (size_t)(k0 + r) * ld + n0); v[r][0] = t.x; v[r][1] = t.y; v[r][2] = t.z; v[r][3] = t.w; }
#pragma unroll
    for (int j = 0; j < 4; ++j) { bf16_t* d = dst + (size_t)dst_row(n0 + j) * K + k0; float a[8], b[8];
#pragma unroll
        for (int r = 0; r < 8; ++r) { a[r] = v[r][j]; b[r] = v[8 + r][j]; }
        st8(d, a); st8(d + 8, b); }
}
HD void st_cvt_win(const Params& P, int l, i64 i) {
    cvt_tile(P.w_in + (size_t)l * D * DIN, DIN, DIN, D, i, P.WINT, [](int n) { return n; });
}
HD void st_cvt_wout(const Params& P, int l, i64 i) {
    cvt_tile(P.w_out + (size_t)l * D * D, D, D, D, i, P.WOUTT, [](int n) { return n; });
}
HD void st_cvt_w13(const Params& P, int l, i64 i) {
    const int which = (int)((i >> 14) & 1), e = (int)(i >> 15);
    const float* src = (which ? P.exp_w3 : P.exp_w1) + (size_t)(l * NE + e) * D * 1024;
    cvt_tile(src, 1024, 1024, D, i & 16383, P.W13T + (size_t)e * 2048 * D, [which](int f) { return (f >> 7) * 256 + which * 128 + (f & 127); });
}
HD void st_cvt_w2(const Params& P, int l, i64 i) {
    const int e = (int)(i >> 14);
    cvt_tile(P.exp_w2 + (size_t)(l * NE + e) * 1024 * D, D, D, 1024, i & 16383, P.W2T + (size_t)e * D * 1024, [](int n) { return n; });
}

HD void st_norm1(const Params& P, int l, i64 row) {
    const float* x = xsrc_row(P, l, (int)row);
    float ss = 0.f; for (int d = 0; d < D; ++d) ss += x[d] * x[d];
    const float rstd = 1.0f / sqrtf(ss * (1.0f / D) + EPS);
    const int who = row_who((int)row);
    const float *sh = modv(P, l, who, 0), *sc = modv(P, l, who, 1), *w = P.norm1_w + l * D;
    bf16_t* h = P.H + (size_t)row * D;
    for (int d = 0; d < D; ++d) h[d] = f2bf(x[d] * rstd * w[d] * (1.0f + sc[d]) + sh[d]);
}
HD void st_inproj(const Params& P, int l, i64 i) {
    const int n = (int)(i % DIN); const i64 row = i / DIN;
    const bf16_t* h = P.H + (size_t)row * D; const bf16_t* w = P.WINT + (size_t)n * D;
    float s = 0.f; for (int k = 0; k < D; ++k) s += bf2f(h[k]) * bf2f(w[k]);
    P.Z[i] = f2bf(s);
}
HD void st_cvt_wg(const Params& P, int l, i64 i) {
    const int kb = (int)(i & 31), n = (int)(i >> 5), pn = n >> 8, r = n & 255, g = r >> 7, ch = (pn & 1) * 128 + (r & 127), dir = pn >> 1, blk = ch >> 6, j = ch & 63;
    const float* w = (g ? P.a_gate_x_w : P.a_gate_a_w) + ((size_t)((l * 2 + dir) * 4 + blk) * 64) * 64 + j;
    bf16_t* dst = P.WG + (size_t)n * 256 + kb * 8;
    for (int q = 0; q < 8; ++q) { const int k = kb * 8 + q; dst[q] = (k >> 6) == blk ? f2bf(w[(size_t)(k & 63) * 64]) : (bf16_t)0; }
}
HD void st_xa(const Params& P, int l, i64 i) {
    const int c8 = (int)(i & 31) * 8, row = (int)(i >> 5), seg = row_seg(row), t = row - seg_base(seg), len = seg_len(seg);
    float s[8]; ld8f(P.a_conv_b + l * 256 + c8, s);
    for (int j = 0; j < 4; ++j) { const int tt = t + j - 2; if (tt >= 0 && tt < len) { float w[8], x[8]; ld8f(P.a_conv_w + (l * 4 + j) * 256 + c8, w); ld8(P.Z + (size_t)(row + j - 2) * DIN + Z_AX + c8, x);
#pragma unroll
        for (int q = 0; q < 8; ++q) s[q] += w[q] * x[q]; } }
    st8(P.XAB + (size_t)row * 256 + c8, s);
}
HD void a_coef_elem(const Params& P, int l, int dir, float pa, float px, float xa, int ch, float& oma, float& u) {
    const float r = sigmoidf_(pa + P.a_gate_a_b[(l * 2 + dir) * 256 + ch]), ig = sigmoidf_(px + P.a_gate_x_b[(l * 2 + dir) * 256 + ch]);
    const float log_a = -8.0f * r * log1pf(expf(-P.a_lambda[(l * 2 + dir) * 256 + ch]));
    oma = -expm1f(log_a); u = sqrtf(-expm1f(2.0f * log_a)) * (ig * xa);
}
HD void st_a_coef(const Params& P, int l, i64 i) {
    const int ch = (int)(i & 255); const i64 rr = i >> 8; const int row = (int)(rr % NR), dir = (int)(rr / NR);
    const bf16_t* xa = P.XAB + (size_t)row * 256;
    const bf16_t* wa = P.WG + (size_t)((dir * 2 + (ch >> 7)) * 256 + (ch & 127)) * 256; const bf16_t* wx = wa + (size_t)128 * 256;
    float pa = 0.f, px = 0.f;
    for (int k = 0; k < 256; ++k) { const float x = bf2f(xa[k]); pa += x * bf2f(wa[k]); px += x * bf2f(wx[k]); }
    float oma, u; a_coef_elem(P, l, dir, pa, px, bf2f(xa[ch]), ch, oma, u); P.CA[i] = f2bf(oma); P.CU[i] = f2bf(u);
}
HD int scan_row(int b, int dir, int s) {
    if (s < LC) return NLAT + b * LC + (dir ? LC - 1 - s : s);
    const int t = s - LC; return b * L + (dir ? L - 1 - t : t);
}
constexpr int SB = (CL % 10 == 0) ? 10 : ((CL % 6 == 0) ? 6 : 1);
HD void st_a_scan1(const Params& P, int l, i64 i) {
    const int ch = (int)(i & 255), c = (int)((i >> 8) % NCH), bd = (int)((i >> 8) / NCH), dir = bd & 1, b = bd >> 1;
    float h = 0.f, A = 1.f;
    for (int s0 = c * CL; s0 < (c + 1) * CL; s0 += SB) { float av[SB], uv[SB];
#pragma unroll
        for (int q = 0; q < SB; ++q) { const size_t idx = ((size_t)dir * NR + scan_row(b, dir, s0 + q)) * 256 + ch; av[q] = 1.0f - bf2f(P.CA[idx]); uv[q] = bf2f(P.CU[idx]); }
#pragma unroll
        for (int q = 0; q < SB; ++q) { h = av[q] * h + uv[q]; A *= av[q]; } }
    P.CRA[i] = A; P.CRH[i] = h;
}
HD void st_a_scan2(const Params& P, int l, i64 i) {
    const int ch = (int)(i & 255), bd = (int)(i >> 8);
    float carry = 0.f;
    for (int c0 = 0; c0 < NCH; c0 += 8) { float Av[8], hv[8];
#pragma unroll
        for (int q = 0; q < 8; ++q) { const size_t k = ((size_t)bd * NCH + c0 + q) * 256 + ch; Av[q] = P.CRA[k]; hv[q] = P.CRH[k]; }
#pragma unroll
        for (int q = 0; q < 8; ++q) { const size_t k = ((size_t)bd * NCH + c0 + q) * 256 + ch; P.CRH[k] = carry; carry = Av[q] * carry + hv[q]; } }
}
HD void st_a_scan3(const Params& P, int l, i64 i) {
    const int ch = (int)(i & 255), c = (int)((i >> 8) % NCH), bd = (int)((i >> 8) / NCH), dir = bd & 1, b = bd >> 1;
    float h = 0.f;
    for (int c0 = 0; c0 < c; c0 += 8) { float Av[8], hv[8];
#pragma unroll
        for (int q = 0; q < 8; ++q) { const int cc = c0 + q < c ? c0 + q : c - 1; const size_t k = ((size_t)bd * NCH + cc) * 256 + ch; Av[q] = P.CRA[k]; hv[q] = P.CRH[k]; }
#pragma unroll
        for (int q = 0; q < 8; ++q) if (c0 + q < c) h = Av[q] * h + hv[q]; }
    for (int s0 = c * CL; s0 < (c + 1) * CL; s0 += SB) { float av[SB], uv[SB]; size_t ix[SB];
#pragma unroll
        for (int q = 0; q < SB; ++q) { ix[q] = ((size_t)dir * NR + scan_row(b, dir, s0 + q)) * 256 + ch; av[q] = 1.0f - bf2f(P.CA[ix[q]]); uv[q] = bf2f(P.CU[ix[q]]); }
#pragma unroll
        for (int q = 0; q < SB; ++q) { h = av[q] * h + uv[q]; P.CU[ix[q]] = f2bf(h); } }
}
HD void st_a_out(const Params& P, int l, i64 i) {
    const int c8 = (int)(i & 31) * 8; const size_t row = (size_t)(i >> 5);
    float h0[8], h1[8], ay[8], y[8]; ld8(P.CU + row * 256 + c8, h0); ld8(P.CU + ((size_t)NR + row) * 256 + c8, h1); ld8(P.Z + row * DIN + Z_AY + c8, ay);
#pragma unroll
    for (int q = 0; q < 8; ++q) y[q] = (h0[q] + h1[q]) * gelu_tanh_(ay[q]);
    st8(P.YM + row * D + c8, y);
}
HD void st_b_pre(const Params& P, int l, i64 i) {
    const int c8 = (int)(i & 31) * 8; const size_t row = (size_t)(i >> 5);
    float lb[8], q[8], z[8], o[8]; ld8f(P.LB + l * 256 + c8, lb); ld8(P.Z + row * DIN + Z_BQ + c8, q);
#pragma unroll
    for (int k = 0; k < 8; ++k) o[k] = siluf_(q[k]) * 0.125f;
    st8f(P.BQ + row * 256 + c8, o);
    for (int dir = 0; dir < 2; ++dir) { ld8(P.Z + row * DIN + Z_BFF + dir * 256 + c8, z);
#pragma unroll
        for (int k = 0; k < 8; ++k) o[k] = lb[k] + (1.0f - lb[k]) * sigmoidf_(z[k]);
        st8f(P.BF + ((size_t)dir * NR + row) * 256 + c8, o); }
}
HD void st_b_scan1(const Params& P, int l, i64 i) {
    const int v = (int)(i & 63); const i64 u = i >> 6; const int c = (int)(u % NCH), bdh = (int)(u / NCH), head = bdh & 3, dir = (bdh >> 2) & 1, b = bdh >> 3;
    float S[64];
#pragma unroll
    for (int k = 0; k < 64; ++k) S[k] = 0.f;
    float pr = 1.f;
    for (int s = c * CL; s < (c + 1) * CL; ++s) { const size_t row = (size_t)scan_row(b, dir, s);
        const float* f = P.BF + ((size_t)dir * NR + row) * 256 + head * 64; const float vv = bf2f(P.Z[row * DIN + Z_BI + head * 64 + v]);
        pr *= f[v];
#pragma unroll
        for (int k = 0; k < 64; ++k) S[k] = f[k] * (S[k] - vv) + vv; }
    float* sst = P.SST + (size_t)u * 4096;
#pragma unroll
    for (int k = 0; k < 64; ++k) sst[k * 64 + v] = S[k];
    P.PST[u * 64 + v] = pr;
}
template <int NCH_> HD void st_b_scan2(const Params& P, int l, i64 i) {
    constexpr int NCH = NCH_; static_assert(NCH_ % 8 == 0, "scan2 batches");
    const int kv = (int)(i & 4095), bdh = (int)(i >> 12), k = kv >> 6;
    float carry = 0.f;
    float locA[8], ppA[8], locB[8], ppB[8];
#define B2LD(LOC, PP, C0) do { _Pragma("unroll") for (int q = 0; q < 8; ++q) { const int cc = (C0) + q < NCH ? (C0) + q : NCH - 1; const size_t u = (size_t)bdh * NCH + cc; LOC[q] = P.SST[u * 4096 + kv]; PP[q] = P.PST[u * 64 + k]; } } while (0)
#define B2ST(LOC, PP, C0) do { _Pragma("unroll") for (int q = 0; q < 8; ++q) { const size_t u = (size_t)bdh * NCH + (C0) + q; P.SST[u * 4096 + kv] = carry; carry = PP[q] * carry + LOC[q]; } } while (0)
    B2LD(locA, ppA, 0);
    for (int c0 = 0; c0 < NCH; c0 += 16) {
        B2LD(locB, ppB, c0 + 8);
        B2ST(locA, ppA, c0);
        if (c0 + 8 < NCH) { B2LD(locA, ppA, c0 + 16); B2ST(locB, ppB, c0 + 8); }
    }
#undef B2LD
#undef B2ST
}
HD void st_b_scan3(const Params& P, int l, i64 i) {
    const int v = (int)(i & 63); const i64 u = i >> 6; const int c = (int)(u % NCH), bdh = (int)(u / NCH), head = bdh & 3, dir = (bdh >> 2) & 1, b = bdh >> 3;
    float S[64]; const float* sst = P.SST + (size_t)u * 4096;
#pragma unroll
    for (int k = 0; k < 64; ++k) S[k] = sst[k * 64 + v];
    for (int s = c * CL; s < (c + 1) * CL; ++s) { const size_t row = (size_t)scan_row(b, dir, s);
        const float* f = P.BF + ((size_t)dir * NR + row) * 256 + head * 64; const float* q = P.BQ + row * 256 + head * 64;
        const float vv = bf2f(P.Z[row * DIN + Z_BI + head * 64 + v]); float o = 0.f;
#pragma unroll
        for (int k = 0; k < 64; ++k) { S[k] = f[k] * (S[k] - vv) + vv; o += q[k] * S[k]; }
        P.HB[((size_t)dir * NR + row) * 256 + head * 64 + v] = f2bf(o); }
}
HD void st_b_out(const Params& P, int l, i64 i) {
    const int head = (int)(i & 3); const size_t row = (size_t)(i >> 2);
    const bf16_t* o0 = P.HB + row * 256 + head * 64; const bf16_t* o1 = P.HB + ((size_t)NR + row) * 256 + head * 64;
    float o[64]; float ss = 0.f;
#pragma unroll
    for (int g = 0; g < 8; ++g) { float a[8], b[8]; ld8(o0 + g * 8, a); ld8(o1 + g * 8, b);
#pragma unroll
        for (int q = 0; q < 8; ++q) { o[g * 8 + q] = a[q] + b[q]; ss += o[g * 8 + q] * o[g * 8 + q]; } }
    const float rstd = 1.0f / sqrtf(ss * (1.0f / 64.0f) + EPS);
#pragma unroll
    for (int g = 0; g < 8; ++g) { float w[8], gt[8], y[8]; ld8f(P.b_onorm_w + l * 64 + g * 8, w); ld8(P.Z + row * DIN + Z_BG + head * 64 + g * 8, gt);
#pragma unroll
        for (int q = 0; q < 8; ++q) y[q] = o[g * 8 + q] * rstd * w[q] * siluf_(gt[q]);
        st8(P.YM + row * D + 256 + head * 64 + g * 8, y); }
}
HD void st_qkv_prep_rh(const Params& P, int l, int row, int hs) {
    const bool lat = row < NLAT;
    int col; const float* nw = nullptr;
    if (hs < 4) col = Z_CQ + hs * 64; else if (hs < 6) col = Z_CK + (hs - 4) * 64;
    else if (hs < 10) { col = Z_DQ + (hs - 6) * 64; nw = P.d_qnorm_w + l * 64; } else { col = Z_DK + (hs - 10) * 64; nw = P.d_knorm_w + l * 64; }
    if (!lat && !nw && hs >= 4) return;
    bf16_t* p = P.Z + (size_t)row * DIN + col;
    float x[64];
#pragma unroll
    for (int g = 0; g < 8; ++g) { float t8[8]; ld8(p + g * 8, t8);
#pragma unroll
        for (int q = 0; q < 8; ++q) x[g * 8 + q] = t8[q]; }
    if (nw) { float ss = 0.f;
#pragma unroll
        for (int e = 0; e < 64; ++e) ss += x[e] * x[e];
        const float rstd = 1.0f / sqrtf(ss * (1.0f / 64.0f) + EPS);
#pragma unroll
        for (int e = 0; e < 64; ++e) x[e] = x[e] * rstd * nw[e]; }
    if (lat) { const int t = row % L, pr = t / 64, pc = t % 64;
#pragma unroll
        for (int f = 0; f < 16; ++f) {
            { const float c = P.ROPE[(pr * 16 + f) * 2], s = P.ROPE[(pr * 16 + f) * 2 + 1], x1 = x[f], x2 = x[16 + f]; x[f] = x1 * c - x2 * s; x[16 + f] = x2 * c + x1 * s; }
            { const float c = P.ROPE[(pc * 16 + f) * 2], s = P.ROPE[(pc * 16 + f) * 2 + 1], x1 = x[32 + f], x2 = x[48 + f]; x[32 + f] = x1 * c - x2 * s; x[48 + f] = x2 * c + x1 * s; } } }
    const float osc = (hs < 4 || (hs >= 6 && hs < 10)) ? QC2 : 1.0f;
#pragma unroll
    for (int g = 0; g < 8; ++g) { float t8[8];
#pragma unroll
        for (int q = 0; q < 8; ++q) t8[q] = x[g * 8 + q] * osc;
        st8(p + g * 8, t8); }
}
HD void st_qkv_prep(const Params& P, int l, i64 i) { st_qkv_prep_rh(P, l, (int)(i / 12), (int)(i % 12)); }
HD void st_qkv_prep_k(const Params& P, int l, i64 i) { const int kk = (int)(i & 3); st_qkv_prep_rh(P, l, (int)(i >> 2), kk < 2 ? 4 + kk : 8 + kk); }
template <bool LOG2> HD void attn_sweep(const float (&q)[64], const bf16_t* Z, size_t row0, int nkeys, int kcol, int vcol, float& m, float& lsum, float (&acc)[64]) {
    for (int j = 0; j < nkeys; ++j) {
        const U4* kp = (const U4*)(Z + (row0 + j) * DIN + kcol); const U4* vp = (const U4*)(Z + (row0 + j) * DIN + vcol);
        float s = 0.f;
#pragma unroll
        for (int e = 0; e < 8; ++e) { const U4 k4 = kp[e];
            s += q[8 * e] * bf_lo(k4.x) + q[8 * e + 1] * bf_hi(k4.x) + q[8 * e + 2] * bf_lo(k4.y) + q[8 * e + 3] * bf_hi(k4.y) + q[8 * e + 4] * bf_lo(k4.z) + q[8 * e + 5] * bf_hi(k4.z) + q[8 * e + 6] * bf_lo(k4.w) + q[8 * e + 7] * bf_hi(k4.w); }
        if (s > m) { const float sc = LOG2 ? exp2f(m - s) : expf(m - s); lsum *= sc;
#pragma unroll
            for (int e = 0; e < 64; ++e) acc[e] *= sc;
            m = s; }
        const float p = LOG2 ? exp2f(s - m) : expf(s - m); lsum += p;
#pragma unroll
        for (int e = 0; e < 8; ++e) { const U4 v4 = vp[e];
            acc[8 * e] += p * bf_lo(v4.x); acc[8 * e + 1] += p * bf_hi(v4.x); acc[8 * e + 2] += p * bf_lo(v4.y); acc[8 * e + 3] += p * bf_hi(v4.y);
            acc[8 * e + 4] += p * bf_lo(v4.z); acc[8 * e + 5] += p * bf_hi(v4.z); acc[8 * e + 6] += p * bf_lo(v4.w); acc[8 * e + 7] += p * bf_hi(v4.w); }
    }
}
template <int WHICH  >
HD void st_attn(const Params& P, int l, int head, int row) {
    const int kv = head >> 1;
    const int qcol = (WHICH == 0 ? Z_CQ : Z_DQ) + head * 64, kcol = (WHICH == 0 ? Z_CK : Z_DK) + kv * 64, vcol = (WHICH == 0 ? Z_CV : Z_DV) + kv * 64;
    float q[64], acc[64];
#pragma unroll
    for (int e = 0; e < 64; ++e) { q[e] = bf2f(P.Z[(size_t)row * DIN + qcol + e]); acc[e] = 0.f; }
    float m, lsum;
    if (WHICH == 0) { m = P.c_sink[l * 4 + head] * 1.4426950408889634f; lsum = 1.0f; } else { m = -INFINITY; lsum = 0.f; }
    const int seg = row_seg(row), b = seg & 1;
    attn_sweep<true>(q, P.Z, (size_t)seg_base(2 + b), LC, kcol, vcol, m, lsum, acc);
    if (row < NLAT) { const int t = row - b * L; int lo = 0, hi = L - 1;
        if (WHICH == 0) { lo = t - WINDOW < 0 ? 0 : t - WINDOW; hi = t + WINDOW > L - 1 ? L - 1 : t + WINDOW; }
        attn_sweep<true>(q, P.Z, (size_t)b * L + lo, hi - lo + 1, kcol, vcol, m, lsum, acc); }
    const float inv = 1.0f / lsum;
    bf16_t* o = P.YM + (size_t)row * D + (WHICH == 0 ? 512 : 768) + head * 64;
#pragma unroll
    for (int e = 0; e < 64; ++e) o[e] = f2bf(acc[e] * inv);
}
HD void st_outproj(const Params& P, int l, i64 i) {
    const int n = (int)(i & (D - 1)), row = (int)(i >> 10);
    const bf16_t* y = P.YM + (size_t)row * D; const bf16_t* w = P.WOUTT + (size_t)n * D;
    float s = 0.f; for (int k = 0; k < D; ++k) s += bf2f(y[k]) * bf2f(w[k]);
    xcur_row(P, row)[n] = xsrc_row(P, l, row)[n] + modv(P, l, row_who(row), 2)[n] * s;
}
HD void st_norm2(const Params& P, int l, i64 row_) {
    const int row = (int)row_; const float* x = xcur_row(P, row);
    float ss = 0.f; for (int d = 0; d < D; ++d) ss += x[d] * x[d];
    const float rstd = 1.0f / sqrtf(ss * (1.0f / D) + EPS);
    const int who = row_who(row);
    const float *sh = modv(P, l, who, 3), *sc = modv(P, l, who, 4), *w = P.norm2_w + l * D;
    bf16_t* h = P.H + (size_t)row * D;
    for (int d = 0; d < D; ++d) h[d] = f2bf(x[d] * rstd * w[d] * (1.0f + sc[d]) + sh[d]);
}
HD void st_cvt_rw(const Params& P, int l, i64 i) {
    const int kb = (int)(i & 127), n = (int)(i >> 7);
    bf16_t* dst = P.RWT + (size_t)n * D + kb * 8;
    for (int q = 0; q < 8; ++q) dst[q] = n < NE ? f2bf(P.router_w[((size_t)l * D + kb * 8 + q) * NE + n]) : (bf16_t)0;
}
HD void st_router(const Params& P, int l, i64 row_) {
    const int row = (int)row_; const bf16_t* h = P.H + (size_t)row * D;
    float lg[16];
#pragma unroll
    for (int e = 0; e < 16; ++e) { float a = 0.f; const bf16_t* w = P.RWT + (size_t)e * D; for (int d = 0; d < D; ++d) a += bf2f(h[d]) * bf2f(w[d]); lg[e] = a; }
    float mx = lg[0];
#pragma unroll
    for (int e = 1; e < 16; ++e) mx = fmaxf(mx, lg[e]);
    float sum = 0.f;
#pragma unroll
    for (int e = 0; e < 16; ++e) { lg[e] = expf(lg[e] - mx); sum += lg[e]; }
    const int seg = row_seg(row), t = row - seg_base(seg);
#pragma unroll
    for (int e = 0; e < 16; ++e) P.AFF[((size_t)seg * NE + e) * L + t] = lg[e] / sum;
}
HD unsigned f2key(float f) { union { unsigned u; float f; } c; c.f = f; return c.u; }
HD void st_topk(const Params& P, int l, i64 i) {
    const int e = (int)(i & 15), seg = (int)(i >> 4), N = seg_len(seg), cap = 2 * N / NE;
    const float* a = P.AFF + ((size_t)seg * NE + e) * L;
    unsigned lo = 0u, hi = 0x7f800001u;
    while (hi - lo > 1u) { const unsigned mid = lo + ((hi - lo) >> 1); int cnt = 0; for (int t = 0; t < N; ++t) cnt += f2key(a[t]) >= mid ? 1 : 0; if (cnt >= cap) lo = mid; else hi = mid; }
    int gt = 0; for (int t = 0; t < N; ++t) gt += f2key(a[t]) > lo ? 1 : 0;
    int ties = cap - gt, slot = (seg < 2 ? seg * CAP_L : 2 * CAP_L + (seg - 2) * CAP_C);
    const int base = seg_base(seg);
    for (int t = 0; t < N; ++t) { const unsigned k = f2key(a[t]); bool sel = k > lo; if (k == lo && ties > 0) { sel = true; --ties; }
        if (sel) { P.ROWLIST[e * SLOTS_PAD + slot] = base + t; P.GATE[e * SLOTS_PAD + slot] = a[t]; P.INV[(size_t)e * NR + base + t] = slot; ++slot; }
        else P.INV[(size_t)e * NR + base + t] = -1; }
}
HD void st_gather(const Params& P, int l, i64 i) {
    const int c = (int)(i & 127); const i64 es = i >> 7; const int ns = nslots(l), slot = (int)(es % ns), e = (int)(es / ns);
    const int row = P.ROWLIST[e * SLOTS_PAD + slot];
    const bf16_t* src = P.H + (size_t)row * D + c * 8; bf16_t* dst = P.XS + ((size_t)e * SLOTS_PAD + slot) * D + c * 8;
    *(U4*)dst = *(const U4*)src;
}
HD void st_moe1(const Params& P, int l, i64 i) {
    const int f = (int)(i & 1023); const i64 es = i >> 10; const int ns = nslots(l), slot = (int)(es % ns), e = (int)(es / ns);
    const bf16_t* h = P.H + (size_t)P.ROWLIST[e * SLOTS_PAD + slot] * D;
    const bf16_t* w1 = P.W13T + ((size_t)e * 2048 + (f >> 7) * 256 + (f & 127)) * D; const bf16_t* w3 = w1 + (size_t)128 * D;
    float a1 = 0.f, a3 = 0.f;
    for (int d = 0; d < D; ++d) { const float hv = bf2f(h[d]); a1 += hv * bf2f(w1[d]); a3 += hv * bf2f(w3[d]); }
    P.HID[((size_t)e * SLOTS_PAD + slot) * 1024 + f] = f2bf(siluf_(a1) * a3);
}
HD void st_moe2(const Params& P, int l, i64 i) {
    const int d = (int)(i & 1023); const i64 es = i >> 10; const int ns = nslots(l), slot = (int)(es % ns), e = (int)(es / ns);
    const bf16_t* hid = P.HID + ((size_t)e * SLOTS_PAD + slot) * 1024;
    const bf16_t* w2 = P.W2T + ((size_t)e * D + d) * 1024;
    float s = 0.f; for (int f = 0; f < 1024; ++f) s += bf2f(hid[f]) * bf2f(w2[f]);
    P.Y[((size_t)e * SLOTS_PAD + slot) * D + d] = f2bf(s);
}
HD void st_moe_comb(const Params& P, int l, i64 i) {
    const int d8 = (int)(i & 127) * 8, row = (int)(i >> 7);
    float acc[8];
#pragma unroll
    for (int q = 0; q < 8; ++q) acc[q] = 0.f;
    for (int e = 0; e < NE; ++e) { const int s = P.INV[(size_t)e * NR + row]; if (s >= 0) { const float g = P.GATE[e * SLOTS_PAD + s]; float y[8]; ld8(P.Y + ((size_t)e * SLOTS_PAD + s) * D + d8, y);
#pragma unroll
        for (int q = 0; q < 8; ++q) acc[q] += g * y[q]; } }
    float x[8], m[8]; float* xp = xcur_row(P, row) + d8; ld8f(xp, x); ld8f(modv(P, l, row_who(row), 5) + d8, m);
#pragma unroll
    for (int q = 0; q < 8; ++q) x[q] += m[q] * acc[q];
    st8f(xp, x);
}
HD void st_final(const Params& P, i64 row) {
    float* x = P.out + (size_t)row * D;
    float ss = 0.f; for (int d = 0; d < D; ++d) ss += x[d] * x[d];
    const float rstd = 1.0f / sqrtf(ss * (1.0f / D) + EPS);
    for (int d = 0; d < D; ++d) x[d] = x[d] * rstd * P.final_norm_w[d];
}

template <int LYR, class E> HD void layer_body(E& ex) {
    constexpr int l = LYR;
        const int nro = nrows_out(l);
        ex.run((i64)(D / 16) * (DIN / 4), [&](const Params& P, i64 i) { st_cvt_win(P, l, i); });
        ex.run((i64)(D / 16) * (D / 4), [&](const Params& P, i64 i) { st_cvt_wout(P, l, i); });
        ex.run((i64)1024 * 32, [&](const Params& P, i64 i) { st_cvt_wg(P, l, i); });
        ex.run((i64)256 * 128, [&](const Params& P, i64 i) { st_cvt_rw(P, l, i); });
        if (l == 0) ex.sync();
        ex.norm1(l); ex.sync();
        constexpr i64 n13 = (i64)NE * 2 * 16384, n2 = (i64)NE * 16384, NTC = n13 + n2, A1 = 162816, A2 = (l == 0) ? 380928 : 0;
        auto cvt_any = [&](const Params& P, i64 i) { if (i < n13) st_cvt_w13(P, l, i); else st_cvt_w2(P, l, i - n13); };
        ex.inproj(l); ex.run_from(150, A1, [&](const Params& P, i64 i) { cvt_any(P, i); }); ex.sync();
        ex.run((i64)NR * 32, [&](const Params& P, i64 i) { st_xa(P, l, i); });
        ex.qkv_prep(l);
        ex.b_pre(l); ex.sync();
        ex.a_coef(l); ex.b_scan(l, 1); ex.sync();
        if (l == 0) ex.run_skipctx((i64)2 * 2 * NCH * 256, [&](const Params& P, i64 i) { st_a_scan1(P, l, i); });
        else ex.run((i64)2 * 2 * NCH * 256, [&](const Params& P, i64 i) { st_a_scan1(P, l, i); });
        ex.b_scan(l, 2);
        ex.attn_win(l); ex.attn_dense(l); ex.sync();
        ex.run((i64)2 * 2 * NCH * 256, [&](const Params& P, i64 i) { st_a_scan3(P, l, i); });
        ex.b_scan(l, 3); ex.sync();
        ex.run((i64)nro * 32, [&](const Params& P, i64 i) { st_a_out(P, l, i); });
        ex.run((i64)nro * 4, [&](const Params& P, i64 i) { st_b_out(P, l, i); }); ex.sync();
        ex.outproj(l); if (l == 0) ex.run_from(8, A2, [&](const Params& P, i64 i) { cvt_any(P, A1 + i); }); ex.sync();
        ex.norm2(l);
        ex.run((i64)NE * SLOTS_PAD, [&](const Params& P, i64 i) { P.ROWLIST[i] = 0; }); ex.sync();
        constexpr i64 AR = 129024;
        ex.router(l); ex.run_from(130, AR, [&](const Params& P, i64 i) { cvt_any(P, A1 + A2 + i); }); ex.sync();
        ex.topk(l);
        { constexpr i64 B0 = A1 + A2 + AR, rest = NTC - B0, cap = ((NTC * 21 / 100) & ~(i64)63), A3 = rest < cap ? rest : cap; const int b0 = (l == 0 ? 4 : 2) * 16;
          ex.run_from(b0, A3, [&](const Params& P, i64 i) { cvt_any(P, B0 + i); });
          ex.run(rest - A3, [&](const Params& P, i64 i) { cvt_any(P, B0 + A3 + i); }); }
        ex.sync();
        ex.moe1(l); ex.sync();
        ex.moe2(l); ex.sync();
        ex.comb(l); ex.sync_soft();
}
template <class E> HD void pipeline(E& ex) {
    {
    ex.mod();
    ex.run(256, [&](const Params& P, i64 i) { st_lb(P, i); });
    ex.run(2, [&](const Params& P, i64 i) { st_flags(P, i); });
    ex.run(2 * 2 * 256, [&](const Params& P, i64 i) { st_sp8(P, i); });
    ex.run(256 * 16, [&](const Params& P, i64 i) { st_rope(P, i); });
    }
    layer_body<0>(ex);
    layer_body<1>(ex);
    ex.final_norm();
}
template <class E> HD void naive_inproj(int l, E& ex) { ex.run((i64)NR * DIN, [&](const Params& P, i64 i) { st_inproj(P, l, i); }); }
template <class E> HD void naive_outproj(int l, E& ex) { ex.run((i64)nrows_out(l) * D, [&](const Params& P, i64 i) { st_outproj(P, l, i); }); }
template <class E> HD void naive_moe1(int l, E& ex) { ex.run((i64)NE * nslots(l) * 1024, [&](const Params& P, i64 i) { st_moe1(P, l, i); }); }
template <class E> HD void naive_attn_win(int l, E& ex, int row0, int nrows) { ex.run((i64)4 * nrows, [&](const Params& P, i64 i) { st_attn<0>(P, l, (int)(i / nrows), row0 + (int)(i % nrows)); }); }
template <class E> HD void naive_attn_dense(int l, E& ex, int row0, int nrows) { ex.run((i64)4 * nrows, [&](const Params& P, i64 i) { st_attn<1>(P, l, (int)(i / nrows), row0 + (int)(i % nrows)); }); }
template <class E> HD void naive_qkv_prep(int l, E& ex) { ex.run((i64)NR * 12, [&](const Params& P, i64 i) { st_qkv_prep(P, l, i); }); }
template <class E> HD void naive_b_pre(int l, E& ex) { ex.run((i64)NR * 32, [&](const Params& P, i64 i) { st_b_pre(P, l, i); }); }
template <class E> HD void naive_b_scan(int l, int ph, E& ex) { if (ph == 2) ex.run((i64)2 * 2 * 4 * 4096, [&](const Params& P, i64 i) { st_b_scan2<NCH>(P, l, i); }); else if (ph == 1) ex.run((i64)2 * 2 * 4 * NCH * 64, [&](const Params& P, i64 i) { st_b_scan1(P, l, i); }); else ex.run((i64)2 * 2 * 4 * NCH * 64, [&](const Params& P, i64 i) { st_b_scan3(P, l, i); }); }
template <class E> HD void naive_a_coef(int l, E& ex) { ex.run((i64)2 * NR * 256, [&](const Params& P, i64 i) { st_a_coef(P, l, i); }); }
template <class E> HD void naive_comb(int l, E& ex) { ex.run((i64)nrows_out(l) * 128, [&](const Params& P, i64 i) { st_moe_comb(P, l, i); }); }
template <class E> HD void naive_mod(E& ex) { ex.run((i64)2 * 3 * 6 * D, [&](const Params& P, i64 i) { st_mod(P, i); }); }
template <class E> HD void naive_norm1(int l, E& ex) { ex.run(NR, [&](const Params& P, i64 i) { st_norm1(P, l, i); }); }
template <class E> HD void naive_norm2(int l, E& ex) { ex.run(nrows_out(l), [&](const Params& P, i64 i) { st_norm2(P, l, i); }); }
template <class E> HD void naive_router(int l, E& ex) { ex.run(nrows_out(l), [&](const Params& P, i64 i) { st_router(P, l, i); }); }
template <class E> HD void naive_topk(int l, E& ex) { ex.run((l == 0 ? 4 : 2) * 16, [&](const Params& P, i64 i) { st_topk(P, l, i); }); }
template <class E> HD void naive_final(E& ex) { ex.run(NLAT, [&](const Params& P, i64 i) { st_final(P, i); }); }
template <class E> HD void naive_moe2(int l, E& ex) { ex.run((i64)NE * nslots(l) * 1024, [&](const Params& P, i64 i) { st_moe2(P, l, i); }); }

#ifndef CPU_TEST
__device__ __forceinline__ int lane_id() { int l; asm volatile("v_mbcnt_lo_u32_b32 %0, -1, 0\n\tv_mbcnt_hi_u32_b32 %0, -1, %0" : "=v"(l)); return l; }
__device__ __forceinline__ int grid_dim() { int g = (int)gridDim.x; asm volatile("" : "+s"(g)); return g; }
__device__ __forceinline__ int block_id() { int b = (int)blockIdx.x; asm volatile("" : "+s"(b)); return b; }
#define XB_TMO      128
#define XB_XCNT(j)  (256  + 64 * (j))
#define XB_XSUB(j)  (1280 + 64 * (j))
#define XB_XGEN(j)  (2304 + 64 * (j))
#define XB_TOP      3328
#define XB_TOPGEN   3392
#define XCD_BAR_WORDS 3456
#define XB_SPIN_CAP (1u << 27)
#define LAS __attribute__((address_space(3)))

__device__ __forceinline__ unsigned xb_ld(unsigned* p)              { return __hip_atomic_load(p, __ATOMIC_RELAXED, __HIP_MEMORY_SCOPE_AGENT); }
__device__ __forceinline__ unsigned xb_add(unsigned* p, unsigned v) { return __hip_atomic_fetch_add(p, v, __ATOMIC_RELAXED, __HIP_MEMORY_SCOPE_AGENT); }
__device__ __forceinline__ unsigned xb_xcc_id() { return (unsigned)__builtin_amdgcn_s_getreg((3 << 11) | 20) & 0xFu; }
#define XB_SPIN(cond, bar) do { unsigned _sp = 0; while (cond) { __builtin_amdgcn_s_sleep(1); \
    if ((++_sp & 255u) == 0u) { if (xb_ld(&(bar)[XB_TMO])) break; if (_sp > XB_SPIN_CAP) { atomicAdd(&(bar)[XB_TMO], 1u); break; } } } } while (0)

struct XcdBarrier { unsigned* bar; unsigned x; volatile LAS unsigned* st; };

__device__ __forceinline__ XcdBarrier xcd_barrier_post(unsigned* bar, volatile LAS unsigned* st, bool leader) {
    XcdBarrier b; b.bar = bar; b.x = xb_xcc_id(); b.st = st;
    if (leader) (void)xb_add(&bar[XB_XCNT(b.x)], 1u);
    return b;
}
__device__ __forceinline__ void xcd_barrier_complete(unsigned* bar, unsigned x, unsigned& nloc, unsigned& nx) {
    const unsigned G = gridDim.x * gridDim.y * gridDim.z;
    unsigned sum, cnt, mine, sp = 0u;
    for (;;) {
        sum = 0u; cnt = 0u; mine = 0u;
#pragma unroll
        for (unsigned j = 0; j < 16; ++j) { const unsigned c = xb_ld(&bar[XB_XCNT(j)]); sum += c; cnt += (c > 0u) ? 1u : 0u; mine = (j == x) ? c : mine; }
        if (sum == G) break;
        __builtin_amdgcn_s_sleep(1);
        if ((++sp & 255u) == 0u) { if (xb_ld(&bar[XB_TMO])) break; if (sp > XB_SPIN_CAP) { atomicAdd(&bar[XB_TMO], 1u); break; } }
    }
    nloc = mine > 0u ? mine : 1u; nx = cnt > 0u ? cnt : 1u;
}
__device__ __forceinline__ void xcd_barrier(const XcdBarrier& b, bool leader) {
    asm volatile("s_waitcnt vmcnt(0)" ::: "memory");
    __syncthreads();
    if (leader) {
        unsigned* bar = b.bar;
        __builtin_amdgcn_s_waitcnt(0);
        unsigned nloc = b.st[0], nx = b.st[1];
        if (nloc == 0u) { xcd_barrier_complete(bar, b.x, nloc, nx); b.st[0] = nloc; b.st[1] = nx; }
        const unsigned old = xb_add(&bar[XB_XSUB(b.x)], 1u);
        const unsigned gen = old / nloc;
        if (old + 1u == (gen + 1u) * nloc) {
            __builtin_amdgcn_fence(__ATOMIC_RELEASE, "agent");
            asm volatile("s_waitcnt vmcnt(0)" ::: "memory");
            const unsigned og = xb_add(&bar[XB_TOP], 1u);
            const unsigned tg = og / nx;
            if (og + 1u == (tg + 1u) * nx) xb_add(&bar[XB_TOPGEN], 1u);
            else XB_SPIN(xb_ld(&bar[XB_TOPGEN]) == tg, bar);
            __builtin_amdgcn_fence(__ATOMIC_ACQUIRE, "agent");
            xb_add(&bar[XB_XGEN(b.x)], 1u);
            asm volatile("s_waitcnt vmcnt(0)" ::: "memory");
        } else {
            XB_SPIN(xb_ld(&bar[XB_XGEN(b.x)]) == gen, bar);
            __builtin_amdgcn_fence(__ATOMIC_ACQUIRE, "agent");
            asm volatile("s_waitcnt vmcnt(0)" ::: "memory");
        }
    }
    __syncthreads();
}

namespace pg8 {
#define PG8_LAS __attribute__((address_space(3)))
typedef unsigned short bf16_t;
typedef short bf16x8 __attribute__((ext_vector_type(8)));
typedef float f32x4 __attribute__((ext_vector_type(4)));
typedef unsigned u32x4 __attribute__((ext_vector_type(4)));
constexpr int BM = 256, BK = 64, HALF = 128, HTB = HALF * BK * 2  , STAGE_BYTES = 8 * HTB, NXCD = 8, WGM = 8;

__host__ __device__ __forceinline__ int lds_byte(int r, int c) { const int st = (r >> 4) * 2 + (c >> 5), rr = r & 15, cc = c & 31, ob = rr * 64 + cc * 2; return st * 1024 + (ob ^ (((ob >> 9) & 1) << 5)); }
__host__ __device__ __forceinline__ void stage_rc(int b, int& R, int& C) { const int st = b / 1024, sb = b % 1024, swz = sb ^ (((sb >> 9) & 1) << 5); R = (st >> 1) * 16 + swz / 64; C = (st & 1) * 32 + (swz % 64) / 2; }
__host__ __device__ __forceinline__ int perm32(int rho) { const int n = rho >> 4, i = rho & 15; return 8 * (i >> 2) + 4 * n + (i & 3); }

struct Unit { int pm, pn; };
struct Gemm { const bf16_t* A; const bf16_t* Bt; int M, N, K; };

struct StaticOrder {
    int nM, nN, nwg, G, c;
    __host__ __device__ void init(int M, int N, int G_, int c_) { nM = M / BM; nN = N / BM; nwg = nM * nN; G = G_; c = c_; }
    __host__ __device__ bool next(int i, Unit& u) const {
        const long L = (long)i * G + c; if (L >= nwg) return false;
        int wgid = (int)L; { const int q = nwg / NXCD, r = nwg % NXCD, xcd = wgid % NXCD, off = wgid / NXCD; wgid = (xcd < r ? xcd * (q + 1) : r * (q + 1) + (xcd - r) * q) + off; }
        const int nig = WGM * nN, gid = wgid / nig, fm = gid * WGM, gsz = (nM - fm) < WGM ? (nM - fm) : WGM;
        u.pm = fm + ((wgid % nig) % gsz); u.pn = (wgid % nig) / gsz; return true;
    }
    __device__ __forceinline__ void a_ready(const Unit&) const {}
    __device__ __forceinline__ void done(const Unit&) const {}
};
__device__ __forceinline__ unsigned cvt_pk_bf16(float lo, float hi) { unsigned r; asm volatile("v_cvt_pk_bf16_f32 %0, %1, %2" : "=v"(r) : "v"(lo), "v"(hi)); return r; }
typedef float f32x2 __attribute__((ext_vector_type(2)));
template <class Epi, class Sched, bool STAMP = false, bool GATHER = false, bool HALFU = false>
__device__ __forceinline__ void gemm_phase(PG8_LAS unsigned char* lds, const Gemm g, const Sched& S, const Epi& E, unsigned long long* stamps, int wv, const int* rowlist = nullptr) {
    int tid_ = wv * 64 + lane_id(); asm volatile("" : "+v"(tid_));
    const int tid = tid_, wid = __builtin_amdgcn_readfirstlane(tid >> 6), lane = tid & 63, wr = wid >> 2, wc = wid & 3, fr = lane & 15, fq = lane >> 4;
    const int K = g.K, nt = K / BK;
    int ts_lo = 0, ts_hi = 0, nts = 0; const unsigned long long rt_entry = STAMP ? (unsigned long long)wall_clock64() : 0ull;
#define PG8_STAMP() do { if (STAMP && wid == 0 && nts < 64) { const unsigned long long _c = (unsigned long long)clock64(); \
        ts_lo = (lane == nts) ? (int)(unsigned)_c : ts_lo; ts_hi = (lane == nts) ? (int)(unsigned)(_c >> 32) : ts_hi; ++nts; } } while (0)
    PG8_STAMP();
    unsigned voffA[2], voffB[2]; int RA[2]; unsigned CBy[2];
#pragma unroll
    for (int i = 0; i < 2; ++i) { int R, C; stage_rc(tid * 16 + i * 8192, R, C); const int Rb = Epi::PERM ? ((R & ~31) + perm32(R & 31)) : R;
        voffA[i] = (unsigned)(R * K + C) * 2u; voffB[i] = (unsigned)(Rb * K + C) * 2u; RA[i] = R; CBy[i] = (unsigned)C * 2u; }
    unsigned goff[2][2] = {{0u, 0u}, {0u, 0u}}, noff[2][2] = {{0u, 0u}, {0u, 0u}};
#define PG8_LOADOFF(dst, U) do { if (GATHER) { _Pragma("unroll") for (int h_ = 0; h_ < 2; ++h_) _Pragma("unroll") for (int i_ = 0; i_ < 2; ++i_) \
        dst[h_][i_] = (unsigned)rowlist[(U).pm * BM + h_ * HALF + RA[i_]] * (unsigned)(K * 2) + CBy[i_]; } } while (0)
#define PG8_STAGE_A(bufoff, base, h, nx) do { if (GATHER) { const unsigned so_[2] = {(nx) ? noff[h][0] : goff[h][0], (nx) ? noff[h][1] : goff[h][1]}; PG8_STAGE(bufoff, base, so_); } \
        else PG8_STAGE(bufoff, (base) + ((h) ? hstep : 0), voffA); } while (0)
    const size_t kstep = (size_t)(BK * 2);
    const size_t hstep = (size_t)HALF * K * 2;
    const size_t tstep = 2 * hstep;
    const unsigned ldsw = (unsigned)wid * 1024u;
    const int aoff = lds_byte(wr * 64 + fr, fq * 8), boff = lds_byte(wc * 32 + fr, fq * 8);
#define PG8_SA(b, h) (((b) * 2 + (h)) * HTB)
#define PG8_SB(b, h) ((4 + (b) * 2 + (h)) * HTB)
#define PG8_STAGE(bufoff, gbase, voff) do { _Pragma("unroll") for (int _i = 0; _i < 2; ++_i) \
        __builtin_amdgcn_global_load_lds((const unsigned*)((const char*)(gbase) + (voff)[_i]), (PG8_LAS unsigned*)(lds + (bufoff) + ldsw + _i * 8192), 16, 0, 0); } while (0)
#define PG8_LDA(dst, b, h) do { _Pragma("unroll") for (int m = 0; m < 4; ++m) _Pragma("unroll") for (int k = 0; k < 2; ++k) dst[m][k] = *(const PG8_LAS bf16x8*)(lds + PG8_SA(b, h) + aoff + m * 2048 + k * 1024); } while (0)
#define PG8_LDB(dst, b, h) do { _Pragma("unroll") for (int n = 0; n < 2; ++n) _Pragma("unroll") for (int k = 0; k < 2; ++k) dst[n][k] = *(const PG8_LAS bf16x8*)(lds + PG8_SB(b, h) + boff + n * 2048 + k * 1024); } while (0)
#define PG8_MMA(ai, bj, At, Bt) do { __builtin_amdgcn_s_setprio(1); _Pragma("unroll") for (int m = 0; m < 4; ++m) _Pragma("unroll") for (int n = 0; n < 2; ++n) _Pragma("unroll") for (int k = 0; k < 2; ++k) \
        acc[ai][bj][m][n] = __builtin_amdgcn_mfma_f32_16x16x32_bf16(Bt[n][k], At[m][k], acc[ai][bj][m][n], 0, 0, 0); __builtin_amdgcn_s_setprio(0); } while (0)
#define PG8_WAIT_V(n) asm volatile("s_waitcnt vmcnt(" #n ")" ::: "memory")
#define PG8_WAIT_L(n) asm volatile("s_waitcnt lgkmcnt(" #n ")" ::: "memory")
#define PG8_BAR __builtin_amdgcn_s_barrier()
#define PG8_SCHED __builtin_amdgcn_sched_barrier(0)
    Unit cur, nxt; int ui = 0;
    if (!S.next(0, cur)) return;
    f32x4 acc[2][2][4][2];
#pragma unroll
    for (int a = 0; a < 2; ++a)
#pragma unroll
        for (int b = 0; b < 2; ++b)
#pragma unroll
            for (int m = 0; m < 4; ++m)
#pragma unroll
                for (int n = 0; n < 2; ++n) acc[a][b][m][n] = (f32x4){0.f, 0.f, 0.f, 0.f};
    bf16x8 At[4][2], B0[2][2], B1[2][2];
    const char* cA = (const char*)g.A + (GATHER ? (size_t)0 : (size_t)cur.pm * tstep); const char* cB = (const char*)g.Bt + (size_t)cur.pn * tstep;
    PG8_LOADOFF(goff, cur);
    S.a_ready(cur);
    PG8_STAGE(PG8_SB(0, 0), cB, voffB); PG8_STAGE_A(PG8_SA(0, 0), cA, 0, false); PG8_STAGE(PG8_SB(0, 1), cB + hstep, voffB); PG8_STAGE_A(PG8_SA(0, 1), cA, 1, false);
    if (wr == 1) PG8_BAR;
    PG8_WAIT_V(4); PG8_BAR;
    PG8_STAGE(PG8_SB(1, 0), cB + kstep, voffB); PG8_STAGE_A(PG8_SA(1, 0), cA + kstep, 0, false); PG8_STAGE(PG8_SB(1, 1), cB + hstep + kstep, voffB);
    PG8_WAIT_V(6); PG8_BAR;
    PG8_STAMP();
    for (;;) {
        const bool has_next = S.next(ui + 1, nxt);
        bool hu = false; if constexpr (HALFU) hu = S.is_half(cur);
        const char* nA = (has_next && !GATHER) ? (const char*)g.A + (size_t)nxt.pm * tstep : cA; const char* nB = has_next ? (const char*)g.Bt + (size_t)nxt.pn * tstep : cB;
        if (GATHER) { if (has_next) PG8_LOADOFF(noff, nxt); else { noff[0][0] = goff[0][0]; noff[0][1] = goff[0][1]; noff[1][0] = goff[1][0]; noff[1][1] = goff[1][1]; } }
        for (int t = 0; t < nt; t += 2) {
            const bool last = (t == nt - 2);
            const char* a1 = cA + (size_t)(t + 1) * kstep;
            const char* a2 = last ? nA : cA + (size_t)(t + 2) * kstep; const char* b2 = last ? nB : cB + (size_t)(t + 2) * kstep;
            const char* a3 = a2 + kstep; const char* b3 = b2 + kstep;
            if (last && has_next) S.a_ready(nxt);
            PG8_LDB(B0, 0, 0); PG8_SCHED; PG8_LDA(At, 0, 0); PG8_STAGE_A(PG8_SA(1, 1), a1, 1, false);
            PG8_WAIT_L(8); PG8_BAR; PG8_WAIT_L(0); PG8_MMA(0, 0, At, B0); PG8_BAR; PG8_SCHED;
            PG8_LDB(B1, 0, 1); PG8_STAGE(PG8_SB(0, 0), b2, voffB);
            PG8_BAR; PG8_WAIT_L(0); PG8_MMA(0, 1, At, B1); PG8_BAR;
            if (!hu) PG8_LDA(At, 0, 1); PG8_STAGE_A(PG8_SA(0, 0), a2, 0, last);
            PG8_BAR; PG8_WAIT_L(0); if (!hu) PG8_MMA(1, 0, At, B0); PG8_BAR; PG8_SCHED;
            PG8_STAGE(PG8_SB(0, 1), b2 + hstep, voffB);
            PG8_WAIT_V(6); PG8_BAR; if (!hu) PG8_MMA(1, 1, At, B1); PG8_BAR;
            PG8_LDB(B0, 1, 0); PG8_SCHED; PG8_LDA(At, 1, 0); PG8_STAGE_A(PG8_SA(0, 1), a2, 1, last);
            PG8_WAIT_L(8); PG8_BAR; PG8_WAIT_L(0); PG8_MMA(0, 0, At, B0); PG8_BAR; PG8_SCHED;
            PG8_LDB(B1, 1, 1); PG8_STAGE(PG8_SB(1, 0), b3, voffB);
            PG8_BAR; PG8_WAIT_L(0); PG8_MMA(0, 1, At, B1); PG8_BAR;
            if (!hu) PG8_LDA(At, 1, 1); PG8_STAGE_A(PG8_SA(1, 0), a3, 0, last);
            PG8_BAR; PG8_WAIT_L(0); if (!hu) PG8_MMA(1, 0, At, B0); PG8_BAR; PG8_SCHED;
            PG8_STAGE(PG8_SB(1, 1), b3 + hstep, voffB);
            PG8_WAIT_V(6); PG8_BAR; if (!hu) PG8_MMA(1, 1, At, B1); PG8_BAR;
        }
        PG8_STAMP();
        if constexpr (!Epi::AFTER_DRAIN) { E(acc, cur, wr, wc, fr, fq); S.done(cur); }
        PG8_STAMP();
        if (!has_next) break;
#pragma unroll
        for (int a = 0; a < 2; ++a)
#pragma unroll
            for (int b = 0; b < 2; ++b)
#pragma unroll
                for (int m = 0; m < 4; ++m)
#pragma unroll
                    for (int n = 0; n < 2; ++n) acc[a][b][m][n] = (f32x4){0.f, 0.f, 0.f, 0.f};
        cur = nxt; cA = nA; cB = nB; ++ui;
        if (GATHER) { goff[0][0] = noff[0][0]; goff[0][1] = noff[0][1]; goff[1][0] = noff[1][0]; goff[1][1] = noff[1][1]; }
    }
    PG8_WAIT_V(0);
    if (wr == 0) PG8_BAR;
    PG8_BAR;
    if constexpr (Epi::AFTER_DRAIN) { E.fused(acc, cur, wr, wc, fr, fq, lds, wid, lane); S.done(cur); }
    PG8_STAMP();
    if (STAMP && wid == 0) { stamps[lane] = lane < nts ? (((unsigned long long)(unsigned)ts_hi << 32) | (unsigned)ts_lo) : 0ull;
        if (lane == 62) stamps[62] = rt_entry; if (lane == 63) stamps[63] = (unsigned long long)wall_clock64(); }
#undef PG8_STAMP
#undef PG8_SA
#undef PG8_SB
#undef PG8_STAGE
#undef PG8_STAGE_A
#undef PG8_LOADOFF
#undef PG8_LDA
#undef PG8_LDB
#undef PG8_MMA
#undef PG8_WAIT_V
#undef PG8_WAIT_L
#undef PG8_BAR
#undef PG8_SCHED
}
}

namespace pg8 {
constexpr int TPE = SLOTS_PAD / 256;
struct EpiZ {
    static constexpr bool PERM = true, AFTER_DRAIN = false;
    bf16_t* O; int ldc;
    __device__ __forceinline__ void operator()(const f32x4 (&acc)[2][2][4][2], const Unit& u, int wr, int wc, int fr, int fq) const {
        const int row0 = u.pm * BM + wr * 64 + fr, col0 = u.pn * BM + wc * 32 + 8 * fq;
#pragma unroll
        for (int ai = 0; ai < 2; ++ai)
#pragma unroll
            for (int m = 0; m < 4; ++m) { bf16_t* rowp = O + (size_t)(row0 + ai * HALF + m * 16) * ldc + col0;
#pragma unroll
                for (int bj = 0; bj < 2; ++bj) { const f32x4 v0 = acc[ai][bj][m][0], v1 = acc[ai][bj][m][1];
                    u32x4 w; w.x = cvt_pk_bf16(v0[0], v0[1]); w.y = cvt_pk_bf16(v0[2], v0[3]); w.z = cvt_pk_bf16(v1[0], v1[1]); w.w = cvt_pk_bf16(v1[2], v1[3]);
                    *(u32x4*)(rowp + bj * HALF) = w; } }
    }
};
template <bool SRC16> struct EpiOut {
    static constexpr bool PERM = true, AFTER_DRAIN = false;
    const float* src_lat; const float* src_ctx; const bf16_t* srcb; bf16_t* dst; const float* mod;
    __device__ __forceinline__ void operator()(const f32x4 (&acc)[2][2][4][2], const Unit& u, int wr, int wc, int fr, int fq) const {
        const bool lat = u.pm < NLAT / BM; const int who = lat ? u.pm / (L / BM) : 2;
        const int row0 = u.pm * BM + wr * 64 + fr, col0 = u.pn * BM + wc * 32 + 8 * fq;
        const float* mv = mod + (size_t)(who * 6 + 2) * D;
        f32x4 m4[2][2];
#pragma unroll
        for (int bj = 0; bj < 2; ++bj)
#pragma unroll
            for (int n = 0; n < 2; ++n) m4[bj][n] = *(const f32x4*)(mv + col0 + bj * HALF + n * 4);
#pragma unroll
        for (int ai = 0; ai < 2; ++ai)
#pragma unroll
            for (int m = 0; m < 4; ++m) { const size_t grow = (size_t)(row0 + ai * HALF + m * 16);
#pragma unroll
                for (int bj = 0; bj < 2; ++bj) { const int c = col0 + bj * HALF; f32x4 x0, x1;
                    if (SRC16) { const u32x4 w = *(const u32x4*)(srcb + grow * D + c); x0 = (f32x4){bf_lo(w.x), bf_hi(w.x), bf_lo(w.y), bf_hi(w.y)}; x1 = (f32x4){bf_lo(w.z), bf_hi(w.z), bf_lo(w.w), bf_hi(w.w)}; }
                    else { const float* sp = (lat ? src_lat + grow * D : src_ctx + (grow - NLAT) * D) + c; x0 = __builtin_nontemporal_load((const f32x4*)sp); x1 = __builtin_nontemporal_load((const f32x4*)(sp + 4)); }
                    const f32x4 y0 = x0 + m4[bj][0] * acc[ai][bj][m][0], y1 = x1 + m4[bj][1] * acc[ai][bj][m][1];
                    u32x4 o; o.x = cvt_pk_bf16(y0[0], y0[1]); o.y = cvt_pk_bf16(y0[2], y0[3]); o.z = cvt_pk_bf16(y1[0], y1[1]); o.w = cvt_pk_bf16(y1[2], y1[3]);
                    *(u32x4*)(dst + grow * D + c) = o; } }
    }
};
__device__ __forceinline__ float silu_fast(float x) { return x * __builtin_amdgcn_rcpf(1.0f + __expf(-x)); }
struct EpiHid {
    static constexpr bool PERM = true, AFTER_DRAIN = false;
    bf16_t* O;
    __device__ __forceinline__ void operator()(const f32x4 (&acc)[2][2][4][2], const Unit& u, int wr, int wc, int fr, int fq) const {
        const int row0 = u.pm * BM + wr * 64 + fr, col0 = (u.pn & 7) * 128 + wc * 32 + 8 * fq;
#pragma unroll
        for (int ai = 0; ai < 2; ++ai)
#pragma unroll
            for (int m = 0; m < 4; ++m) { float h[8];
#pragma unroll
                for (int n = 0; n < 2; ++n)
#pragma unroll
                    for (int j = 0; j < 4; ++j) h[n * 4 + j] = silu_fast(acc[ai][0][m][n][j]) * acc[ai][1][m][n][j];
                u32x4 w; w.x = cvt_pk_bf16(h[0], h[1]); w.y = cvt_pk_bf16(h[2], h[3]); w.z = cvt_pk_bf16(h[4], h[5]); w.w = cvt_pk_bf16(h[6], h[7]);
                *(u32x4*)(O + (size_t)(row0 + ai * HALF + m * 16) * 1024 + col0) = w; }
    }
};
struct EpiY {
    static constexpr bool PERM = true, AFTER_DRAIN = false;
    bf16_t* O;
    __device__ __forceinline__ void operator()(const f32x4 (&acc)[2][2][4][2], const Unit& u, int wr, int wc, int fr, int fq) const {
        const int row0 = u.pm * BM + wr * 64 + fr, col0 = (u.pn & 3) * BM + wc * 32 + 8 * fq;
#pragma unroll
        for (int ai = 0; ai < 2; ++ai)
#pragma unroll
            for (int m = 0; m < 4; ++m) { bf16_t* rowp = O + (size_t)(row0 + ai * HALF + m * 16) * D + col0;
#pragma unroll
                for (int bj = 0; bj < 2; ++bj) { const f32x4 v0 = acc[ai][bj][m][0], v1 = acc[ai][bj][m][1];
                    u32x4 w; w.x = cvt_pk_bf16(v0[0], v0[1]); w.y = cvt_pk_bf16(v0[2], v0[3]); w.z = cvt_pk_bf16(v1[0], v1[1]); w.w = cvt_pk_bf16(v1[2], v1[3]);
                    *(u32x4*)(rowp + bj * HALF) = w; } }
    }
};
struct EpiCoef {
    static constexpr bool PERM = true, AFTER_DRAIN = false;
    const Params* P; int l;
    __device__ __forceinline__ void operator()(const f32x4 (&acc)[2][2][4][2], const Unit& u, int wr, int wc, int fr_, int fq_) const {
        int fr = fr_, fq = fq_; asm volatile("" : "+v"(fr), "+v"(fq));
        const int dir = u.pn >> 1, ch0 = (u.pn & 1) * 128 + wc * 32 + 8 * fq, row0 = u.pm * BM + wr * 64 + fr;
        const float* gb = P->a_gate_a_b + (l * 2 + dir) * 256 + ch0; const float* gx = P->a_gate_x_b + (l * 2 + dir) * 256 + ch0; const float* gs = P->SP8 + (l * 2 + dir) * 256 + ch0;
        bool small = true;
#pragma unroll
        for (int q = 0; q < 8; ++q) small = small && (gs[q] >= -0.5f);
        const bool poly = __all(small);
#pragma unroll
        for (int ai = 0; ai < 2; ++ai)
#pragma unroll
            for (int m = 0; m < 4; ++m) { const size_t row = (size_t)(row0 + ai * HALF + m * 16);
                const u32x4 xw = *(const u32x4*)(P->XAB + row * 256 + ch0); const unsigned xr[4] = {xw.x, xw.y, xw.z, xw.w};
                float om8[8], u8[8];
#pragma unroll
                for (int n = 0; n < 2; ++n)
#pragma unroll
                    for (int j = 0; j < 4; ++j) { const int q = n * 4 + j; const float xa = (q & 1) ? bf_hi(xr[q >> 1]) : bf_lo(xr[q >> 1]);
                        const float r = __builtin_amdgcn_rcpf(1.0f + __expf(-(acc[ai][0][m][n][j] + gb[q]))), ig = __builtin_amdgcn_rcpf(1.0f + __expf(-(acc[ai][1][m][n][j] + gx[q])));
                        const float y = r * gs[q];
                        float oma = -y * (1.0f + y * (0.5f + y * (0.16666667f + y * (0.041666667f + y * 0.0083333333f))));
                        if (!poly) oma = y > -0.5f ? oma : 1.0f - __expf(y);
                        om8[q] = oma; u8[q] = sqrtf(oma * (2.0f - oma)) * (ig * xa); }
                u32x4 wa, wu; wa.x = cvt_pk_bf16(om8[0], om8[1]); wa.y = cvt_pk_bf16(om8[2], om8[3]); wa.z = cvt_pk_bf16(om8[4], om8[5]); wa.w = cvt_pk_bf16(om8[6], om8[7]);
                wu.x = cvt_pk_bf16(u8[0], u8[1]); wu.y = cvt_pk_bf16(u8[2], u8[3]); wu.z = cvt_pk_bf16(u8[4], u8[5]); wu.w = cvt_pk_bf16(u8[6], u8[7]);
                *(u32x4*)(P->CA + ((size_t)dir * NR + row) * 256 + ch0) = wa; *(u32x4*)(P->CU + ((size_t)dir * NR + row) * 256 + ch0) = wu; }
    }
};
struct EpiRouter {
    static constexpr bool PERM = false, AFTER_DRAIN = false;
    float* AFF;
    __device__ __forceinline__ void operator()(const f32x4 (&acc)[2][2][4][2], const Unit& u, int wr, int wc, int fr_, int fq_) const {
        if (wc != 0) return;
        int fr = fr_, fq = fq_; asm volatile("" : "+v"(fr), "+v"(fq));
        const int lane = fq * 16 + fr;
#pragma unroll
        for (int ai = 0; ai < 2; ++ai)
#pragma unroll
            for (int m = 0; m < 4; ++m) { const f32x4 v = acc[ai][0][m][0];
                float mx = fmaxf(fmaxf(v[0], v[1]), fmaxf(v[2], v[3]));
                mx = fmaxf(mx, __int_as_float(__builtin_amdgcn_ds_bpermute((lane ^ 16) << 2, __float_as_int(mx)))); mx = fmaxf(mx, __int_as_float(__builtin_amdgcn_ds_bpermute((lane ^ 32) << 2, __float_as_int(mx))));
                const float e0 = __expf(v[0] - mx), e1 = __expf(v[1] - mx), e2 = __expf(v[2] - mx), e3 = __expf(v[3] - mx);
                float sm = (e0 + e1) + (e2 + e3);
                sm += __int_as_float(__builtin_amdgcn_ds_bpermute((lane ^ 16) << 2, __float_as_int(sm))); sm += __int_as_float(__builtin_amdgcn_ds_bpermute((lane ^ 32) << 2, __float_as_int(sm)));
                const float inv = 1.0f / sm;
                const int row = u.pm * BM + ai * HALF + wr * 64 + m * 16 + fr, seg = row_seg(row), t = row - seg_base(seg);
                float* o = AFF + ((size_t)seg * NE + 4 * fq) * L + t;
                o[0] = e0 * inv; o[(size_t)L] = e1 * inv; o[(size_t)2 * L] = e2 * inv; o[(size_t)3 * L] = e3 * inv; }
    }
};
struct GroupOrder {
    StaticOrder so; int tf, nNl, nsh, G, c;
    __device__ void init(int nsl, int nNl_, int G_, int c_) { const int tv = (nsl + 255) / 256, rem = nsl & 255; const bool sh = rem != 0 && rem <= 128; tf = sh ? tv - 1 : tv; nNl = nNl_; nsh = sh ? NE * nNl_ : 0; G = G_; c = c_;
        so.init(NE * tf * BM, nNl_ * BM, G_, c_); }
    __device__ bool next(int i, Unit& u) const {
        if (so.next(i, u)) { const int e = u.pm / tf; u.pm = e * TPE + (u.pm - e * tf); u.pn += e * nNl; return true; }
        const long j = (long)i * G + c - so.nwg; if (j >= nsh) return false;
        const int e = (int)j / nNl; u.pm = e * TPE + tf; u.pn = (int)j; return true;
    }
    __device__ __forceinline__ bool is_half(const Unit& u) const { return nsh != 0 && (u.pm % TPE) == tf; }
    __device__ __forceinline__ void a_ready(const Unit&) const {}
    __device__ __forceinline__ void done(const Unit&) const {}
};
}

namespace attn_body {
using bf16=__hip_bfloat16;
using bf16x8=__attribute__((ext_vector_type(8)))short;
using s16x4=__attribute__((ext_vector_type(4)))short;
using f32x16=__attribute__((ext_vector_type(16)))float;
using u32x4=__attribute__((ext_vector_type(4)))unsigned;
constexpr int D=64,ZP=DIN,OP=1024,NTC=LC/64;
constexpr int NW=8,QBLK=32,QB=QBLK*NW,KVBLK=64,NQB=L/QB;
__device__ __forceinline__ int crow(int r,int hi){return (r&3)+8*(r>>2)+4*hi;}
#define SBAR() __builtin_amdgcn_sched_barrier(0)
constexpr int NSLOT=3, SLOTB=8192;
constexpr int LDS_K=0, LDS_V=NSLOT*SLOTB, LDS_WS=2*NSLOT*SLOTB, LDS_OST=LDS_WS+NW*64*4, LDS_BYTES=LDS_OST+NW*4096;
constexpr float C2=0.125f*1.4426950408889634f;
__device__ __forceinline__ void glds16(const void*sbase,unsigned voff,unsigned lds_dst){unsigned keep;
  asm volatile("s_mov_b32 %0, m0\n\ts_mov_b32 m0, %3\n\ts_nop 0\n\tglobal_load_lds_dwordx4 %1, %2\n\ts_mov_b32 m0, %0":"=&s"(keep):"v"(voff),"s"(sbase),"s"(lds_dst):"memory");}
__device__ __forceinline__ float max3f(float a,float b,float c){float r;asm("v_max3_f32 %0, %1, %2, %3":"=v"(r):"v"(a),"v"(b),"v"(c));return r;}
__device__ __forceinline__ float max2f(float a,float b){float r;asm("v_max_f32_e32 %0, %1, %2":"=v"(r):"v"(a),"v"(b));return r;}
__device__ __forceinline__ float fadd_s(float a,float b){float r;asm("v_add_f32_e32 %0, %1, %2":"=v"(r):"v"(a),"v"(b));return r;}
__device__ __forceinline__ float fsub_s(float a,float b){float r;asm("v_sub_f32_e32 %0, %1, %2":"=v"(r):"v"(a),"v"(b));return r;}
typedef float f32x2_t __attribute__((ext_vector_type(2))); typedef __bf16 bf16x2_t __attribute__((ext_vector_type(2)));
__device__ __forceinline__ unsigned cvtpk_s(float lo,float hi){f32x2_t v={lo,hi};bf16x2_t b=__builtin_convertvector(v,bf16x2_t);return __builtin_bit_cast(unsigned,b);}
#define WAIT_BAR(N) asm volatile("s_waitcnt vmcnt(" #N ") lgkmcnt(0)\n\ts_barrier":::"memory")

__device__ __forceinline__ void qkt(f32x16&p0,f32x16&p1,const char*Kslot,const bf16x8*qr,const f32x16&negm,int r32,int hi){
  const char*kb=Kslot+hi*1024+r32*16;
  #pragma unroll
  for(int d0=0;d0<4;++d0){
    const bf16x8 b0=*reinterpret_cast<const bf16x8*>(kb+d0*2048);
    const bf16x8 b1=*reinterpret_cast<const bf16x8*>(kb+d0*2048+512);
    if(d0==0){p0=__builtin_amdgcn_mfma_f32_32x32x16_bf16(b0,qr[0],negm,0,0,0);p1=__builtin_amdgcn_mfma_f32_32x32x16_bf16(b1,qr[0],negm,0,0,0);}
    else{p0=__builtin_amdgcn_mfma_f32_32x32x16_bf16(b0,qr[d0],p0,0,0,0);p1=__builtin_amdgcn_mfma_f32_32x32x16_bf16(b1,qr[d0],p1,0,0,0);}}
}
typedef __attribute__((address_space(3))) const char* lds_cptr;
typedef short v4i16_t __attribute__((ext_vector_type(4)));
__device__ __forceinline__ void kload8(bf16x8*kf,lds_cptr kp){
  kf[0]=*(const __attribute__((address_space(3))) bf16x8*)(kp);      kf[1]=*(const __attribute__((address_space(3))) bf16x8*)(kp+512);
  kf[2]=*(const __attribute__((address_space(3))) bf16x8*)(kp+2048); kf[3]=*(const __attribute__((address_space(3))) bf16x8*)(kp+2560);
  kf[4]=*(const __attribute__((address_space(3))) bf16x8*)(kp+4096); kf[5]=*(const __attribute__((address_space(3))) bf16x8*)(kp+4608);
  kf[6]=*(const __attribute__((address_space(3))) bf16x8*)(kp+6144); kf[7]=*(const __attribute__((address_space(3))) bf16x8*)(kp+6656);
}
__device__ __forceinline__ void kload2(bf16x8*kf,lds_cptr kp,int j){ kf[2*j]=*(const __attribute__((address_space(3))) bf16x8*)(kp+j*2048); kf[2*j+1]=*(const __attribute__((address_space(3))) bf16x8*)(kp+j*2048+512); }
__device__ __forceinline__ s16x4 vtr(lds_cptr p){ return __builtin_bit_cast(s16x4,__builtin_amdgcn_ds_read_tr16_b64_v4i16((__attribute__((address_space(3))) v4i16_t*)p)); }
__device__ __forceinline__ float rowmax(const f32x16&p0,const f32x16&p1){
  float a=max3f(p0[0],p0[1],p1[0]),b=max3f(p0[2],p0[3],p1[1]);a=max3f(a,p1[2],p1[3]);
  #pragma unroll
  for(int r=4;r<16;r+=4){a=max3f(a,p0[r],p0[r+1]);b=max3f(b,p0[r+2],p0[r+3]);a=max3f(a,p1[r],p1[r+1]);b=max3f(b,p1[r+2],p1[r+3]);}
  const float m=max2f(a,b);
  auto rr=__builtin_amdgcn_permlane32_swap(__float_as_uint(m),__float_as_uint(m),false,false);
  return max2f(__uint_as_float(rr[0]),__uint_as_float(rr[1]));
}
__device__ __forceinline__ void pv(f32x16*o,int vb,bf16x8 pa0,bf16x8 pa1,bf16x8 pa2,bf16x8 pa3){
  #pragma unroll
  for(int d0=0;d0<2;++d0){s16x4 lo[4],hi[4];
    #pragma unroll
    for(int ks=0;ks<4;++ks){
      asm volatile("ds_read_b64_tr_b16 %0,%1 offset:%c2":"=&v"(lo[ks]):"v"(vb),"i"(d0*4096+ks*1024):"memory");
      asm volatile("ds_read_b64_tr_b16 %0,%1 offset:%c2":"=&v"(hi[ks]):"v"(vb),"i"(d0*4096+ks*1024+512):"memory");}
    asm volatile("s_waitcnt lgkmcnt(0)":::"memory");SBAR();
    #define PK(k) (bf16x8){lo[k][0],lo[k][1],lo[k][2],lo[k][3],hi[k][0],hi[k][1],hi[k][2],hi[k][3]}
    o[d0]=__builtin_amdgcn_mfma_f32_32x32x16_bf16(pa0,PK(0),o[d0],0,0,0);
    o[d0]=__builtin_amdgcn_mfma_f32_32x32x16_bf16(pa1,PK(1),o[d0],0,0,0);
    o[d0]=__builtin_amdgcn_mfma_f32_32x32x16_bf16(pa2,PK(2),o[d0],0,0,0);
    o[d0]=__builtin_amdgcn_mfma_f32_32x32x16_bf16(pa3,PK(3),o[d0],0,0,0);
    #undef PK
  }
}

#ifndef ATTN_STORE16
#define ATTN_STORE16(p,v) (*(u32x4*)(p)=(v))
#endif
__device__ __forceinline__ void wmask(f32x16&p0,f32x16&p1,int s0,int tq,int hi){
  const float NEG=-INFINITY;
  #pragma unroll
  for(int r=0;r<16;++r){ const int s=s0+4*hi+(r&3)+8*(r>>2); const int d0=tq-s,d1=d0-32;
    if(!(s>=0&&s<L&&d0<=WINDOW&&d0>=-WINDOW))p0[r]=NEG; if(!(s+32>=0&&s+32<L&&d1<=WINDOW&&d1>=-WINDOW))p1[r]=NEG; }
}
template<int MODE,int THRL,bool FAST> __device__ __forceinline__ void attn_unit(int b,int h,int qb,const bf16*__restrict__ Z,bf16*O,char*shm,int wv,float sinkl2,const float*qnw,const float*rope){
  constexpr bool ISC=(MODE==1||MODE==2),CTXQ=(MODE>=2),WIN=(MODE==1);
  constexpr int QCOL=ISC?Z_CQ:Z_DQ,KCOL=ISC?Z_CK:Z_DK,VCOL=ISC?Z_CV:Z_DV,OCOL=ISC?512:768;
  static_assert(!CTXQ||LC==QB,"context queries: one 256-row unit per (batch, head)");
  const int lane=lane_id(),r32=lane&31,hi=lane>>5; const int wid=wv;
  const long rowbase=CTXQ?(long)NLAT+(long)b*LC:(long)b*L; const int q0=CTXQ?0:qb*QB; const int kvh=h>>1;
  const bf16*Qw=Z+(rowbase+q0+wid*QBLK)*ZP+QCOL+h*D;
  const bf16*Zk=Z+KCOL+kvh*D,*Zv=Z+VCOL+kvh*D; const int crow0=NLAT+b*LC,lrow0=b*L;
  const int kt0=WIN?q0/KVBLK-2-NTC:-NTC;
  #define TROW(t) __builtin_amdgcn_readfirstlane((t)<NTC?crow0+(t)*KVBLK:lrow0+(CTXQ?0:(WIN?min(max(kt0+(t),0),L/KVBLK-1):kt0+(t)))*KVBLK)
  const unsigned lds0=(unsigned)(uintptr_t)shm;
  float*wsf=(float*)(shm+LDS_WS)+wid*64;
  const unsigned koff=(unsigned)(lane*ZP+wid*8)*2u, voff=(unsigned)((16*(wid&3)+(lane>>2))*ZP+(wid>>2)*32+(lane&3)*8)*2u;
  const unsigned kdst=lds0+LDS_K+wid*1024, vdst=lds0+LDS_V+wid*1024;
  #define DMA_K(t,slot) glds16(Zk+(long)TROW(t)*ZP,koff,(unsigned)__builtin_amdgcn_readfirstlane(kdst+(slot)))
  #define DMA_V(t,slot) glds16(Zv+(long)TROW(t)*ZP,voff,(unsigned)__builtin_amdgcn_readfirstlane(vdst+(slot)))
  const int vb0=(int)(lds0+LDS_V)+((lane>>4)&1)*32+(lane&3)*8+(4*hi+((lane&15)>>2))*64;
  const char*Kbase=shm+LDS_K; bf16x8 kf[8];
  const lds_cptr shm3=(lds_cptr)shm; const lds_cptr kp0=shm3+LDS_K+hi*1024+r32*16; const lds_cptr vp0=shm3+LDS_V+((lane>>4)&1)*32+(lane&3)*8+(4*hi+((lane&15)>>2))*64;
  constexpr int NT=CTXQ?NTC+2:(WIN?NTC+8:(LC+L)/KVBLK);
  DMA_K(0,0);DMA_V(0,0);DMA_K(1,SLOTB);
  bf16x8 qr[4];
  #pragma unroll
  for(int d0=0;d0<4;++d0)qr[d0]=*reinterpret_cast<const bf16x8*>(&Qw[(long)r32*ZP+d0*16+hi*8]);
  { float xq[4][8];
    #pragma unroll
    for(int d0=0;d0<4;++d0){
      #pragma unroll
      for(int j=0;j<8;++j)xq[d0][j]=__uint_as_float(((unsigned)(unsigned short)qr[d0][j])<<16); }
    if(!ISC){ float ss=0.f;
      #pragma unroll
      for(int d0=0;d0<4;++d0){
        #pragma unroll
        for(int j=0;j<8;++j)ss+=xq[d0][j]*xq[d0][j]; }
      {auto rr=__builtin_amdgcn_permlane32_swap(__float_as_uint(ss),__float_as_uint(ss),false,false);ss=__uint_as_float(rr[0])+__uint_as_float(rr[1]);}
      const float rstd=1.0f/sqrtf(ss*(1.0f/64.0f)+EPS);
      #pragma unroll
      for(int d0=0;d0<4;++d0){
        #pragma unroll
        for(int j=0;j<8;++j)xq[d0][j]=xq[d0][j]*rstd*qnw[16*d0+8*hi+j]; } }
    if(!CTXQ){ const int tpos=q0+wid*QBLK+r32,pr=tpos>>6,pc=tpos&63;
      #pragma unroll
      for(int j=0;j<8;++j){ const int f=8*hi+j;
        { const float c=rope[(pr*16+f)*2],s_=rope[(pr*16+f)*2+1],x1=xq[0][j],x2=xq[1][j]; xq[0][j]=x1*c-x2*s_; xq[1][j]=x2*c+x1*s_; }
        { const float c=rope[(pc*16+f)*2],s_=rope[(pc*16+f)*2+1],x1=xq[2][j],x2=xq[3][j]; xq[2][j]=x1*c-x2*s_; xq[3][j]=x2*c+x1*s_; } } }
    #pragma unroll
    for(int d0=0;d0<4;++d0){ const u32x4 w=(u32x4){cvtpk_s(xq[d0][0]*QC2,xq[d0][1]*QC2),cvtpk_s(xq[d0][2]*QC2,xq[d0][3]*QC2),cvtpk_s(xq[d0][4]*QC2,xq[d0][5]*QC2),cvtpk_s(xq[d0][6]*QC2,xq[d0][7]*QC2)}; qr[d0]=__builtin_bit_cast(bf16x8,w); } }
  float mhat=0.f,l_reg=0.f;f32x16 o[2];o[0]=f32x16{};o[1]=f32x16{};const f32x16 negm=f32x16{};
  const int tq=q0+wid*QBLK+r32;
  #define CMASK(P0,P1,t) do{ if(MODE&&(t)>=NTC)wmask(P0,P1,CTXQ?-(1<<24):(kt0+(t))*KVBLK,tq,hi); }while(0)
  bool resc=false;
  #define START(P0,P1) do{ resc=false; \
    if(!FAST){ const float rm=rowmax(P0,P1); const float dl=rm; mhat=fadd_s(mhat,dl); \
      _Pragma("unroll") for(int r=0;r<16;++r){P0[r]=fsub_s(P0[r],dl);P1[r]=fsub_s(P1[r],dl);} } \
    _Pragma("unroll") for(int r=0;r<16;++r)P0[r]=__builtin_amdgcn_exp2f(P0[r]); }while(0)
  #define RESC() do{ if(!FAST&&resc){ asm volatile("s_waitcnt lgkmcnt(0)":::"memory"); \
      _Pragma("unroll") for(int d_=0;d_<2;++d_) _Pragma("unroll") for(int r=0;r<16;++r)o[d_][r]*=wsf[crow(r,hi)]; } }while(0)
  f32x16 pA0,pA1,pB0,pB1;
  int sl_prev=0,sl_cur=0,sl_next=SLOTB;
  #define ROT() do{sl_prev=sl_cur;sl_cur=sl_next;sl_next=(sl_next==(NSLOT-1)*SLOTB)?0:sl_next+SLOTB;}while(0)
  DMA_K(2,2*SLOTB);
  WAIT_BAR(3);
  qkt(pA0,pA1,Kbase,qr,negm,r32,hi);asm volatile("s_nop 15\n\ts_nop 7":"+v"(pA0),"+v"(pA1));CMASK(pA0,pA1,0);
  START(pA0,pA1);
  _Pragma("unroll") for(int r=0;r<16;++r)pA1[r]=__builtin_amdgcn_exp2f(pA1[r]);
  WAIT_BAR(0);
  DMA_K(3,0);DMA_V(1,SLOTB);
  ROT();
  kload8(kf,kp0+sl_cur);
  WAIT_BAR(2);
  s16x4 vlo[8],vhi[8]; u32x4 pw0,pw1,pw2,pw3;
  #define PKW(P,B) cvtpk_s(P[B],P[B+1])
  #define PAF(k) __builtin_bit_cast(bf16x8,pw##k)
  #define VFR(i) (bf16x8){vlo[i][0],vlo[i][1],vlo[i][2],vlo[i][3],vhi[i][0],vhi[i][1],vhi[i][2],vhi[i][3]}
  #define PIN(x) asm volatile("":"+v"(x))
  #define MX3(a,b,c) __builtin_fmaxf(__builtin_fmaxf((a),(b)),(c))
  #define GAPA(MF,A0,A1,A2,A3,W0,W1,PW) do{ MF; sacc+=A0; sacc+=A1; sacc+=A2; sacc+=A3; PIN(sacc); W0; W1; PIN(PW); SBAR(); }while(0)
  #define EX(v) __builtin_amdgcn_exp2f(v)
  #define SH(v) (FAST?(v):(v)-mhat)
  #define GAPB(MF,X,B) do{ MF; X[B]=EX(SH(X[B])); X[B+1]=EX(SH(X[B+1])); X[B+2]=EX(SH(X[B+2])); X[B+3]=EX(SH(X[B+3])); PIN(X); SBAR(); }while(0)
  #define VRD(i) do{ vlo[i]=vtr(vp_+(((i)>>2)*4096+((i)&3)*1024)); vhi[i]=vtr(vp_+(((i)>>2)*4096+((i)&3)*1024+512)); }while(0)
  #define KRD(G,j) do{ if(G){ kload2(kf,kp0+sl_next,j); SBAR(); } }while(0)
  #define STEP(C0,C1,P0,P1,t,GK,GV,GL) do{ SBAR(); \
    const lds_cptr vp_=vp0+sl_prev; \
    VRD(0); SBAR(); float sacc=(P0[0]+P0[1]); \
    GAPA(C0=__builtin_amdgcn_mfma_f32_32x32x16_bf16(kf[0],qr[0],negm,0,0,0), P0[2],P0[3],P0[4],P0[5],     pw0[0]=PKW(P0,0), pw0[1]=PKW(P0,2), pw0); \
    VRD(4); SBAR(); GAPA(C1=__builtin_amdgcn_mfma_f32_32x32x16_bf16(kf[1],qr[0],negm,0,0,0), P0[6],P0[7],P0[8],P0[9],     pw0[2]=PKW(P0,4), pw0[3]=PKW(P0,6), pw0); \
    VRD(1); SBAR(); GAPA(C0=__builtin_amdgcn_mfma_f32_32x32x16_bf16(kf[2],qr[1],C0,0,0,0),   P0[10],P0[11],P0[12],P0[13], pw1[0]=PKW(P0,8), pw1[1]=PKW(P0,10), pw1); \
    VRD(5); SBAR(); GAPA(C1=__builtin_amdgcn_mfma_f32_32x32x16_bf16(kf[3],qr[1],C1,0,0,0),   P0[14],P0[15],P1[0],P1[1],   pw1[2]=PKW(P0,12),pw1[3]=PKW(P0,14), pw1); \
    VRD(2); SBAR(); GAPA(C0=__builtin_amdgcn_mfma_f32_32x32x16_bf16(kf[4],qr[2],C0,0,0,0),   P1[2],P1[3],P1[4],P1[5],     pw2[0]=PKW(P1,0), pw2[1]=PKW(P1,2), pw2); \
    VRD(6); SBAR(); GAPA(C1=__builtin_amdgcn_mfma_f32_32x32x16_bf16(kf[5],qr[2],C1,0,0,0),   P1[6],P1[7],P1[8],P1[9],     pw2[2]=PKW(P1,4), pw2[3]=PKW(P1,6), pw2); \
    VRD(3); SBAR(); GAPA(C0=__builtin_amdgcn_mfma_f32_32x32x16_bf16(kf[6],qr[3],C0,0,0,0),   P1[10],P1[11],P1[12],P1[13], pw3[0]=PKW(P1,8), pw3[1]=PKW(P1,10), pw3); \
    VRD(7); SBAR(); GAPA(C1=__builtin_amdgcn_mfma_f32_32x32x16_bf16(kf[7],qr[3],C1,0,0,0),   P1[14],P1[15],0.f,0.f,       pw3[2]=PKW(P1,12),pw3[3]=PKW(P1,14), pw3); \
    l_reg+=sacc; \
    if(GK){DMA_K((t)+3,sl_cur);} if(GV){DMA_V((t)+1,sl_next);} \
    CMASK(C0,C1,t); \
    if(!FAST){ float a=MX3(C0[0],C0[1],C1[0]),b=MX3(C0[2],C0[3],C1[1]); a=MX3(a,C1[2],C1[3]); \
      _Pragma("unroll") for(int r=4;r<16;r+=4){a=MX3(a,C0[r],C0[r+1]);b=MX3(b,C0[r+2],C0[r+3]);a=MX3(a,C1[r],C1[r+1]);b=MX3(b,C1[r+2],C1[r+3]);} \
      float rm=__builtin_fmaxf(a,b); { auto rr=__builtin_amdgcn_permlane32_swap(__float_as_uint(rm),__float_as_uint(rm),false,false); rm=__builtin_fmaxf(__uint_as_float(rr[0]),__uint_as_float(rr[1])); } \
      rm-=mhat;   \
      resc=false; \
      if(__builtin_expect(__any(rm>(float)THRL),0)){ const float dl=__builtin_fmaxf(rm,0.f); mhat+=dl; \
        const float f=__builtin_amdgcn_exp2f(-dl); l_reg*=f; if(hi==0)wsf[r32]=f; resc=true; } } \
    SBAR(); \
    GAPB(o[0]=__builtin_amdgcn_mfma_f32_32x32x16_bf16(PAF(0),VFR(0),o[0],0,0,0), C0,0); \
    GAPB(o[1]=__builtin_amdgcn_mfma_f32_32x32x16_bf16(PAF(0),VFR(4),o[1],0,0,0), C0,4); \
    KRD(GL,0); GAPB(o[0]=__builtin_amdgcn_mfma_f32_32x32x16_bf16(PAF(1),VFR(1),o[0],0,0,0), C0,8); \
    KRD(GL,1); GAPB(o[1]=__builtin_amdgcn_mfma_f32_32x32x16_bf16(PAF(1),VFR(5),o[1],0,0,0), C0,12); \
    KRD(GL,2); GAPB(o[0]=__builtin_amdgcn_mfma_f32_32x32x16_bf16(PAF(2),VFR(2),o[0],0,0,0), C1,0); \
    KRD(GL,3); GAPB(o[1]=__builtin_amdgcn_mfma_f32_32x32x16_bf16(PAF(2),VFR(6),o[1],0,0,0), C1,4); \
    GAPB(o[0]=__builtin_amdgcn_mfma_f32_32x32x16_bf16(PAF(3),VFR(3),o[0],0,0,0), C1,8); \
    GAPB(o[1]=__builtin_amdgcn_mfma_f32_32x32x16_bf16(PAF(3),VFR(7),o[1],0,0,0), C1,12); \
    }while(0)
  int t=1;
  for(;t+5<NT;t+=2){
    STEP(pB0,pB1,pA0,pA1,t,true,true,true);     WAIT_BAR(2); RESC(); ROT();
    STEP(pA0,pA1,pB0,pB1,t+1,true,true,true);   WAIT_BAR(2); RESC(); ROT();
  }
  #define ENDW(tt) do{ if((tt)+3<NT){WAIT_BAR(2);} else if((tt)+2<NT){WAIT_BAR(1);} else {WAIT_BAR(0);} }while(0)
  for(;t+1<NT;t+=2){
    STEP(pB0,pB1,pA0,pA1,t,(t+3<NT),(t+1<NT),(t+1<NT));       ENDW(t);   RESC(); ROT();
    STEP(pA0,pA1,pB0,pB1,t+1,(t+4<NT),(t+2<NT),(t+2<NT));     ENDW(t+1); RESC(); ROT();
  }
  STEP(pB0,pB1,pA0,pA1,NT-1,false,false,false); RESC();
  { float sacc=pB0[0]+pB0[1]; _Pragma("unroll") for(int r=2;r<16;++r)sacc+=pB0[r]; _Pragma("unroll") for(int r=0;r<16;++r)sacc+=pB1[r]; l_reg+=sacc;
    pw0=(u32x4){PKW(pB0,0),PKW(pB0,2),PKW(pB0,4),PKW(pB0,6)};pw1=(u32x4){PKW(pB0,8),PKW(pB0,10),PKW(pB0,12),PKW(pB0,14)};pw2=(u32x4){PKW(pB1,0),PKW(pB1,2),PKW(pB1,4),PKW(pB1,6)};pw3=(u32x4){PKW(pB1,8),PKW(pB1,10),PKW(pB1,12),PKW(pB1,14)};
    SBAR(); pv(o,vb0+sl_cur,PAF(0),PAF(1),PAF(2),PAF(3)); }
  #undef PKW
  #undef PAF
  #undef VFR
  #undef PIN
  #undef MX3
  #undef GAPA
  #undef GAPB
  #undef SH
  #undef EX
  #undef VRD
  #undef KRD
  #undef STEP
  #undef ENDW
  {auto rr=__builtin_amdgcn_permlane32_swap(__float_as_uint(l_reg),__float_as_uint(l_reg),false,false);l_reg=__uint_as_float(rr[0])+__uint_as_float(rr[1]);}
  if(ISC)l_reg+=__builtin_amdgcn_exp2f(sinkl2-mhat);
  if(hi==0)wsf[32+r32]=l_reg;asm volatile("s_waitcnt lgkmcnt(0)":::"memory");
  float rli[16];
  #pragma unroll
  for(int r=0;r<16;++r)rli[r]=__builtin_amdgcn_rcpf(wsf[32+crow(r,hi)]);
  bf16*Ow=O+(rowbase+q0+wid*QBLK)*OP+OCOL+h*D;
  { bf16*stg=(bf16*)(shm+LDS_OST)+wid*2048;
    #pragma unroll
    for(int r=0;r<16;++r){const int orow=crow(r,hi);
      #pragma unroll
      for(int d0=0;d0<2;++d0)stg[orow*64+d0*32+r32]=__float2bfloat16(o[d0][r]*rli[r]);}
    asm volatile("s_waitcnt lgkmcnt(0)":::"memory");
    #pragma unroll
    for(int i=0;i<4;++i){const int row=i*8+(lane>>3),ch=lane&7; const u32x4 v=*(const u32x4*)(stg+row*64+ch*8); ATTN_STORE16(Ow+(long)row*OP+ch*8,v);} }
  asm volatile("s_waitcnt lgkmcnt(0)\n\ts_barrier":::"memory");
  #undef DMA_K
  #undef DMA_V
  #undef TROW
  #undef CMASK
  #undef START
  #undef RESC
  #undef ROT
}
constexpr int ATTN_LDS_BYTES=LDS_BYTES;
template<int MODE,int THRL=8,bool FAST=false> __device__ __forceinline__ void attn_phase(char*lds,const bf16*Z,bf16*O,int wv,const float*sink,const float*qnw,const float*rope){
  const int G=grid_dim(), bid=block_id(), vcu=(G%8==0)?(bid%8)*(G/8)+bid/8:bid; constexpr int NQ=(MODE>=2)?1:NQB, NU=NB*4*NQ;
  const int upc=(NU+G-1)/G;
  const int voff=(MODE==3&&G>=2*NU)?NU:0;
  for(int i=0;i<upc;++i){ const int u=(vcu-voff)*upc+i; if(u<0||u>=NU)break; const int qb=u%NQ,bh=u/NQ; attn_unit<MODE,THRL,FAST>(bh>>2,bh&3,qb,Z,O,lds,wv,(MODE==1||MODE==2)?sink[bh&3]*1.4426950408889634f:0.f,qnw,rope); }
}
#undef SBAR
#undef WAIT_BAR
}

constexpr int LDS_BYTES = pg8::STAGE_BYTES + 16;
static_assert(attn_body::ATTN_LDS_BYTES <= pg8::STAGE_BYTES, "attention LDS");

typedef const __attribute__((address_space(4))) Params* KParams;
__device__ __forceinline__ const Params& fresh_params() { KParams p = (KParams)__builtin_amdgcn_kernarg_segment_ptr(); asm volatile("" : "+s"(p)); return *(const Params*)p; }


typedef float f4_t __attribute__((ext_vector_type(4)));
typedef unsigned u2_t __attribute__((ext_vector_type(2)));
__device__ __forceinline__ float lane_read(float v, int src) { return __int_as_float(__builtin_amdgcn_ds_bpermute(src << 2, __float_as_int(v))); }
__device__ __forceinline__ unsigned lane_read(unsigned v, int src) { return (unsigned)__builtin_amdgcn_ds_bpermute(src << 2, (int)v); }
__device__ __forceinline__ float wave_sum(float v, int lane) {
#pragma unroll
    for (int o = 32; o >= 1; o >>= 1) v += lane_read(v, lane ^ o);
    return v;
}
__device__ __forceinline__ unsigned pk_bf16(float lo, float hi) { return (unsigned)f2bf(lo) | ((unsigned)f2bf(hi) << 16); }
__device__ __forceinline__ void norm_mod_row(const float* x, const float* w, const float* sc, const float* sh, bf16_t* h, int lane, f4_t (&hv)[4]) {
    f4_t xv[4]; float ss = 0.f;
#pragma unroll
    for (int j = 0; j < 4; ++j) { xv[j] = ((const f4_t*)x)[j * 64 + lane]; ss += xv[j][0] * xv[j][0] + xv[j][1] * xv[j][1] + xv[j][2] * xv[j][2] + xv[j][3] * xv[j][3]; }
    ss = wave_sum(ss, lane);
    const float rstd = 1.0f / sqrtf(ss * (1.0f / D) + EPS);
#pragma unroll
    for (int j = 0; j < 4; ++j) { const f4_t wv4 = ((const f4_t*)w)[j * 64 + lane], s4 = ((const f4_t*)sc)[j * 64 + lane], b4 = ((const f4_t*)sh)[j * 64 + lane];
        hv[j] = xv[j] * rstd * wv4 * (1.0f + s4) + b4;
        u2_t o; o.x = pk_bf16(hv[j][0], hv[j][1]); o.y = pk_bf16(hv[j][2], hv[j][3]); ((u2_t*)h)[j * 64 + lane] = o; }
}
template <int NR_, class XF, class HF> __device__ __forceinline__ void norm_rows(const Params& P, int l, int which  , int r0, int dr, int n, int lane, XF xrow, HF hrow) {
    f4_t xv[NR_][4];
#pragma unroll
    for (int q = 0; q < NR_; ++q) { const int r = r0 + q * dr; if (r < n) { const float* x = xrow(r);
#pragma unroll
        for (int j = 0; j < 4; ++j) xv[q][j] = __builtin_nontemporal_load((const f4_t*)x + j * 64 + lane); } }
    f4_t gv[4], sv[4]; int wcur = -1;
#pragma unroll
    for (int q = 0; q < NR_; ++q) { const int r = r0 + q * dr; if (r < n) { float ss = 0.f;
#pragma unroll
        for (int j = 0; j < 4; ++j) ss += xv[q][j][0] * xv[q][j][0] + xv[q][j][1] * xv[q][j][1] + xv[q][j][2] * xv[q][j][2] + xv[q][j][3] * xv[q][j][3];
        ss = wave_sum(ss, lane);
        const float rstd = 1.0f / sqrtf(ss * (1.0f / D) + EPS); const int who = row_who(r);
        if (who != wcur) { wcur = who; const float* sc = modv(P, l, who, which == 1 ? 1 : 4); const float* sh = modv(P, l, who, which == 1 ? 0 : 3);
#pragma unroll
            for (int j = 0; j < 4; ++j) { gv[j] = ((const f4_t*)sc)[j * 64 + lane]; sv[j] = ((const f4_t*)sh)[j * 64 + lane]; } }
        bf16_t* h = hrow(r);
#pragma unroll
        for (int j = 0; j < 4; ++j) { const f4_t hv = xv[q][j] * rstd * gv[j] + sv[j];
            u2_t o; o.x = pk_bf16(hv[0], hv[1]); o.y = pk_bf16(hv[2], hv[3]); ((u2_t*)h)[j * 64 + lane] = o; } } }
}
template <int NR_, class HF> __device__ __forceinline__ void norm_rows16(const Params& P, int l, int r0, int dr, int n, int lane, HF hrow) {
    u2_t xr[NR_][4];
#pragma unroll
    for (int q = 0; q < NR_; ++q) { const int r = r0 + q * dr; if (r < n) { const u2_t* x = (const u2_t*)(P.XB + (size_t)r * D);
#pragma unroll
        for (int j = 0; j < 4; ++j) xr[q][j] = x[j * 64 + lane]; } }
    f4_t gv[4], sv[4]; int wcur = -1;
#pragma unroll
    for (int q = 0; q < NR_; ++q) { const int r = r0 + q * dr; if (r < n) { float ss = 0.f; f4_t xv[4];
#pragma unroll
        for (int j = 0; j < 4; ++j) { xv[j] = (f4_t){bf_lo(xr[q][j].x), bf_hi(xr[q][j].x), bf_lo(xr[q][j].y), bf_hi(xr[q][j].y)}; ss += xv[j][0] * xv[j][0] + xv[j][1] * xv[j][1] + xv[j][2] * xv[j][2] + xv[j][3] * xv[j][3]; }
        ss = wave_sum(ss, lane);
        const float rstd = 1.0f / sqrtf(ss * (1.0f / D) + EPS); const int who = row_who(r);
        if (who != wcur) { wcur = who; const float* sc = modv(P, l, who, 4); const float* sh = modv(P, l, who, 3);
#pragma unroll
            for (int j = 0; j < 4; ++j) { gv[j] = ((const f4_t*)sc)[j * 64 + lane]; sv[j] = ((const f4_t*)sh)[j * 64 + lane]; } }
        bf16_t* h = hrow(r);
#pragma unroll
        for (int j = 0; j < 4; ++j) { const f4_t hv = xv[j] * rstd * gv[j] + sv[j];
            u2_t o; o.x = pk_bf16(hv[0], hv[1]); o.y = pk_bf16(hv[2], hv[3]); ((u2_t*)h)[j * 64 + lane] = o; } } }
}
__device__ __forceinline__ void mod_wave(const Params& P, int w, int lane) {
    const int nb = w % 96, who = (w / 96) % 3, l = w / 288, n = nb * 64 + lane;
    const float* cv = who < 2 ? P.c + who * D : P.c_ctx; const float* wp = P.mod_w + (size_t)l * D * 6 * D + n;
    float acc = 0.f;
    for (int j = 0; j < 16; ++j) { const float x = cv[j * 64 + lane], sv = x * __builtin_amdgcn_rcpf(1.0f + __expf(-x));
#pragma unroll
        for (int kk = 0; kk < 64; ++kk) acc += __int_as_float(__builtin_amdgcn_readlane(__float_as_int(sv), kk)) * wp[(size_t)(j * 64 + kk) * 6 * D]; }
    float v = acc + P.mod_b[l * 6 * D + n];
    { const int part = nb >> 4, col = n & (D - 1);
      if (part == 1) v = (1.0f + v) * P.norm1_w[l * D + col]; else if (part == 4) v = (1.0f + v) * P.norm2_w[l * D + col]; }
    P.MOD[(size_t)(l * 3 + who) * 6 * D + n] = v;
}
struct CombVec { f4_t m5v[4], gv[4], sv[4]; int wcur; };
template <int LYR> __device__ __forceinline__ void comb_wave(const Params& P, int row, int lane, CombVec& cv) {
    const int who = row_who(row); u2_t* xb = (u2_t*)(P.XB + (size_t)row * D);
    int inv[16];
#pragma unroll
    for (int e = 0; e < NE; ++e) inv[e] = P.INV[(size_t)e * NR + row];
    f4_t acc[4];
#pragma unroll
    for (int j = 0; j < 4; ++j) acc[j] = (f4_t){0.f, 0.f, 0.f, 0.f};
#pragma unroll
    for (int e = 0; e < NE; ++e) { const int sl = __builtin_amdgcn_readfirstlane(inv[e]);
        if (sl >= 0) { const float g = P.GATE[e * SLOTS_PAD + sl]; const u2_t* yr = (const u2_t*)(P.Y + ((size_t)e * SLOTS_PAD + sl) * D);
#pragma unroll
            for (int j = 0; j < 4; ++j) { const u2_t w = yr[j * 64 + lane]; acc[j] += g * (f4_t){bf_lo(w.x), bf_hi(w.x), bf_lo(w.y), bf_hi(w.y)}; } } }
    if (who != cv.wcur) { cv.wcur = who; const float* m5 = modv(P, LYR, who, 5);
        const float* gsrc = LYR == 0 ? modv(P, 1, who, 1) : P.final_norm_w; const float* ssrc = modv(P, 1, who, 0);
#pragma unroll
        for (int j = 0; j < 4; ++j) { cv.m5v[j] = ((const f4_t*)m5)[j * 64 + lane]; cv.gv[j] = ((const f4_t*)gsrc)[j * 64 + lane]; if (LYR == 0) cv.sv[j] = ((const f4_t*)ssrc)[j * 64 + lane]; } }
    f4_t xv[4]; float ss = 0.f;
#pragma unroll
    for (int j = 0; j < 4; ++j) { const u2_t xw = xb[j * 64 + lane]; xv[j] = (f4_t){bf_lo(xw.x), bf_hi(xw.x), bf_lo(xw.y), bf_hi(xw.y)} + cv.m5v[j] * acc[j];
        ss += xv[j][0] * xv[j][0] + xv[j][1] * xv[j][1] + xv[j][2] * xv[j][2] + xv[j][3] * xv[j][3]; }
    ss = wave_sum(ss, lane);
    const float rstd = 1.0f / sqrtf(ss * (1.0f / D) + EPS);
    if (LYR == 0) {
        const float *w = P.norm1_w + D, *sc = modv(P, 1, who, 1), *sh = modv(P, 1, who, 0); bf16_t* h = P.H + (size_t)row * D;
#pragma unroll
        for (int j = 0; j < 4; ++j) { u2_t xo; xo.x = pk_bf16(xv[j][0], xv[j][1]); xo.y = pk_bf16(xv[j][2], xv[j][3]); xb[j * 64 + lane] = xo;
            const f4_t hv = xv[j] * rstd * cv.gv[j] + cv.sv[j];
            u2_t o; o.x = pk_bf16(hv[0], hv[1]); o.y = pk_bf16(hv[2], hv[3]); ((u2_t*)h)[j * 64 + lane] = o; }
    } else {
        float* x = P.out + (size_t)row * D;
#pragma unroll
        for (int j = 0; j < 4; ++j) __builtin_nontemporal_store(xv[j] * rstd * cv.gv[j], (f4_t*)x + j * 64 + lane);
    }
}
__device__ __forceinline__ unsigned block_excl_scan(unsigned v, unsigned* wsum, int wv, int lane, unsigned& total) {
    unsigned inc = v;
#pragma unroll
    for (int o = 1; o < 64; o <<= 1) { const unsigned t = lane_read(inc, (lane - o) & 63); if (lane >= o) inc += t; }
    __syncthreads();
    if (lane == 63) wsum[wv] = inc;
    __syncthreads();
    unsigned off = 0, tot = 0;
#pragma unroll
    for (int w = 0; w < 8; ++w) { const unsigned t = wsum[w]; off += (w < wv) ? t : 0u; tot += t; }
    total = tot; return off + inc - v;
}
__device__ __forceinline__ void topk_block(const Params& P, int item, int wv, int lane, unsigned* lds) {
    const int e = item & 15, seg = item >> 4, N = seg_len(seg), cap = 2 * N / NE, tid = wv * 64 + lane, base = seg_base(seg);
    const float* a = P.AFF + ((size_t)seg * NE + e) * L;
    unsigned* K = lds; unsigned* hist = lds + 16896; unsigned* sh = hist + 16 * 256; unsigned* wsum = sh + 8;
#define KP(i) ((i) + ((i) >> 5))
    { const int n4 = N >> 2; f4_t v[8];
#pragma unroll
        for (int j = 0; j < 8; ++j) { const int q = tid + 512 * j; if (q < n4) v[j] = ((const f4_t*)a)[q]; }
#pragma unroll
        for (int j = 0; j < 8; ++j) { const int q = tid + 512 * j; if (q < n4) { const int p = KP(4 * q); K[p] = __float_as_uint(v[j][0]); K[p + 1] = __float_as_uint(v[j][1]); K[p + 2] = __float_as_uint(v[j][2]); K[p + 3] = __float_as_uint(v[j][3]); } } }
    if (tid == 0) { sh[0] = 0u; sh[1] = (unsigned)cap; }
    __syncthreads();
    for (int pass = 3; pass >= 0; --pass) {
        const int shift = pass * 8; const unsigned maskhi = pass == 3 ? 0u : (0xFFFFFFFFu << (shift + 8));
        for (int i = tid; i < 16 * 256; i += 512) hist[i] = 0u;
        __syncthreads();
        const unsigned prefix = sh[0];
        for (int i = tid; i < N; i += 512) { const unsigned k = K[KP(i)]; if ((k & maskhi) == prefix) atomicAdd(&hist[(lane & 15) * 256 + ((k >> shift) & 255u)], 1u); }
        __syncthreads();
        if (wv == 0) {
            unsigned c[4]; unsigned tot = 0;
#pragma unroll
            for (int j = 0; j < 4; ++j) { unsigned a = 0;
#pragma unroll
                for (int q = 0; q < 16; ++q) a += hist[q * 256 + 4 * lane + j];
                c[j] = a; tot += a; }
            unsigned inc = tot;
#pragma unroll
            for (int o = 1; o < 64; o <<= 1) { const unsigned t = lane_read(inc, (lane + o) & 63); if (lane + o < 64) inc += t; }
            unsigned cum = inc - tot; const unsigned rem = sh[1];
#pragma unroll
            for (int j = 3; j >= 0; --j) { if (cum < rem && rem <= cum + c[j]) { sh[0] = prefix | ((unsigned)(4 * lane + j) << shift); sh[1] = rem - cum; } cum += c[j]; }
        }
        __syncthreads();
    }
    const unsigned kstar = sh[0], need = sh[1];
    const int per = (N + 511) / 512, i0 = tid * per; const bool act = i0 < N;
    unsigned gt = 0, eq = 0;
    if (act) for (int j = 0; j < per; ++j) { const unsigned k = K[KP(i0 + j)]; gt += k > kstar ? 1u : 0u; eq += k == kstar ? 1u : 0u; }
    unsigned tot;
    const unsigned eqb = block_excl_scan(eq, wsum, wv, lane, tot);
    const unsigned take = eqb >= need ? 0u : (need - eqb < eq ? need - eqb : eq);
    unsigned slot = block_excl_scan(gt + take, wsum, wv, lane, tot) + (unsigned)(seg < 2 ? seg * CAP_L : 2 * CAP_L + (seg - 2) * CAP_C);
    unsigned tie = eqb;
    if (act) for (int j = 0; j < per; ++j) { const int i = i0 + j; const unsigned k = K[KP(i)]; bool sel = k > kstar; if (k == kstar) { sel = tie < need; ++tie; }
        if (sel) { P.ROWLIST[e * SLOTS_PAD + slot] = base + i; P.GATE[e * SLOTS_PAD + slot] = __uint_as_float(k); K[KP(i)] = slot; ++slot; }
        else K[KP(i)] = 0xFFFFFFFFu; }
    __syncthreads();
    { const int n4 = N >> 2; int4* dst = (int4*)(P.INV + (size_t)e * NR + base);
        for (int q = tid; q < n4; q += 512) { const int p = KP(4 * q); int4 o; o.x = (int)K[p]; o.y = (int)K[p + 1]; o.z = (int)K[p + 2]; o.w = (int)K[p + 3]; dst[q] = o; } }
#undef KP
    __syncthreads();
}

extern __shared__ __attribute__((aligned(16))) unsigned char shm[];

namespace hg {
typedef short bf16x8 __attribute__((ext_vector_type(8)));
typedef float f32x16 __attribute__((ext_vector_type(16)));
typedef unsigned u32x2 __attribute__((ext_vector_type(2)));
typedef unsigned u32x4 __attribute__((ext_vector_type(4)));
typedef float f32x4_t __attribute__((ext_vector_type(4)));
constexpr int CLB = 160, NCHB = TOT / CLB, NBLK = CLB / 32;
constexpr int KTP = 80, QP = 144, OFF_KT = 0, OFF_QL = 64 * KTP, OFF_KL = OFF_QL + 32 * QP, OFF_LAM = OFF_KL + 32 * QP, WAVE_LDS = OFF_LAM + 256;
static_assert(8 * WAVE_LDS <= pg8::STAGE_BYTES, "hgrn LDS");
__device__ __forceinline__ unsigned pkbf(float lo, float hi) { unsigned r; asm volatile("v_cvt_pk_bf16_f32 %0, %1, %2" : "=v"(r) : "v"(lo), "v"(hi)); return r; }
__device__ __forceinline__ bf16x8 frag2(u32x2 a, u32x2 b) { u32x4 w = {a.x, a.y, b.x, b.y}; return __builtin_bit_cast(bf16x8, w); }
__device__ __forceinline__ bf16x8 accfrag(const f32x16& x, int s2) { u32x4 w = {pkbf(x[8 * s2], x[8 * s2 + 1]), pkbf(x[8 * s2 + 2], x[8 * s2 + 3]), pkbf(x[8 * s2 + 4], x[8 * s2 + 5]), pkbf(x[8 * s2 + 6], x[8 * s2 + 7])}; return __builtin_bit_cast(bf16x8, w); }
template <int PH> __device__ __forceinline__ void b_mfma_wave(const Params& P, int l, int u, int lane, int wv) {
    const int c = u % NCHB, bdh = u / NCHB, head = bdh & 3, dir = (bdh >> 2) & 1, b = bdh >> 3, sgn = dir ? -1 : 1;
    PG8_LAS unsigned char* wl = (PG8_LAS unsigned char*)shm + wv * WAVE_LDS;
    const int kk = lane & 31, h = lane >> 5;
    const float lb = P.LB[l * 256 + head * 64 + lane];
    f32x16 S[2][2];
    float* sst = P.SST + (size_t)u * 4096 + h * 256 + kk;
#pragma unroll
    for (int mt = 0; mt < 2; ++mt)
#pragma unroll
        for (int nt = 0; nt < 2; ++nt)
#pragma unroll
            for (int r = 0; r < 16; ++r) S[mt][nt][r] = PH == 1 ? 0.f : sst[(32 * mt + (r & 3) + 8 * (r >> 2)) * 64 + 32 * nt];
    float ptot = 1.f;
    for (int jb = 0; jb < NBLK; ++jb) {
        const int rbase = scan_row(b, dir, c * CLB + 32 * jb);
        bf16x8 vf[2][2]; const int vlane = sgn * 4 * h * DIN + kk;
#pragma unroll
        for (int s2 = 0; s2 < 2; ++s2)
#pragma unroll
            for (int nt = 0; nt < 2; ++nt) { unsigned w[4];
#pragma unroll
                for (int jp = 0; jp < 4; ++jp) { const int tu = 16 * s2 + 8 * (jp >> 1) + 2 * (jp & 1);
                    const bf16_t* vu = P.Z + ((long)rbase + (long)sgn * tu) * DIN + Z_BI + head * 64 + 32 * nt;
                    w[jp] = (unsigned)vu[vlane] | ((unsigned)vu[vlane + sgn * DIN] << 16); }
                vf[s2][nt] = __builtin_bit_cast(bf16x8, (u32x4){w[0], w[1], w[2], w[3]}); }
        { float lam = 1.f; unsigned ktw[4];
          const bf16_t* zf = P.Z + (size_t)rbase * DIN + Z_BFF + dir * 256 + head * 64 + lane; const bf16_t* zq = P.Z + (size_t)rbase * DIN + Z_BQ + head * 64 + lane;
#pragma unroll
          for (int t = 0; t < 32; ++t) { const long ro = (long)sgn * t * DIN;
              const float z = bf2f(zf[ro]), e = __expf(-z), sg = __builtin_amdgcn_rcpf(1.0f + e), f = lb + (1.0f - lb) * sg, om = (1.0f - lb) * e * sg;
              lam = fmaxf(lam * f, 1e-30f);
              const float kt = om * __builtin_amdgcn_rcpf(lam);
              if (t & 1) { ktw[(t >> 1) & 3] = ((unsigned)f2bf(kt) << 16) | ktw[(t >> 1) & 3]; } else ktw[(t >> 1) & 3] = (unsigned)f2bf(kt);
              if ((t & 7) == 7) *(PG8_LAS u32x4*)(wl + OFF_KT + lane * KTP + (t >> 3) * 16) = (u32x4){ktw[0], ktw[1], ktw[2], ktw[3]};
              if (PH == 3) { const float zqv = bf2f(zq[ro]), q = zqv * __builtin_amdgcn_rcpf(1.0f + __expf(-zqv)) * 0.125f;
                  *(PG8_LAS bf16_t*)(wl + OFF_QL + t * QP + lane * 2) = f2bf(q * lam); *(PG8_LAS bf16_t*)(wl + OFF_KL + t * QP + lane * 2) = f2bf(kt); } }
          *(PG8_LAS float*)(wl + OFF_LAM + lane * 4) = lam; ptot *= lam; }
        asm volatile("s_waitcnt lgkmcnt(0)" ::: "memory");
        if (PH == 3) {
            bf16x8 qf[4], kf[4];
#pragma unroll
            for (int sl = 0; sl < 4; ++sl) { const int o = (16 * sl + 4 * h) * 2;
                qf[sl] = frag2(*(PG8_LAS u32x2*)(wl + OFF_QL + kk * QP + o), *(PG8_LAS u32x2*)(wl + OFF_QL + kk * QP + o + 16));
                kf[sl] = frag2(*(PG8_LAS u32x2*)(wl + OFF_KL + kk * QP + o), *(PG8_LAS u32x2*)(wl + OFF_KL + kk * QP + o + 16)); }
            f32x16 ct = {};
#pragma unroll
            for (int sl = 0; sl < 4; ++sl) ct = __builtin_amdgcn_mfma_f32_32x32x16_bf16(kf[sl], qf[sl], ct, 0, 0, 0);
#pragma unroll
            for (int r = 0; r < 16; ++r) { const int sr = (r & 3) + 8 * (r >> 2) + 4 * h; if (sr > kk) ct[r] = 0.f; }
            const bf16x8 af0 = accfrag(ct, 0), af1 = accfrag(ct, 1);
            f32x16 o[2] = {{}, {}};
#pragma unroll
            for (int nt = 0; nt < 2; ++nt) {
#pragma unroll
                for (int sl = 0; sl < 4; ++sl) o[nt] = __builtin_amdgcn_mfma_f32_32x32x16_bf16(qf[sl], accfrag(S[sl >> 1][nt], sl & 1), o[nt], 0, 0, 0);
                o[nt] = __builtin_amdgcn_mfma_f32_32x32x16_bf16(af0, vf[0][nt], o[nt], 0, 0, 0);
                o[nt] = __builtin_amdgcn_mfma_f32_32x32x16_bf16(af1, vf[1][nt], o[nt], 0, 0, 0); }
#pragma unroll
            for (int nt = 0; nt < 2; ++nt)
#pragma unroll
                for (int r = 0; r < 16; ++r) { bf16_t* hu = P.HB + ((long)dir * NR + rbase + (long)sgn * ((r & 3) + 8 * (r >> 2))) * 256 + head * 64 + 32 * nt;
                    hu[sgn * 4 * h * 256 + kk] = f2bf(o[nt][r]); }
        }
#pragma unroll
        for (int mt = 0; mt < 2; ++mt) {
            bf16x8 a0, a1; { const int ro = (32 * mt + kk) * KTP + 4 * h * 2;
                a0 = frag2(*(PG8_LAS u32x2*)(wl + OFF_KT + ro), *(PG8_LAS u32x2*)(wl + OFF_KT + ro + 16));
                a1 = frag2(*(PG8_LAS u32x2*)(wl + OFF_KT + ro + 32), *(PG8_LAS u32x2*)(wl + OFF_KT + ro + 48)); }
#pragma unroll
            for (int nt = 0; nt < 2; ++nt) { S[mt][nt] = __builtin_amdgcn_mfma_f32_32x32x16_bf16(a0, vf[0][nt], S[mt][nt], 0, 0, 0); S[mt][nt] = __builtin_amdgcn_mfma_f32_32x32x16_bf16(a1, vf[1][nt], S[mt][nt], 0, 0, 0); }
#pragma unroll
            for (int g = 0; g < 4; ++g) { const f32x4_t lm = *(PG8_LAS f32x4_t*)(wl + OFF_LAM + (32 * mt + 8 * g + 4 * h) * 4);
#pragma unroll
                for (int nt = 0; nt < 2; ++nt) { S[mt][nt][4 * g] *= lm[0]; S[mt][nt][4 * g + 1] *= lm[1]; S[mt][nt][4 * g + 2] *= lm[2]; S[mt][nt][4 * g + 3] *= lm[3]; } } }
        asm volatile("s_waitcnt lgkmcnt(0)" ::: "memory");
    }
    if (PH == 1) {
#pragma unroll
        for (int mt = 0; mt < 2; ++mt)
#pragma unroll
            for (int nt = 0; nt < 2; ++nt)
#pragma unroll
                for (int r = 0; r < 16; ++r) sst[(32 * mt + (r & 3) + 8 * (r >> 2)) * 64 + 32 * nt] = S[mt][nt][r];
        P.PST[(size_t)u * 64 + lane] = ptot; }
}
}

struct GpuExec {
    int wv;
    __device__ __forceinline__ PG8_LAS unsigned char* lds() const { return (PG8_LAS unsigned char*)shm; }
    template <class F> __device__ __forceinline__ void run(i64 n, F f) { const Params& P = fresh_params(); const int G = grid_dim(); const i64 gsz = (i64)G * 512; for (i64 i = ((i64)wv * G + block_id()) * 64 + lane_id(); i < n; i += gsz) f(P, i); }
    __device__ __forceinline__ void sync_soft() {}
    template <class F> __device__ __forceinline__ void run_skipctx(i64 n, F f) { const Params& P = fresh_params(); const int G = grid_dim(), bid = block_id();
        if (G != 256) { for (i64 i = ((i64)wv * G + bid) * 64 + lane_id(); i < n; i += (i64)G * 512) f(P, i); return; }
        if (bid < 128 && (bid & 7) == 0) return;
        const int G2 = 240, rk = bid >= 128 ? bid - 16 : bid - (bid >> 3) - 1;
        for (i64 i = ((i64)wv * G2 + rk) * 64 + lane_id(); i < n; i += (i64)G2 * 512) f(P, i); }
    __device__ __forceinline__ void sync() { XcdBarrier b; b.bar = fresh_params().bar; b.x = xb_xcc_id(); b.st = (volatile LAS unsigned*)(lds() + pg8::STAGE_BYTES); xcd_barrier(b, wv == 0 && lane_id() == 0); }
    template <class F> __device__ __forceinline__ void run_from(int b0, i64 n, F f) {
        const Params& P = fresh_params(); const int G = grid_dim(), bid = block_id(), o = G > b0 ? b0 : 0, G2 = G - o; if (bid < o) return;
        const i64 gsz = (i64)G2 * 512; for (i64 i = ((i64)wv * G2 + (bid - o)) * 64 + lane_id(); i < n; i += gsz) f(P, i); }
    template <class F> __device__ __forceinline__ void run_wave_from(int b0, int n, F f) { const Params& P = fresh_params(); const int lane = lane_id(), G = grid_dim(), bid = block_id(), o = G > 2 * b0 ? b0 : 0, G2 = G - o; if (bid < o) return;
        for (int r = wv * G2 + (bid - o); r < n; r += G2 * 8) f(P, r, lane); }
    template <class F> __device__ __forceinline__ void run_wave(int n, F f) { const Params& P = fresh_params(); const int lane = lane_id(), G = grid_dim(), nw = G * 8; for (int r = wv * G + block_id(); r < n; r += nw) f(P, r, lane); }
    __device__ __forceinline__ void mod() { run_wave(2 * 3 * 96, [&](const Params& P, int w, int lane) { mod_wave(P, w, lane); }); }
    template <int WHICH> __device__ __forceinline__ void norm_phase(int l, int n) { const Params& P = fresh_params(); const int lane = lane_id(), G = grid_dim(), nw = G * 8;
        for (int r = wv * G + block_id(); r < n; r += 4 * nw) norm_rows<4>(P, l, WHICH, r, nw, n, lane, [&](int rr) { return WHICH == 1 ? xsrc_row(P, l, rr) : (const float*)xcur_row(P, rr); }, [&](int rr) { return P.H + (size_t)rr * D; }); }
    __device__ __forceinline__ void norm1(int l) { if (l == 0) norm_phase<1>(l, NR); }
    __device__ __forceinline__ void comb(int l) { CombVec cv; cv.wcur = -1; if (l == 0) run_wave(NR, [&](const Params& P, int r, int lane) { comb_wave<0>(P, r, lane, cv); }); else run_wave(NLAT, [&](const Params& P, int r, int lane) { comb_wave<1>(P, r, lane, cv); }); }
    __device__ __forceinline__ void norm2(int l) { const Params& P = fresh_params(); const int lane = lane_id(), G = grid_dim(), nw = G * 8, n = nrows_out(l);
        for (int r = wv * G + block_id(); r < n; r += 8 * nw) norm_rows16<8>(P, l, r, nw, n, lane, [&](int rr) { return P.H + (size_t)rr * D; }); }
    __device__ __forceinline__ void final_norm() {}
    __device__ __forceinline__ void qkv_prep(int l) { run((i64)NR * 4, [&](const Params& P, i64 i) { st_qkv_prep_k(P, l, i); }); }
    __device__ __forceinline__ void b_pre(int l) {}
    __device__ __forceinline__ void b_scan(int l, int ph) {
        if (ph == 1) run_wave_from(8, 16 * hg::NCHB, [&](const Params& P, int u, int lane) { hg::b_mfma_wave<1>(P, l, u, lane, wv); });
        else if (ph == 2) { if (l == 0) run_skipctx((i64)2 * 2 * 4 * 4096, [&](const Params& P, i64 i) { st_b_scan2<hg::NCHB>(P, l, i); }); else run((i64)2 * 2 * 4 * 4096, [&](const Params& P, i64 i) { st_b_scan2<hg::NCHB>(P, l, i); }); }
        else run_wave(16 * hg::NCHB, [&](const Params& P, int u, int lane) { hg::b_mfma_wave<3>(P, l, u, lane, wv); });
    }
    __device__ __forceinline__ void topk(int l) { const Params& P = fresh_params(); const int lane = lane_id(); for (int it = block_id(); it < (l == 0 ? 4 : 2) * 16; it += grid_dim()) topk_block(P, it, wv, lane, (unsigned*)shm); }
    __device__ __forceinline__ void inproj(int l) {
        const Params& P = fresh_params();
        pg8::StaticOrder S; S.init(NR, DIN, grid_dim(), block_id());
        pg8::EpiZ E{P.Z, DIN};
        pg8::gemm_phase<pg8::EpiZ, pg8::StaticOrder, false>(lds(), pg8::Gemm{P.H, P.WINT, NR, DIN, D}, S, E, nullptr, wv);
    }
    __device__ __forceinline__ void a_coef(int l) {
        const Params& P = fresh_params();
        pg8::StaticOrder S; S.init(NR, 1024, grid_dim(), block_id());
        pg8::EpiCoef E{&P, l};
        pg8::gemm_phase<pg8::EpiCoef, pg8::StaticOrder, false>(lds(), pg8::Gemm{P.XAB, P.WG, NR, 1024, 256}, S, E, nullptr, wv);
    }
    __device__ __forceinline__ void router(int l) {
        const Params& P = fresh_params();
        pg8::StaticOrder S; S.init(nrows_out(l), 256, grid_dim(), block_id());
        pg8::EpiRouter E{P.AFF};
        pg8::gemm_phase<pg8::EpiRouter, pg8::StaticOrder, false>(lds(), pg8::Gemm{P.H, P.RWT, nrows_out(l), 256, D}, S, E, nullptr, wv);
    }
    __device__ __forceinline__ void outproj(int l) {
        const Params& P = fresh_params();
        pg8::StaticOrder S; S.init(nrows_out(l), D, grid_dim(), block_id());
        if (l == 0) { pg8::EpiOut<false> E{P.x, P.ctx, nullptr, P.XB, P.MOD + (size_t)l * 3 * 6 * D};
            pg8::gemm_phase<pg8::EpiOut<false>, pg8::StaticOrder, false>(lds(), pg8::Gemm{P.YM, P.WOUTT, nrows_out(l), D, D}, S, E, nullptr, wv); }
        else { pg8::EpiOut<true> E{nullptr, nullptr, P.XB, P.XB, P.MOD + (size_t)l * 3 * 6 * D};
            pg8::gemm_phase<pg8::EpiOut<true>, pg8::StaticOrder, false>(lds(), pg8::Gemm{P.YM, P.WOUTT, nrows_out(l), D, D}, S, E, nullptr, wv); }
    }
    __device__ __forceinline__ void attn_dense(int l) {
        const Params& P = fresh_params();
        if (P.FLAGS[l]) {
            attn_body::attn_phase<0, 8, true>((char*)shm, (const attn_body::bf16*)P.Z, (attn_body::bf16*)P.YM, wv, nullptr, P.d_qnorm_w + l * 64, P.ROPE);
            if (l == 0) attn_body::attn_phase<3, 8, true>((char*)shm, (const attn_body::bf16*)P.Z, (attn_body::bf16*)P.YM, wv, nullptr, P.d_qnorm_w + l * 64, P.ROPE);
        } else {
            attn_body::attn_phase<0, 8>((char*)shm, (const attn_body::bf16*)P.Z, (attn_body::bf16*)P.YM, wv, nullptr, P.d_qnorm_w + l * 64, P.ROPE);
            if (l == 0) attn_body::attn_phase<3, 8>((char*)shm, (const attn_body::bf16*)P.Z, (attn_body::bf16*)P.YM, wv, nullptr, P.d_qnorm_w + l * 64, P.ROPE);
        }
    }
    __device__ __forceinline__ void attn_win(int l) {
        const Params& P = fresh_params();
        attn_body::attn_phase<1, 8>((char*)shm, (const attn_body::bf16*)P.Z, (attn_body::bf16*)P.YM, wv, P.c_sink + l * 4, nullptr, P.ROPE);
        if (l == 0) attn_body::attn_phase<2, 8>((char*)shm, (const attn_body::bf16*)P.Z, (attn_body::bf16*)P.YM, wv, P.c_sink + l * 4, nullptr, P.ROPE);
    }
    __device__ __forceinline__ void moe1(int l) {
        const Params& P = fresh_params();
        pg8::GroupOrder S; S.init(nslots(l), 8, grid_dim(), block_id());
        pg8::EpiHid E{P.HID};
        pg8::gemm_phase<pg8::EpiHid, pg8::GroupOrder, false, true, true>(lds(), pg8::Gemm{P.H, P.W13T, NE * SLOTS_PAD, NE * 2048, D}, S, E, nullptr, wv, P.ROWLIST);
    }
    __device__ __forceinline__ void moe2(int l) {
        const Params& P = fresh_params();
        pg8::GroupOrder S; S.init(nslots(l), 4, grid_dim(), block_id());
        pg8::EpiY E{P.Y};
        pg8::gemm_phase<pg8::EpiY, pg8::GroupOrder, false, false, true>(lds(), pg8::Gemm{P.HID, P.W2T, NE * SLOTS_PAD, NE * 1024, 1024}, S, E, nullptr, wv);
    }
};

__global__ void __launch_bounds__(512, 2) mega_fwd(Params P) {
    GpuExec ex; ex.wv = __builtin_amdgcn_readfirstlane((int)threadIdx.x >> 6);
    volatile LAS unsigned* xbw = (volatile LAS unsigned*)(ex.lds() + pg8::STAGE_BYTES);
    if (threadIdx.x < 4) xbw[threadIdx.x] = 0u;
    __syncthreads();
    (void)xcd_barrier_post(fresh_params().bar, xbw, threadIdx.x == 0);
    pipeline(ex);
}

extern "C" void kernel_launch(void* const* d_in, const int* in_sizes, int n_in, void* d_out, int out_size, void* d_ws, size_t ws_size, hipStream_t stream) {
    Params P{};
    const float** f = (const float**)&P;
    for (int i = 0; i < 27; ++i) f[i] = (const float*)d_in[i];
    P.out = (float*)d_out;
    const size_t need = carve(P, (char*)d_ws);
    if (need > ws_size) fprintf(stderr, "workspace too small: need %zu have %zu\n", need, ws_size);
    static int grid = 0;
    if (!grid) {
        int dev = 0, cus = 0, per_cu = 0;
        (void)hipGetDevice(&dev);
        (void)hipDeviceGetAttribute(&cus, hipDeviceAttributeMultiprocessorCount, dev);
        (void)hipFuncSetAttribute((const void*)mega_fwd, hipFuncAttributeMaxDynamicSharedMemorySize, LDS_BYTES);
        (void)hipOccupancyMaxActiveBlocksPerMultiprocessor(&per_cu, mega_fwd, 512, LDS_BYTES);
        grid = cus * (per_cu < 1 ? per_cu : 1);
        if (grid <= 0) grid = 256;
    }
    (void)hipMemsetAsync(P.bar, 0, XCD_BAR_WORDS * sizeof(unsigned), stream);
    hipLaunchKernelGGL(mega_fwd, dim3(grid), dim3(512), LDS_BYTES, stream, P);
}
#endif
```

```cpp
#ifndef CPU_TEST
#include <hip/hip_runtime.h>
#include <hip/hip_bf16.h>
#include <cstdio>
#include <cstdint>
#define HD __device__ __forceinline__
#else
#include <cmath>
#include <cstdio>
#include <cstdint>
#include <cstring>
#define HD inline
#endif

#ifndef CFG_SEQ
#define CFG_SEQ 16384
#endif
#ifndef CFG_CTX
#define CFG_CTX 256
#endif

typedef unsigned short bf16_t;
typedef long long i64;

constexpr int NB = 2, L = CFG_SEQ, LC = CFG_CTX, D = 1024, DIN = 2816;
constexpr int NLAT = NB * L, NCTX = NB * LC, NR = NLAT + NCTX;
constexpr int NE = 16, CAP_L = 2 * L / NE, CAP_C = 2 * LC / NE;
constexpr int SLOTS_L = NB * CAP_L, SLOTS_ALL = NB * CAP_L + NB * CAP_C, SLOTS_PAD = ((SLOTS_ALL + 255) / 256) * 256;
constexpr int WINDOW = 128;
constexpr int TOT = LC + L, NCH = 128, CL = TOT / NCH;
static_assert(TOT % NCH == 0, "chunking");
static_assert(NCH % 8 == 0, "scan2 batches");
constexpr float EPS = 1e-6f;
constexpr float QC2 = 0.125f * 1.4426950408889634f;
constexpr int Z_AX = 0, Z_AY = 256, Z_BQ = 512, Z_BFF = 768, Z_BFB = 1024, Z_BI = 1280, Z_BG = 1536,
              Z_CQ = 1792, Z_CK = 2048, Z_CV = 2176, Z_DQ = 2304, Z_DK = 2560, Z_DV = 2688;

struct Params {
    const float *x, *c, *ctx, *c_ctx, *mod_w, *mod_b, *norm1_w, *w_in, *a_conv_w, *a_conv_b, *a_gate_a_w, *a_gate_a_b,
                *a_gate_x_w, *a_gate_x_b, *a_lambda, *b_lb_logits, *b_onorm_w, *c_sink, *d_qnorm_w, *d_knorm_w, *w_out,
                *norm2_w, *router_w, *exp_w1, *exp_w3, *exp_w2, *final_norm_w;
    float* out;
    unsigned* bar;
    float *MOD, *LB, *ROPE, *XC, *AFF, *GATE, *SP8;
    int *ROWLIST, *INV, *FLAGS;
    bf16_t *H, *Z, *YM, *HID, *Y, *XS;
    bf16_t *WINT, *WOUTT, *W13T, *W2T;
    bf16_t *RWT;
    bf16_t *XAB, *WG;
    bf16_t *CA, *CU;
    float *BQ, *BF; bf16_t *HB;
    float *CRA, *CRH, *SST, *PST;
    bf16_t* XB;
};

struct Carver { char* base; size_t off; void* take(size_t bytes) { void* p = base + off; off += (bytes + 255) & ~(size_t)255; return p; } };
inline size_t carve(Params& P, char* ws) {
    Carver c{ws, 0};
    P.bar = (unsigned*)c.take(16384);
    P.MOD = (float*)c.take(sizeof(float) * 2 * 3 * 6 * D);
    P.LB = (float*)c.take(sizeof(float) * 2 * 256);
    P.SP8 = (float*)c.take(sizeof(float) * 2 * 2 * 256);
    P.ROPE = (float*)c.take(sizeof(float) * 256 * 16 * 2);
    P.XC = (float*)c.take(sizeof(float) * (size_t)NCTX * D);
    P.AFF = (float*)c.take(sizeof(float) * (size_t)4 * NE * L);
    P.GATE = (float*)c.take(sizeof(float) * (size_t)NE * SLOTS_PAD);
    P.ROWLIST = (int*)c.take(sizeof(int) * (size_t)NE * SLOTS_PAD);
    P.INV = (int*)c.take(sizeof(int) * (size_t)NR * NE);
    P.FLAGS = (int*)c.take(256);
    P.WINT = (bf16_t*)c.take(2 * (size_t)DIN * D);
    P.WOUTT = (bf16_t*)c.take(2 * (size_t)D * D);
    P.W13T = (bf16_t*)c.take(2 * (size_t)NE * 2048 * D);
    P.W2T = (bf16_t*)c.take(2 * (size_t)NE * D * 1024);
    P.WG = (bf16_t*)c.take(2 * (size_t)1024 * 256);
    P.RWT = (bf16_t*)c.take(2 * (size_t)256 * D);
    P.H = (bf16_t*)c.take(2 * (size_t)NR * D);
    P.YM = P.H;
    const size_t zbytes = 2 * (size_t)NR * DIN, hidbytes = 2 * (size_t)NE * SLOTS_PAD * D;
    char* zreg = (char*)c.take(zbytes > hidbytes ? zbytes : hidbytes);
    P.Z = (bf16_t*)zreg; P.HID = (bf16_t*)zreg;
    const size_t f256 = sizeof(float) * (size_t)NR * 256, h256 = f256 / 2;
    const size_t crbytes = sizeof(float) * 4 * NCH * 256, sstbytes = sizeof(float) * (size_t)16 * NCH * 4096, pstbytes = sizeof(float) * 16 * NCH * 64;
    size_t tbytes = 5 * h256 + 2 * h256 + 2 * crbytes + sstbytes + pstbytes; if (tbytes < hidbytes) tbytes = hidbytes;
    char* treg = (char*)c.take(tbytes);
    P.XAB = (bf16_t*)treg; P.CA = (bf16_t*)(treg + h256); P.CU = (bf16_t*)(treg + 3 * h256); P.HB = (bf16_t*)(treg + 5 * h256);
    { char* q = treg + 5 * h256 + 2 * h256; P.CRA = (float*)q; P.CRH = (float*)(q + crbytes); P.SST = (float*)(q + 2 * crbytes); P.PST = (float*)(q + 2 * crbytes + sstbytes); }
#ifdef CPU_TEST
    P.BQ = (float*)c.take(f256); P.BF = (float*)c.take(2 * f256);
#else
    P.BQ = nullptr; P.BF = nullptr;
#endif
    P.XS = (bf16_t*)treg; P.Y = (bf16_t*)treg;
    P.XB = (bf16_t*)c.take(2 * (size_t)NR * D);
    return c.off;
}

struct alignas(16) U4 { unsigned x, y, z, w; };
struct alignas(16) F4 { float x, y, z, w; };
HD F4 ldnt4(const float* p) {
#if defined(__HIP_DEVICE_COMPILE__)
    typedef float v4f_ __attribute__((ext_vector_type(4))); const v4f_ v = __builtin_nontemporal_load((const v4f_*)p); return F4{v.x, v.y, v.z, v.w};
#else
    return *(const F4*)p;
#endif
}
HD float bf_lo(unsigned u) { union { unsigned u; float f; } c; c.u = u << 16; return c.f; }
HD float bf_hi(unsigned u) { union { unsigned u; float f; } c; c.u = u & 0xffff0000u; return c.f; }
HD unsigned pk2(float lo, float hi);
HD void ld8(const bf16_t* p, float (&v)[8]) { const U4 u = *(const U4*)p; v[0] = bf_lo(u.x); v[1] = bf_hi(u.x); v[2] = bf_lo(u.y); v[3] = bf_hi(u.y); v[4] = bf_lo(u.z); v[5] = bf_hi(u.z); v[6] = bf_lo(u.w); v[7] = bf_hi(u.w); }
HD void ld8f(const float* p, float (&v)[8]) { const F4 a = *(const F4*)p, b = *(const F4*)(p + 4); v[0] = a.x; v[1] = a.y; v[2] = a.z; v[3] = a.w; v[4] = b.x; v[5] = b.y; v[6] = b.z; v[7] = b.w; }
HD void st8f(float* p, const float (&v)[8]) { *(F4*)p = F4{v[0], v[1], v[2], v[3]}; *(F4*)(p + 4) = F4{v[4], v[5], v[6], v[7]}; }
HD float bf2f(bf16_t v) { union { unsigned u; float f; } c; c.u = ((unsigned)v) << 16; return c.f; }
HD bf16_t f2bf(float f) { union { unsigned u; float f; } c; c.f = f; unsigned u = c.u; u += 0x7FFFu + ((u >> 16) & 1u); return (bf16_t)(u >> 16); }
HD unsigned pk2(float lo, float hi) { return (unsigned)f2bf(lo) | ((unsigned)f2bf(hi) << 16); }
HD void st8(bf16_t* p, const float (&v)[8]) { *(U4*)p = U4{pk2(v[0], v[1]), pk2(v[2], v[3]), pk2(v[4], v[5]), pk2(v[6], v[7])}; }
HD float sigmoidf_(float x) { return 1.0f / (1.0f + expf(-x)); }
HD float siluf_(float x) { return x * sigmoidf_(x); }
HD float gelu_tanh_(float x) { return 0.5f * x * (1.0f + tanhf(0.7978845608028654f * (x + 0.044715f * x * x * x))); }

HD int row_who(int row) { return row < NLAT ? row / L : 2; }
HD int row_seg(int row) { return row < NLAT ? row / L : 2 + (row - NLAT) / LC; }
HD int seg_base(int seg) { return seg < 2 ? seg * L : NLAT + (seg - 2) * LC; }
HD int seg_len(int seg) { return seg < 2 ? L : LC; }
HD const float* modv(const Params& P, int l, int who, int part) { return P.MOD + ((size_t)(l * 3 + who) * 6 + part) * D; }
HD const float* xsrc_row(const Params& P, int l, int row) {
    if (row < NLAT) return (l == 0 ? P.x : P.out) + (size_t)row * D;
    return (l == 0 ? P.ctx : P.XC) + (size_t)(row - NLAT) * D;
}
HD float* xcur_row(const Params& P, int row) { return row < NLAT ? P.out + (size_t)row * D : P.XC + (size_t)(row - NLAT) * D; }
HD int nrows_out(int l) { return l == 0 ? NR : NLAT; }
HD int nslots(int l) { return l == 0 ? SLOTS_ALL : SLOTS_L; }

HD void st_mod(const Params& P, i64 i) {
    const int n = (int)(i % (6 * D)), who = (int)((i / (6 * D)) % 3), l = (int)(i / (6 * D) / 3);
    const float* cv = who < 2 ? P.c + who * D : P.c_ctx;
    const float* w = P.mod_w + (size_t)l * D * 6 * D + n;
    float s = 0.f;
    for (int k = 0; k < D; ++k) s += siluf_(cv[k]) * w[(size_t)k * 6 * D];
    P.MOD[i] = s + P.mod_b[l * 6 * D + n];
}
HD void st_lb(const Params& P, i64 i) {
    const float a = P.b_lb_logits[i], b = P.b_lb_logits[256 + i], m = fmaxf(a, b);
    const float ea = expf(a - m), eb = expf(b - m), s0 = ea / (ea + eb), s1 = eb / (ea + eb);
    P.LB[i] = s0 - s0; P.LB[256 + i] = (s0 + s1) - s0;
}
HD void st_flags(const Params& P, i64 l) {
    float mq = 0.f, mk = 0.f; for (int e = 0; e < 64; ++e) { mq = fmaxf(mq, fabsf(P.d_qnorm_w[l * 64 + e])); mk = fmaxf(mk, fabsf(P.d_knorm_w[l * 64 + e])); }
    P.FLAGS[l] = (8.0f * 1.4426950408889634f * mq * mk <= 60.0f) ? 1 : 0;
}
HD void st_sp8(const Params& P, i64 i) {
    P.SP8[i] = -8.0f * log1pf(expf(-P.a_lambda[i]));
}
HD void st_rope(const Params& P, i64 i) {
    const int f = (int)(i & 15), pos = (int)(i >> 4);
    const float inv = (float)exp(-(double)f / 16.0 * 9.210340371976184);
    const float ang = (float)pos * inv;
    double y = (double)ang;
    const double twopi = 6.283185307179586476925;
    y -= twopi * floor(y / twopi + 0.5);
    double s = 0.0, cc = 0.0, term = 1.0;
    for (int n = 0; n < 30; ++n) { if (n & 1) s += ((n >> 1) & 1) ? -term : term; else cc += ((n >> 1) & 1) ? -term : term; term *= y / (double)(n + 1); }
    P.ROPE[i * 2] = (float)cc; P.ROPE[i * 2 + 1] = (float)s;
}

template <class RowFn> HD void cvt_tile(const float* src, size_t ld, int N, size_t K, i64 i, bf16_t* dst, RowFn dst_row) {
    const int li = (int)(i & 63); const i64 w = i >> 6; const int nq = li & 15, kq = li >> 4, ntl = N / 64, nt = (int)(w % ntl), kt = (int)(w / ntl);
    const int n0 = nt * 64 + nq * 4, k0 = kt * 64 + kq * 16;
    float v[16][4];
#pragma unroll
    for (int r = 0; r < 16; ++r) { const F4 t = ldnt4(src + (size_t)(k0 + r) * ld + n0); v[r][0] = t.x; v[r][1] = t.y; v[r][2] = t.z; v[r][3] = t.w; }
#pragma unroll
    for (int j = 0; j < 4; ++j) { bf16_t* d = dst + (size_t)dst_row(n0 + j) * K + k0; float a[8], b[8];
#pragma unroll
        for (int r = 0; r < 8; ++r) { a[r] = v[r][j]; b[r] = v[8 + r][j]; }
        st8(d, a); st8(d + 8, b); }
}
HD void st_cvt_win(const Params& P, int l, i64 i) {
    cvt_tile(P.w_in + (size_t)l * D * DIN, DIN, DIN, D, i, P.WINT, [](int n) { return n; });
}
HD void st_cvt_wout(const Params& P, int l, i64 i) {
    cvt_tile(P.w_out + (size_t)l * D * D, D, D, D, i, P.WOUTT, [](int n) { return n; });
}
HD void st_cvt_w13(const Params& P, int l, i64 i) {
    const int which = (int)((i >> 14) & 1), e = (int)(i >> 15);
    const float* src = (which ? P.exp_w3 : P.exp_w1) + (size_t)(l * NE + e) * D * 1024;
    cvt_tile(src, 1024, 1024, D, i & 16383, P.W13T + (size_t)e * 2048 * D, [which](int f) { return (f >> 7) * 256 + which * 128 + (f & 127); });
}
HD void st_cvt_w2(const Params& P, int l, i64 i) {
    const int e = (int)(i >> 14);
    cvt_tile(P.exp_w2 + (size_t)(l * NE + e) * 1024 * D, D, D, 1024, i & 16383, P.W2T + (size_t)e * D * 1024, [](int n) { return n; });
}

HD void st_norm1(const Params& P, int l, i64 row) {
    const float* x = xsrc_row(P, l, (int)row);
    float ss = 0.f; for (int d = 0; d < D; ++d) ss += x[d] * x[d];
    const float rstd = 1.0f / sqrtf(ss * (1.0f / D) + EPS);
    const int who = row_who((int)row);
    const float *sh = modv(P, l, who, 0), *sc = modv(P, l, who, 1), *w = P.norm1_w + l * D;
    bf16_t* h = P.H + (size_t)row * D;
    for (int d = 0; d < D; ++d) h[d] = f2bf(x[d] * rstd * w[d] * (1.0f + sc[d]) + sh[d]);
}
HD void st_inproj(const Params& P, int l, i64 i) {
    const int n = (int)(i % DIN); const i64 row = i / DIN;
    const bf16_t* h = P.H + (size_t)row * D; const bf16_t* w = P.WINT + (size_t)n * D;
    float s = 0.f; for (int k = 0; k < D; ++k) s += bf2f(h[k]) * bf2f(w[k]);
    P.Z[i] = f2bf(s);
}
HD void st_cvt_wg(const Params& P, int l, i64 i) {
    const int kb = (int)(i & 31), n = (int)(i >> 5), pn = n >> 8, r = n & 255, g = r >> 7, ch = (pn & 1) * 128 + (r & 127), dir = pn >> 1, blk = ch >> 6, j = ch & 63;
    const float* w = (g ? P.a_gate_x_w : P.a_gate_a_w) + ((size_t)((l * 2 + dir) * 4 + blk) * 64) * 64 + j;
    bf16_t* dst = P.WG + (size_t)n * 256 + kb * 8;
    for (int q = 0; q < 8; ++q) { const int k = kb * 8 + q; dst[q] = (k >> 6) == blk ? f2bf(w[(size_t)(k & 63) * 64]) : (bf16_t)0; }
}
HD void st_xa(const Params& P, int l, i64 i) {
    const int c8 = (int)(i & 31) * 8, row = (int)(i >> 5), seg = row_seg(row), t = row - seg_base(seg), len = seg_len(seg);
    float s[8]; ld8f(P.a_conv_b + l * 256 + c8, s);
    for (int j = 0; j < 4; ++j) { const int tt = t + j - 2; if (tt >= 0 && tt < len) { float w[8], x[8]; ld8f(P.a_conv_w + (l * 4 + j) * 256 + c8, w); ld8(P.Z + (size_t)(row + j - 2) * DIN + Z_AX + c8, x);
#pragma unroll
        for (int q = 0; q < 8; ++q) s[q] += w[q] * x[q]; } }
    st8(P.XAB + (size_t)row * 256 + c8, s);
}
HD void a_coef_elem(const Params& P, int l, int dir, float pa, float px, float xa, int ch, float& oma, float& u) {
    const float r = sigmoidf_(pa + P.a_gate_a_b[(l * 2 + dir) * 256 + ch]), ig = sigmoidf_(px + P.a_gate_x_b[(l * 2 + dir) * 256 + ch]);
    const float log_a = -8.0f * r * log1pf(expf(-P.a_lambda[(l * 2 + dir) * 256 + ch]));
    oma = -expm1f(log_a); u = sqrtf(-expm1f(2.0f * log_a)) * (ig * xa);
}
HD void st_a_coef(const Params& P, int l, i64 i) {
    const int ch = (int)(i & 255); const i64 rr = i >> 8; const int row = (int)(rr % NR), dir = (int)(rr / NR);
    const bf16_t* xa = P.XAB + (size_t)row * 256;
    const bf16_t* wa = P.WG + (size_t)((dir * 2 + (ch >> 7)) * 256 + (ch & 127)) * 256; const bf16_t* wx = wa + (size_t)128 * 256;
    float pa = 0.f, px = 0.f;
    for (int k = 0; k < 256; ++k) { const float x = bf2f(xa[k]); pa += x * bf2f(wa[k]); px += x * bf2f(wx[k]); }
    float oma, u; a_coef_elem(P, l, dir, pa, px, bf2f(xa[ch]), ch, oma, u); P.CA[i] = f2bf(oma); P.CU[i] = f2bf(u);
}
HD int scan_row(int b, int dir, int s) {
    if (s < LC) return NLAT + b * LC + (dir ? LC - 1 - s : s);
    const int t = s - LC; return b * L + (dir ? L - 1 - t : t);
}
constexpr int SB = (CL % 10 == 0) ? 10 : ((CL % 6 == 0) ? 6 : 1);
HD void st_a_scan1(const Params& P, int l, i64 i) {
    const int ch = (int)(i & 255), c = (int)((i >> 8) % NCH), bd = (int)((i >> 8) / NCH), dir = bd & 1, b = bd >> 1;
    float h = 0.f, A = 1.f;
    for (int s0 = c * CL; s0 < (c + 1) * CL; s0 += SB) { float av[SB], uv[SB];
#pragma unroll
        for (int q = 0; q < SB; ++q) { const size_t idx = ((size_t)dir * NR + scan_row(b, dir, s0 + q)) * 256 + ch; av[q] = 1.0f - bf2f(P.CA[idx]); uv[q] = bf2f(P.CU[idx]); }
#pragma unroll
        for (int q = 0; q < SB; ++q) { h = av[q] * h + uv[q]; A *= av[q]; } }
    P.CRA[i] = A; P.CRH[i] = h;
}
HD void st_a_scan2(const Params& P, int l, i64 i) {
    const int ch = (int)(i & 255), bd = (int)(i >> 8);
    float carry = 0.f;
    for (int c0 = 0; c0 < NCH; c0 += 8) { float Av[8], hv[8];
#pragma unroll
        for (int q = 0; q < 8; ++q) { const size_t k = ((size_t)bd * NCH + c0 + q) * 256 + ch; Av[q] = P.CRA[k]; hv[q] = P.CRH[k]; }
#pragma unroll
        for (int q = 0; q < 8; ++q) { const size_t k = ((size_t)bd * NCH + c0 + q) * 256 + ch; P.CRH[k] = carry; carry = Av[q] * carry + hv[q]; } }
}
HD void st_a_scan3(const Params& P, int l, i64 i) {
    const int ch = (int)(i & 255), c = (int)((i >> 8) % NCH), bd = (int)((i >> 8) / NCH), dir = bd & 1, b = bd >> 1;
    float h = 0.f;
    for (int c0 = 0; c0 < c; c0 += 8) { float Av[8], hv[8];
#pragma unroll
        for (int q = 0; q < 8; ++q) { const int cc = c0 + q < c ? c0 + q : c - 1; const size_t k = ((size_t)bd * NCH + cc) * 256 + ch; Av[q] = P.CRA[k]; hv[q] = P.CRH[k]; }
#pragma unroll
        for (int q = 0; q < 8; ++q) if (c0 + q < c) h = Av[q] * h + hv[q]; }
    for (int s0 = c * CL; s0 < (c + 1) * CL; s0 += SB) { float av[SB], uv[SB]; size_t ix[SB];
#pragma unroll
        for (int q = 0; q < SB; ++q) { ix[q] = ((size_t)dir * NR + scan_row(b, dir, s0 + q)) * 256 + ch; av[q] = 1.0f - bf2f(P.CA[ix[q]]); uv[q] = bf2f(P.CU[ix[q]]); }
#pragma unroll
        for (int q = 0; q < SB; ++q) { h = av[q] * h + uv[q]; P.CU[ix[q]] = f2bf(h); } }
}
HD void st_a_out(const Params& P, int l, i64 i) {
    const int c8 = (int)(i & 31) * 8; const size_t row = (size_t)(i >> 5);
    float h0[8], h1[8], ay[8], y[8]; ld8(P.CU + row * 256 + c8, h0); ld8(P.CU + ((size_t)NR + row) * 256 + c8, h1); ld8(P.Z + row * DIN + Z_AY + c8, ay);
#pragma unroll
    for (int q = 0; q < 8; ++q) y[q] = (h0[q] + h1[q]) * gelu_tanh_(ay[q]);
    st8(P.YM + row * D + c8, y);
}
HD void st_b_pre(const Params& P, int l, i64 i) {
    const int c8 = (int)(i & 31) * 8; const size_t row = (size_t)(i >> 5);
    float lb[8], q[8], z[8], o[8]; ld8f(P.LB + l * 256 + c8, lb); ld8(P.Z + row * DIN + Z_BQ + c8, q);
#pragma unroll
    for (int k = 0; k < 8; ++k) o[k] = siluf_(q[k]) * 0.125f;
    st8f(P.BQ + row * 256 + c8, o);
    for (int dir = 0; dir < 2; ++dir) { ld8(P.Z + row * DIN + Z_BFF + dir * 256 + c8, z);
#pragma unroll
        for (int k = 0; k < 8; ++k) o[k] = lb[k] + (1.0f - lb[k]) * sigmoidf_(z[k]);
        st8f(P.BF + ((size_t)dir * NR + row) * 256 + c8, o); }
}
HD void st_b_scan1(const Params& P, int l, i64 i) {
    const int v = (int)(i & 63); const i64 u = i >> 6; const int c = (int)(u % NCH), bdh = (int)(u / NCH), head = bdh & 3, dir = (bdh >> 2) & 1, b = bdh >> 3;
    float S[64];
#pragma unroll
    for (int k = 0; k < 64; ++k) S[k] = 0.f;
    float pr = 1.f;
    for (int s = c * CL; s < (c + 1) * CL; ++s) { const size_t row = (size_t)scan_row(b, dir, s);
        const float* f = P.BF + ((size_t)dir * NR + row) * 256 + head * 64; const float vv = bf2f(P.Z[row * DIN + Z_BI + head * 64 + v]);
        pr *= f[v];
#pragma unroll
        for (int k = 0; k < 64; ++k) S[k] = f[k] * (S[k] - vv) + vv; }
    float* sst = P.SST + (size_t)u * 4096;
#pragma unroll
    for (int k = 0; k < 64; ++k) sst[k * 64 + v] = S[k];
    P.PST[u * 64 + v] = pr;
}
template <int NCH_> HD void st_b_scan2(const Params& P, int l, i64 i) {
    constexpr int NCH = NCH_; static_assert(NCH_ % 8 == 0, "scan2 batches");
    const int kv = (int)(i & 4095), bdh = (int)(i >> 12), k = kv >> 6;
    float carry = 0.f;
    float locA[8], ppA[8], locB[8], ppB[8];
#define B2LD(LOC, PP, C0) do { _Pragma("unroll") for (int q = 0; q < 8; ++q) { const int cc = (C0) + q < NCH ? (C0) + q : NCH - 1; const size_t u = (size_t)bdh * NCH + cc; LOC[q] = P.SST[u * 4096 + kv]; PP[q] = P.PST[u * 64 + k]; } } while (0)
#define B2ST(LOC, PP, C0) do { _Pragma("unroll") for (int q = 0; q < 8; ++q) { const size_t u = (size_t)bdh * NCH + (C0) + q; P.SST[u * 4096 + kv] = carry; carry = PP[q] * carry + LOC[q]; } } while (0)
    B2LD(locA, ppA, 0);
    for (int c0 = 0; c0 < NCH; c0 += 16) {
        B2LD(locB, ppB, c0 + 8);
        B2ST(locA, ppA, c0);
        if (c0 + 8 < NCH) { B2LD(locA, ppA, c0 + 16); B2ST(locB, ppB, c0 + 8); }
    }
#undef B2LD
#undef B2ST
}
HD void st_b_scan3(const Params& P, int l, i64 i) {
    const int v = (int)(i & 63); const i64 u = i >> 6; const int c = (int)(u % NCH), bdh = (int)(u / NCH), head = bdh & 3, dir = (bdh >> 2) & 1, b = bdh >> 3;
    float S[64]; const float* sst = P.SST + (size_t)u * 4096;
#pragma unroll
    for (int k = 0; k < 64; ++k) S[k] = sst[k * 64 + v];
    for (int s = c * CL; s < (c + 1) * CL; ++s) { const size_t row = (size_t)scan_row(b, dir, s);
        const float* f = P.BF + ((size_t)dir * NR + row) * 256 + head * 64; const float* q = P.BQ + row * 256 + head * 64;
        const float vv = bf2f(P.Z[row * DIN + Z_BI + head * 64 + v]); float o = 0.f;
#pragma unroll
        for (int k = 0; k < 64; ++k) { S[k] = f[k] * (S[k] - vv) + vv; o += q[k] * S[k]; }
        P.HB[((size_t)dir * NR + row) * 256 + head * 64 + v] = f2bf(o); }
}
HD void st_b_out(const Params& P, int l, i64 i) {
    const int head = (int)(i & 3); const size_t row = (size_t)(i >> 2);
    const bf16_t* o0 = P.HB + row * 256 + head * 64; const bf16_t* o1 = P.HB + ((size_t)NR + row) * 256 + head * 64;
    float o[64]; float ss = 0.f;
#pragma unroll
    for (int g = 0; g < 8; ++g) { float a[8], b[8]; ld8(o0 + g * 8, a); ld8(o1 + g * 8, b);
#pragma unroll
        for (int q = 0; q < 8; ++q) { o[g * 8 + q] = a[q] + b[q]; ss += o[g * 8 + q] * o[g * 8 + q]; } }
    const float rstd = 1.0f / sqrtf(ss * (1.0f / 64.0f) + EPS);
#pragma unroll
    for (int g = 0; g < 8; ++g) { float w[8], gt[8], y[8]; ld8f(P.b_onorm_w + l * 64 + g * 8, w); ld8(P.Z + row * DIN + Z_BG + head * 64 + g * 8, gt);
#pragma unroll
        for (int q = 0; q < 8; ++q) y[q] = o[g * 8 + q] * rstd * w[q] * siluf_(gt[q]);
        st8(P.YM + row * D + 256 + head * 64 + g * 8, y); }
}
HD void st_qkv_prep_rh(const Params& P, int l, int row, int hs) {
    const bool lat = row < NLAT;
    int col; const float* nw = nullptr;
    if (hs < 4) col = Z_CQ + hs * 64; else if (hs < 6) col = Z_CK + (hs - 4) * 64;
    else if (hs < 10) { col = Z_DQ + (hs - 6) * 64; nw = P.d_qnorm_w + l * 64; } else { col = Z_DK + (hs - 10) * 64; nw = P.d_knorm_w + l * 64; }
    if (!lat && !nw && hs >= 4) return;
    bf16_t* p = P.Z + (size_t)row * DIN + col;
    float x[64];
#pragma unroll
    for (int g = 0; g < 8; ++g) { float t8[8]; ld8(p + g * 8, t8);
#pragma unroll
        for (int q = 0; q < 8; ++q) x[g * 8 + q] = t8[q]; }
    if (nw) { float ss = 0.f;
#pragma unroll
        for (int e = 0; e < 64; ++e) ss += x[e] * x[e];
        const float rstd = 1.0f / sqrtf(ss * (1.0f / 64.0f) + EPS);
#pragma unroll
        for (int e = 0; e < 64; ++e) x[e] = x[e] * rstd * nw[e]; }
    if (lat) { const int t = row % L, pr = t / 64, pc = t % 64;
#pragma unroll
        for (int f = 0; f < 16; ++f) {
            { const float c = P.ROPE[(pr * 16 + f) * 2], s = P.ROPE[(pr * 16 + f) * 2 + 1], x1 = x[f], x2 = x[16 + f]; x[f] = x1 * c - x2 * s; x[16 + f] = x2 * c + x1 * s; }
            { const float c = P.ROPE[(pc * 16 + f) * 2], s = P.ROPE[(pc * 16 + f) * 2 + 1], x1 = x[32 + f], x2 = x[48 + f]; x[32 + f] = x1 * c - x2 * s; x[48 + f] = x2 * c + x1 * s; } } }
    const float osc = (hs < 4 || (hs >= 6 && hs < 10)) ? QC2 : 1.0f;
#pragma unroll
    for (int g = 0; g < 8; ++g) { float t8[8];
#pragma unroll
        for (int q = 0; q < 8; ++q) t8[q] = x[g * 8 + q] * osc;
        st8(p + g * 8, t8); }
}
HD void st_qkv_prep(const Params& P, int l, i64 i) { st_qkv_prep_rh(P, l, (int)(i / 12), (int)(i % 12)); }
HD void st_qkv_prep_k(const Params& P, int l, i64 i) { const int kk = (int)(i & 3); st_qkv_prep_rh(P, l, (int)(i >> 2), kk < 2 ? 4 + kk : 8 + kk); }
template <bool LOG2> HD void attn_sweep(const float (&q)[64], const bf16_t* Z, size_t row0, int nkeys, int kcol, int vcol, float& m, float& lsum, float (&acc)[64]) {
    for (int j = 0; j < nkeys; ++j) {
        const U4* kp = (const U4*)(Z + (row0 + j) * DIN + kcol); const U4* vp = (const U4*)(Z + (row0 + j) * DIN + vcol);
        float s = 0.f;
#pragma unroll
        for (int e = 0; e < 8; ++e) { const U4 k4 = kp[e];
            s += q[8 * e] * bf_lo(k4.x) + q[8 * e + 1] * bf_hi(k4.x) + q[8 * e + 2] * bf_lo(k4.y) + q[8 * e + 3] * bf_hi(k4.y) + q[8 * e + 4] * bf_lo(k4.z) + q[8 * e + 5] * bf_hi(k4.z) + q[8 * e + 6] * bf_lo(k4.w) + q[8 * e + 7] * bf_hi(k4.w); }
        if (s > m) { const float sc = LOG2 ? exp2f(m - s) : expf(m - s); lsum *= sc;
#pragma unroll
            for (int e = 0; e < 64; ++e) acc[e] *= sc;
            m = s; }
        const float p = LOG2 ? exp2f(s - m) : expf(s - m); lsum += p;
#pragma unroll
        for (int e = 0; e < 8; ++e) { const U4 v4 = vp[e];
            acc[8 * e] += p * bf_lo(v4.x); acc[8 * e + 1] += p * bf_hi(v4.x); acc[8 * e + 2] += p * bf_lo(v4.y); acc[8 * e + 3] += p * bf_hi(v4.y);
            acc[8 * e + 4] += p * bf_lo(v4.z); acc[8 * e + 5] += p * bf_hi(v4.z); acc[8 * e + 6] += p * bf_lo(v4.w); acc[8 * e + 7] += p * bf_hi(v4.w); }
    }
}
template <int WHICH  >
HD void st_attn(const Params& P, int l, int head, int row) {
    const int kv = head >> 1;
    const int qcol = (WHICH == 0 ? Z_CQ : Z_DQ) + head * 64, kcol = (WHICH == 0 ? Z_CK : Z_DK) + kv * 64, vcol = (WHICH == 0 ? Z_CV : Z_DV) + kv * 64;
    float q[64], acc[64];
#pragma unroll
    for (int e = 0; e < 64; ++e) { q[e] = bf2f(P.Z[(size_t)row * DIN + qcol + e]); acc[e] = 0.f; }
    float m, lsum;
    if (WHICH == 0) { m = P.c_sink[l * 4 + head] * 1.4426950408889634f; lsum = 1.0f; } else { m = -INFINITY; lsum = 0.f; }
    const int seg = row_seg(row), b = seg & 1;
    attn_sweep<true>(q, P.Z, (size_t)seg_base(2 + b), LC, kcol, vcol, m, lsum, acc);
    if (row < NLAT) { const int t = row - b * L; int lo = 0, hi = L - 1;
        if (WHICH == 0) { lo = t - WINDOW < 0 ? 0 : t - WINDOW; hi = t + WINDOW > L - 1 ? L - 1 : t + WINDOW; }
        attn_sweep<true>(q, P.Z, (size_t)b * L + lo, hi - lo + 1, kcol, vcol, m, lsum, acc); }
    const float inv = 1.0f / lsum;
    bf16_t* o = P.YM + (size_t)row * D + (WHICH == 0 ? 512 : 768) + head * 64;
#pragma unroll
    for (int e = 0; e < 64; ++e) o[e] = f2bf(acc[e] * inv);
}
HD void st_outproj(const Params& P, int l, i64 i) {
    const int n = (int)(i & (D - 1)), row = (int)(i >> 10);
    const bf16_t* y = P.YM + (size_t)row * D; const bf16_t* w = P.WOUTT + (size_t)n * D;
    float s = 0.f; for (int k = 0; k < D; ++k) s += bf2f(y[k]) * bf2f(w[k]);
    xcur_row(P, row)[n] = xsrc_row(P, l, row)[n] + modv(P, l, row_who(row), 2)[n] * s;
}
HD void st_norm2(const Params& P, int l, i64 row_) {
    const int row = (int)row_; const float* x = xcur_row(P, row);
    float ss = 0.f; for (int d = 0; d < D; ++d) ss += x[d] * x[d];
    const float rstd = 1.0f / sqrtf(ss * (1.0f / D) + EPS);
    const int who = row_who(row);
    const float *sh = modv(P, l, who, 3), *sc = modv(P, l, who, 4), *w = P.norm2_w + l * D;
    bf16_t* h = P.H + (size_t)row * D;
    for (int d = 0; d < D; ++d) h[d] = f2bf(x[d] * rstd * w[d] * (1.0f + sc[d]) + sh[d]);
}
HD void st_cvt_rw(const Params& P, int l, i64 i) {
    const int kb = (int)(i & 127), n = (int)(i >> 7);
    bf16_t* dst = P.RWT + (size_t)n * D + kb * 8;
    for (int q = 0; q < 8; ++q) dst[q] = n < NE ? f2bf(P.router_w[((size_t)l * D + kb * 8 + q) * NE + n]) : (bf16_t)0;
}
HD void st_router(const Params& P, int l, i64 row_) {
    const int row = (int)row_; const bf16_t* h = P.H + (size_t)row * D;
    float lg[16];
#pragma unroll
    for (int e = 0; e < 16; ++e) { float a = 0.f; const bf16_t* w = P.RWT + (size_t)e * D; for (int d = 0; d < D; ++d) a += bf2f(h[d]) * bf2f(w[d]); lg[e] = a; }
    float mx = lg[0];
#pragma unroll
    for (int e = 1; e < 16; ++e) mx = fmaxf(mx, lg[e]);
    float sum = 0.f;
#pragma unroll
    for (int e = 0; e < 16; ++e) { lg[e] = expf(lg[e] - mx); sum += lg[e]; }
    const int seg = row_seg(row), t = row - seg_base(seg);
#pragma unroll
    for (int e = 0; e < 16; ++e) P.AFF[((size_t)seg * NE + e) * L + t] = lg[e] / sum;
}
HD unsigned f2key(float f) { union { unsigned u; float f; } c; c.f = f; return c.u; }
HD void st_topk(const Params& P, int l, i64 i) {
    const int e = (int)(i & 15), seg = (int)(i >> 4), N = seg_len(seg), cap = 2 * N / NE;
    const float* a = P.AFF + ((size_t)seg * NE + e) * L;
    unsigned lo = 0u, hi = 0x7f800001u;
    while (hi - lo > 1u) { const unsigned mid = lo + ((hi - lo) >> 1); int cnt = 0; for (int t = 0; t < N; ++t) cnt += f2key(a[t]) >= mid ? 1 : 0; if (cnt >= cap) lo = mid; else hi = mid; }
    int gt = 0; for (int t = 0; t < N; ++t) gt += f2key(a[t]) > lo ? 1 : 0;
    int ties = cap - gt, slot = (seg < 2 ? seg * CAP_L : 2 * CAP_L + (seg - 2) * CAP_C);
    const int base = seg_base(seg);
    for (int t = 0; t < N; ++t) { const unsigned k = f2key(a[t]); bool sel = k > lo; if (k == lo && ties > 0) { sel = true; --ties; }
        if (sel) { P.ROWLIST[e * SLOTS_PAD + slot] = base + t; P.GATE[e * SLOTS_PAD + slot] = a[t]; P.INV[(size_t)e * NR + base + t] = slot; ++slot; }
        else P.INV[(size_t)e * NR + base + t] = -1; }
}
HD void st_gather(const Params& P, int l, i64 i) {
    const int c = (int)(i & 127); const i64 es = i >> 7; const int ns = nslots(l), slot = (int)(es % ns), e = (int)(es / ns);
    const int row = P.ROWLIST[e * SLOTS_PAD + slot];
    const bf16_t* src = P.H + (size_t)row * D + c * 8; bf16_t* dst = P.XS + ((size_t)e * SLOTS_PAD + slot) * D + c * 8;
    *(U4*)dst = *(const U4*)src;
}
HD void st_moe1(const Params& P, int l, i64 i) {
    const int f = (int)(i & 1023); const i64 es = i >> 10; const int ns = nslots(l), slot = (int)(es % ns), e = (int)(es / ns);
    const bf16_t* h = P.H + (size_t)P.ROWLIST[e * SLOTS_PAD + slot] * D;
    const bf16_t* w1 = P.W13T + ((size_t)e * 2048 + (f >> 7) * 256 + (f & 127)) * D; const bf16_t* w3 = w1 + (size_t)128 * D;
    float a1 = 0.f, a3 = 0.f;
    for (int d = 0; d < D; ++d) { const float hv = bf2f(h[d]); a1 += hv * bf2f(w1[d]); a3 += hv * bf2f(w3[d]); }
    P.HID[((size_t)e * SLOTS_PAD + slot) * 1024 + f] = f2bf(siluf_(a1) * a3);
}
HD void st_moe2(const Params& P, int l, i64 i) {
    const int d = (int)(i & 1023); const i64 es = i >> 10; const int ns = nslots(l), slot = (int)(es % ns), e = (int)(es / ns);
    const bf16_t* hid = P.HID + ((size_t)e * SLOTS_PAD + slot) * 1024;
    const bf16_t* w2 = P.W2T + ((size_t)e * D + d) * 1024;
    float s = 0.f; for (int f = 0; f < 1024; ++f) s += bf2f(hid[f]) * bf2f(w2[f]);
    P.Y[((size_t)e * SLOTS_PAD + slot) * D + d] = f2bf(s);
}
HD void st_moe_comb(const Params& P, int l, i64 i) {
    const int d8 = (int)(i & 127) * 8, row = (int)(i >> 7);
    float acc[8];
#pragma unroll
    for (int q = 0; q < 8; ++q) acc[q] = 0.f;
    for (int e = 0; e < NE; ++e) { const int s = P.INV[(size_t)e * NR + row]; if (s >= 0) { const float g = P.GATE[e * SLOTS_PAD + s]; float y[8]; ld8(P.Y + ((size_t)e * SLOTS_PAD + s) * D + d8, y);
#pragma unroll
        for (int q = 0; q < 8; ++q) acc[q] += g * y[q]; } }
    float x[8], m[8]; float* xp = xcur_row(P, row) + d8; ld8f(xp, x); ld8f(modv(P, l, row_who(row), 5) + d8, m);
#pragma unroll
    for (int q = 0; q < 8; ++q) x[q] += m[q] * acc[q];
    st8f(xp, x);
}
HD void st_final(const Params& P, i64 row) {
    float* x = P.out + (size_t)row * D;
    float ss = 0.f; for (int d = 0; d < D; ++d) ss += x[d] * x[d];
    const float rstd = 1.0f / sqrtf(ss * (1.0f / D) + EPS);
    for (int d = 0; d < D; ++d) x[d] = x[d] * rstd * P.final_norm_w[d];
}

template <int LYR, class E> HD void layer_body(E& ex) {
    constexpr int l = LYR;
        const int nro = nrows_out(l);
        ex.run((i64)(D / 16) * (DIN / 4), [&](const Params& P, i64 i) { st_cvt_win(P, l, i); });
        ex.run((i64)(D / 16) * (D / 4), [&](const Params& P, i64 i) { st_cvt_wout(P, l, i); });
        ex.run((i64)1024 * 32, [&](const Params& P, i64 i) { st_cvt_wg(P, l, i); });
        ex.run((i64)256 * 128, [&](const Params& P, i64 i) { st_cvt_rw(P, l, i); });
        if (l == 0) ex.sync();
        ex.norm1(l); ex.sync();
        constexpr i64 n13 = (i64)NE * 2 * 16384, n2 = (i64)NE * 16384, NTC = n13 + n2, A1 = 162816, A2 = (l == 0) ? 380928 : 0;
        auto cvt_any = [&](const Params& P, i64 i) { if (i < n13) st_cvt_w13(P, l, i); else st_cvt_w2(P, l, i - n13); };
        ex.inproj(l); ex.run_from(150, A1, [&](const Params& P, i64 i) { cvt_any(P, i); }); ex.sync();
        ex.xa(l);
        ex.qkv_prep(l);
        ex.b_pre(l); ex.sync();
        ex.a_coef(l); ex.b_scan(l, 1); ex.sync();
        if (l == 0) ex.run_skipctx((i64)2 * 2 * NCH * 256, [&](const Params& P, i64 i) { st_a_scan1(P, l, i); });
        else ex.run((i64)2 * 2 * NCH * 256, [&](const Params& P, i64 i) { st_a_scan1(P, l, i); });
        ex.b_scan(l, 2);
        ex.attn_win(l); ex.attn_dense(l); ex.sync();
        ex.run((i64)2 * 2 * NCH * 256, [&](const Params& P, i64 i) { st_a_scan3(P, l, i); });
        ex.b_scan(l, 3); ex.sync();
        ex.run((i64)nro * 32, [&](const Params& P, i64 i) { st_a_out(P, l, i); });
        ex.run((i64)nro * 4, [&](const Params& P, i64 i) { st_b_out(P, l, i); }); ex.sync();
        ex.outproj(l); if (l == 0) ex.run_from(8, A2, [&](const Params& P, i64 i) { cvt_any(P, A1 + i); }); ex.sync();
        ex.norm2(l);
        ex.run((i64)NE * SLOTS_PAD, [&](const Params& P, i64 i) { P.ROWLIST[i] = 0; }); ex.sync();
        constexpr i64 AR = 129024;
        ex.router(l); ex.run_from(130, AR, [&](const Params& P, i64 i) { cvt_any(P, A1 + A2 + i); }); ex.sync();
        ex.topk(l);
        { constexpr i64 B0 = A1 + A2 + AR, rest = NTC - B0, cap = ((NTC * 21 / 100) & ~(i64)63), A3 = rest < cap ? rest : cap; const int b0 = (l == 0 ? 4 : 2) * 16;
          ex.run_from(b0, A3, [&](const Params& P, i64 i) { cvt_any(P, B0 + i); });
          ex.run(rest - A3, [&](const Params& P, i64 i) { cvt_any(P, B0 + A3 + i); }); }
        ex.sync();
        ex.moe1(l); ex.sync();
        ex.moe2(l); ex.sync();
        ex.comb(l); ex.sync_soft();
}
template <class E> HD void pipeline(E& ex) {
    {
    ex.mod();
    ex.run(256, [&](const Params& P, i64 i) { st_lb(P, i); });
    ex.run(2, [&](const Params& P, i64 i) { st_flags(P, i); });
    ex.run(2 * 2 * 256, [&](const Params& P, i64 i) { st_sp8(P, i); });
    ex.run(256 * 16, [&](const Params& P, i64 i) { st_rope(P, i); });
    }
    layer_body<0>(ex);
    layer_body<1>(ex);
    ex.final_norm();
}
template <class E> HD void naive_inproj(int l, E& ex) { ex.run((i64)NR * DIN, [&](const Params& P, i64 i) { st_inproj(P, l, i); }); }
template <class E> HD void naive_outproj(int l, E& ex) { ex.run((i64)nrows_out(l) * D, [&](const Params& P, i64 i) { st_outproj(P, l, i); }); }
template <class E> HD void naive_moe1(int l, E& ex) { ex.run((i64)NE * nslots(l) * 1024, [&](const Params& P, i64 i) { st_moe1(P, l, i); }); }
template <class E> HD void naive_attn_win(int l, E& ex, int row0, int nrows) { ex.run((i64)4 * nrows, [&](const Params& P, i64 i) { st_attn<0>(P, l, (int)(i / nrows), row0 + (int)(i % nrows)); }); }
template <class E> HD void naive_attn_dense(int l, E& ex, int row0, int nrows) { ex.run((i64)4 * nrows, [&](const Params& P, i64 i) { st_attn<1>(P, l, (int)(i / nrows), row0 + (int)(i % nrows)); }); }
template <class E> HD void naive_qkv_prep(int l, E& ex) { ex.run((i64)NR * 12, [&](const Params& P, i64 i) { st_qkv_prep(P, l, i); }); }
template <class E> HD void naive_xa(int l, E& ex) { ex.run((i64)NR * 32, [&](const Params& P, i64 i) { st_xa(P, l, i); }); }
template <class E> HD void naive_b_pre(int l, E& ex) { ex.run((i64)NR * 32, [&](const Params& P, i64 i) { st_b_pre(P, l, i); }); }
template <class E> HD void naive_b_scan(int l, int ph, E& ex) { if (ph == 2) ex.run((i64)2 * 2 * 4 * 4096, [&](const Params& P, i64 i) { st_b_scan2<NCH>(P, l, i); }); else if (ph == 1) ex.run((i64)2 * 2 * 4 * NCH * 64, [&](const Params& P, i64 i) { st_b_scan1(P, l, i); }); else ex.run((i64)2 * 2 * 4 * NCH * 64, [&](const Params& P, i64 i) { st_b_scan3(P, l, i); }); }
template <class E> HD void naive_a_coef(int l, E& ex) { ex.run((i64)2 * NR * 256, [&](const Params& P, i64 i) { st_a_coef(P, l, i); }); }
template <class E> HD void naive_comb(int l, E& ex) { ex.run((i64)nrows_out(l) * 128, [&](const Params& P, i64 i) { st_moe_comb(P, l, i); }); }
template <class E> HD void naive_mod(E& ex) { ex.run((i64)2 * 3 * 6 * D, [&](const Params& P, i64 i) { st_mod(P, i); }); }
template <class E> HD void naive_norm1(int l, E& ex) { ex.run(NR, [&](const Params& P, i64 i) { st_norm1(P, l, i); }); }
template <class E> HD void naive_norm2(int l, E& ex) { ex.run(nrows_out(l), [&](const Params& P, i64 i) { st_norm2(P, l, i); }); }
template <class E> HD void naive_router(int l, E& ex) { ex.run(nrows_out(l), [&](const Params& P, i64 i) { st_router(P, l, i); }); }
template <class E> HD void naive_topk(int l, E& ex) { ex.run((l == 0 ? 4 : 2) * 16, [&](const Params& P, i64 i) { st_topk(P, l, i); }); }
template <class E> HD void naive_final(E& ex) { ex.run(NLAT, [&](const Params& P, i64 i) { st_final(P, i); }); }
template <class E> HD void naive_moe2(int l, E& ex) { ex.run((i64)NE * nslots(l) * 1024, [&](const Params& P, i64 i) { st_moe2(P, l, i); }); }

#ifndef CPU_TEST
__device__ __forceinline__ int lane_id() { int l; asm volatile("v_mbcnt_lo_u32_b32 %0, -1, 0\n\tv_mbcnt_hi_u32_b32 %0, -1, %0" : "=v"(l)); return l; }
__device__ __forceinline__ int grid_dim() { int g = (int)gridDim.x; asm volatile("" : "+s"(g)); return g; }
__device__ __forceinline__ int block_id() { int b = (int)blockIdx.x; asm volatile("" : "+s"(b)); return b; }
#define XB_TMO      128
#define XB_XCNT(j)  (256  + 64 * (j))
#define XB_XSUB(j)  (1280 + 64 * (j))
#define XB_XGEN(j)  (2304 + 64 * (j))
#define XB_TOP      3328
#define XB_TOPGEN   3392
#define XCD_BAR_WORDS 3456
#define XB_SPIN_CAP (1u << 27)
#define LAS __attribute__((address_space(3)))

__device__ __forceinline__ unsigned xb_ld(unsigned* p)              { return __hip_atomic_load(p, __ATOMIC_RELAXED, __HIP_MEMORY_SCOPE_AGENT); }
__device__ __forceinline__ unsigned xb_add(unsigned* p, unsigned v) { return __hip_atomic_fetch_add(p, v, __ATOMIC_RELAXED, __HIP_MEMORY_SCOPE_AGENT); }
__device__ __forceinline__ unsigned xb_xcc_id() { return (unsigned)__builtin_amdgcn_s_getreg((3 << 11) | 20) & 0xFu; }
#define XB_SPIN(cond, bar) do { unsigned _sp = 0; while (cond) { __builtin_amdgcn_s_sleep(1); \
    if ((++_sp & 255u) == 0u) { if (xb_ld(&(bar)[XB_TMO])) break; if (_sp > XB_SPIN_CAP) { atomicAdd(&(bar)[XB_TMO], 1u); break; } } } } while (0)

struct XcdBarrier { unsigned* bar; unsigned x; volatile LAS unsigned* st; };

__device__ __forceinline__ XcdBarrier xcd_barrier_post(unsigned* bar, volatile LAS unsigned* st, bool leader) {
    XcdBarrier b; b.bar = bar; b.x = xb_xcc_id(); b.st = st;
    if (leader) (void)xb_add(&bar[XB_XCNT(b.x)], 1u);
    return b;
}
__device__ __forceinline__ void xcd_barrier_complete(unsigned* bar, unsigned x, unsigned& nloc, unsigned& nx) {
    const unsigned G = gridDim.x * gridDim.y * gridDim.z;
    unsigned sum, cnt, mine, sp = 0u;
    for (;;) {
        sum = 0u; cnt = 0u; mine = 0u;
#pragma unroll
        for (unsigned j = 0; j < 16; ++j) { const unsigned c = xb_ld(&bar[XB_XCNT(j)]); sum += c; cnt += (c > 0u) ? 1u : 0u; mine = (j == x) ? c : mine; }
        if (sum == G) break;
        __builtin_amdgcn_s_sleep(1);
        if ((++sp & 255u) == 0u) { if (xb_ld(&bar[XB_TMO])) break; if (sp > XB_SPIN_CAP) { atomicAdd(&bar[XB_TMO], 1u); break; } }
    }
    nloc = mine > 0u ? mine : 1u; nx = cnt > 0u ? cnt : 1u;
}
__device__ __forceinline__ void xcd_barrier(const XcdBarrier& b, bool leader) {
    asm volatile("s_waitcnt vmcnt(0)" ::: "memory");
    __syncthreads();
    if (leader) {
        unsigned* bar = b.bar;
        __builtin_amdgcn_s_waitcnt(0);
        unsigned nloc = b.st[0], nx = b.st[1];
        if (nloc == 0u) { xcd_barrier_complete(bar, b.x, nloc, nx); b.st[0] = nloc; b.st[1] = nx; }
        const unsigned old = xb_add(&bar[XB_XSUB(b.x)], 1u);
        const unsigned gen = old / nloc;
        if (old + 1u == (gen + 1u) * nloc) {
            __builtin_amdgcn_fence(__ATOMIC_RELEASE, "agent");
            asm volatile("s_waitcnt vmcnt(0)" ::: "memory");
            const unsigned og = xb_add(&bar[XB_TOP], 1u);
            const unsigned tg = og / nx;
            if (og + 1u == (tg + 1u) * nx) xb_add(&bar[XB_TOPGEN], 1u);
            else XB_SPIN(xb_ld(&bar[XB_TOPGEN]) == tg, bar);
            __builtin_amdgcn_fence(__ATOMIC_ACQUIRE, "agent");
            xb_add(&bar[XB_XGEN(b.x)], 1u);
            asm volatile("s_waitcnt vmcnt(0)" ::: "memory");
        } else {
            XB_SPIN(xb_ld(&bar[XB_XGEN(b.x)]) == gen, bar);
            __builtin_amdgcn_fence(__ATOMIC_ACQUIRE, "agent");
            asm volatile("s_waitcnt vmcnt(0)" ::: "memory");
        }
    }
    __syncthreads();
}

namespace pg8 {
#define PG8_LAS __attribute__((address_space(3)))
typedef unsigned short bf16_t;
typedef short bf16x8 __attribute__((ext_vector_type(8)));
typedef float f32x4 __attribute__((ext_vector_type(4)));
typedef unsigned u32x4 __attribute__((ext_vector_type(4)));
constexpr int BM = 256, BK = 64, HALF = 128, HTB = HALF * BK * 2  , STAGE_BYTES = 8 * HTB, NXCD = 8, WGM = 8;

__host__ __device__ __forceinline__ int lds_byte(int r, int c) { const int st = (r >> 4) * 2 + (c >> 5), rr = r & 15, cc = c & 31, ob = rr * 64 + cc * 2; return st * 1024 + (ob ^ (((ob >> 9) & 1) << 5)); }
__host__ __device__ __forceinline__ void stage_rc(int b, int& R, int& C) { const int st = b / 1024, sb = b % 1024, swz = sb ^ (((sb >> 9) & 1) << 5); R = (st >> 1) * 16 + swz / 64; C = (st & 1) * 32 + (swz % 64) / 2; }
__host__ __device__ __forceinline__ int perm32(int rho) { const int n = rho >> 4, i = rho & 15; return 8 * (i >> 2) + 4 * n + (i & 3); }

struct Unit { int pm, pn; };
struct Gemm { const bf16_t* A; const bf16_t* Bt; int M, N, K; };

struct StaticOrder {
    int nM, nN, nwg, G, c;
    __host__ __device__ void init(int M, int N, int G_, int c_) { nM = M / BM; nN = N / BM; nwg = nM * nN; G = G_; c = c_; }
    __host__ __device__ bool next(int i, Unit& u) const {
        const long L = (long)i * G + c; if (L >= nwg) return false;
        int wgid = (int)L; { const int q = nwg / NXCD, r = nwg % NXCD, xcd = wgid % NXCD, off = wgid / NXCD; wgid = (xcd < r ? xcd * (q + 1) : r * (q + 1) + (xcd - r) * q) + off; }
        const int nig = WGM * nN, gid = wgid / nig, fm = gid * WGM, gsz = (nM - fm) < WGM ? (nM - fm) : WGM;
        u.pm = fm + ((wgid % nig) % gsz); u.pn = (wgid % nig) / gsz; return true;
    }
    __device__ __forceinline__ void a_ready(const Unit&) const {}
    __device__ __forceinline__ void done(const Unit&) const {}
};
__device__ __forceinline__ unsigned cvt_pk_bf16(float lo, float hi) { unsigned r; asm volatile("v_cvt_pk_bf16_f32 %0, %1, %2" : "=v"(r) : "v"(lo), "v"(hi)); return r; }
typedef float f32x2 __attribute__((ext_vector_type(2)));
template <class Epi, class Sched, bool STAMP = false, bool GATHER = false, bool HALFU = false>
__device__ __forceinline__ void gemm_phase(PG8_LAS unsigned char* lds, const Gemm g, const Sched& S, const Epi& E, unsigned long long* stamps, int wv, const int* rowlist = nullptr) {
    int tid_ = wv * 64 + lane_id(); asm volatile("" : "+v"(tid_));
    const int tid = tid_, wid = __builtin_amdgcn_readfirstlane(tid >> 6), lane = tid & 63, wr = wid >> 2, wc = wid & 3, fr = lane & 15, fq = lane >> 4;
    const int K = g.K, nt = K / BK;
    int ts_lo = 0, ts_hi = 0, nts = 0; const unsigned long long rt_entry = STAMP ? (unsigned long long)wall_clock64() : 0ull;
#define PG8_STAMP() do { if (STAMP && wid == 0 && nts < 64) { const unsigned long long _c = (unsigned long long)clock64(); \
        ts_lo = (lane == nts) ? (int)(unsigned)_c : ts_lo; ts_hi = (lane == nts) ? (int)(unsigned)(_c >> 32) : ts_hi; ++nts; } } while (0)
    PG8_STAMP();
    unsigned voffA[2], voffB[2]; int RA[2]; unsigned CBy[2];
#pragma unroll
    for (int i = 0; i < 2; ++i) { int R, C; stage_rc(tid * 16 + i * 8192, R, C); const int Rb = Epi::PERM ? ((R & ~31) + perm32(R & 31)) : R;
        voffA[i] = (unsigned)(R * K + C) * 2u; voffB[i] = (unsigned)(Rb * K + C) * 2u; RA[i] = R; CBy[i] = (unsigned)C * 2u; }
    unsigned goff[2][2] = {{0u, 0u}, {0u, 0u}}, noff[2][2] = {{0u, 0u}, {0u, 0u}};
#define PG8_LOADOFF(dst, U) do { if (GATHER) { _Pragma("unroll") for (int h_ = 0; h_ < 2; ++h_) _Pragma("unroll") for (int i_ = 0; i_ < 2; ++i_) \
        dst[h_][i_] = (unsigned)rowlist[(U).pm * BM + h_ * HALF + RA[i_]] * (unsigned)(K * 2) + CBy[i_]; } } while (0)
#define PG8_STAGE_A(bufoff, base, h, nx) do { if (GATHER) { const unsigned so_[2] = {(nx) ? noff[h][0] : goff[h][0], (nx) ? noff[h][1] : goff[h][1]}; PG8_STAGE(bufoff, base, so_); } \
        else PG8_STAGE(bufoff, (base) + ((h) ? hstep : 0), voffA); } while (0)
    const size_t kstep = (size_t)(BK * 2);
    const size_t hstep = (size_t)HALF * K * 2;
    const size_t tstep = 2 * hstep;
    const unsigned ldsw = (unsigned)wid * 1024u;
    const int aoff = lds_byte(wr * 64 + fr, fq * 8), boff = lds_byte(wc * 32 + fr, fq * 8);
#define PG8_SA(b, h) (((b) * 2 + (h)) * HTB)
#define PG8_SB(b, h) ((4 + (b) * 2 + (h)) * HTB)
#define PG8_STAGE(bufoff, gbase, voff) do { _Pragma("unroll") for (int _i = 0; _i < 2; ++_i) \
        __builtin_amdgcn_global_load_lds((const unsigned*)((const char*)(gbase) + (voff)[_i]), (PG8_LAS unsigned*)(lds + (bufoff) + ldsw + _i * 8192), 16, 0, 0); } while (0)
#define PG8_LDA(dst, b, h) do { _Pragma("unroll") for (int m = 0; m < 4; ++m) _Pragma("unroll") for (int k = 0; k < 2; ++k) dst[m][k] = *(const PG8_LAS bf16x8*)(lds + PG8_SA(b, h) + aoff + m * 2048 + k * 1024); } while (0)
#define PG8_LDB(dst, b, h) do { _Pragma("unroll") for (int n = 0; n < 2; ++n) _Pragma("unroll") for (int k = 0; k < 2; ++k) dst[n][k] = *(const PG8_LAS bf16x8*)(lds + PG8_SB(b, h) + boff + n * 2048 + k * 1024); } while (0)
#define PG8_MMA(ai, bj, At, Bt) do { __builtin_amdgcn_s_setprio(1); _Pragma("unroll") for (int m = 0; m < 4; ++m) _Pragma("unroll") for (int n = 0; n < 2; ++n) _Pragma("unroll") for (int k = 0; k < 2; ++k) \
        acc[ai][bj][m][n] = __builtin_amdgcn_mfma_f32_16x16x32_bf16(Bt[n][k], At[m][k], acc[ai][bj][m][n], 0, 0, 0); __builtin_amdgcn_s_setprio(0); } while (0)
#define PG8_WAIT_V(n) asm volatile("s_waitcnt vmcnt(" #n ")" ::: "memory")
#define PG8_WAIT_L(n) asm volatile("s_waitcnt lgkmcnt(" #n ")" ::: "memory")
#define PG8_BAR __builtin_amdgcn_s_barrier()
#define PG8_SCHED __builtin_amdgcn_sched_barrier(0)
    Unit cur, nxt; int ui = 0;
    if (!S.next(0, cur)) return;
    f32x4 acc[2][2][4][2];
#pragma unroll
    for (int a = 0; a < 2; ++a)
#pragma unroll
        for (int b = 0; b < 2; ++b)
#pragma unroll
            for (int m = 0; m < 4; ++m)
#pragma unroll
                for (int n = 0; n < 2; ++n) acc[a][b][m][n] = (f32x4){0.f, 0.f, 0.f, 0.f};
    bf16x8 At[4][2], B0[2][2], B1[2][2];
    const char* cA = (const char*)g.A + (GATHER ? (size_t)0 : (size_t)cur.pm * tstep); const char* cB = (const char*)g.Bt + (size_t)cur.pn * tstep;
    PG8_LOADOFF(goff, cur);
    S.a_ready(cur);
    PG8_STAGE(PG8_SB(0, 0), cB, voffB); PG8_STAGE_A(PG8_SA(0, 0), cA, 0, false); PG8_STAGE(PG8_SB(0, 1), cB + hstep, voffB); PG8_STAGE_A(PG8_SA(0, 1), cA, 1, false);
    if (wr == 1) PG8_BAR;
    PG8_WAIT_V(4); PG8_BAR;
    PG8_STAGE(PG8_SB(1, 0), cB + kstep, voffB); PG8_STAGE_A(PG8_SA(1, 0), cA + kstep, 0, false); PG8_STAGE(PG8_SB(1, 1), cB + hstep + kstep, voffB);
    PG8_WAIT_V(6); PG8_BAR;
    PG8_STAMP();
    for (;;) {
        const bool has_next = S.next(ui + 1, nxt);
        bool hu = false; if constexpr (HALFU) hu = S.is_half(cur);
        const char* nA = (has_next && !GATHER) ? (const char*)g.A + (size_t)nxt.pm * tstep : cA; const char* nB = has_next ? (const char*)g.Bt + (size_t)nxt.pn * tstep : cB;
        if (GATHER) { if (has_next) PG8_LOADOFF(noff, nxt); else { noff[0][0] = goff[0][0]; noff[0][1] = goff[0][1]; noff[1][0] = goff[1][0]; noff[1][1] = goff[1][1]; } }
        for (int t = 0; t < nt; t += 2) {
            const bool last = (t == nt - 2);
            const char* a1 = cA + (size_t)(t + 1) * kstep;
            const char* a2 = last ? nA : cA + (size_t)(t + 2) * kstep; const char* b2 = last ? nB : cB + (size_t)(t + 2) * kstep;
            const char* a3 = a2 + kstep; const char* b3 = b2 + kstep;
            if (last && has_next) S.a_ready(nxt);
            PG8_LDB(B0, 0, 0); PG8_SCHED; PG8_LDA(At, 0, 0); PG8_STAGE_A(PG8_SA(1, 1), a1, 1, false);
            PG8_WAIT_L(8); PG8_BAR; PG8_WAIT_L(0); PG8_MMA(0, 0, At, B0); PG8_BAR; PG8_SCHED;
            PG8_LDB(B1, 0, 1); PG8_STAGE(PG8_SB(0, 0), b2, voffB);
            PG8_BAR; PG8_WAIT_L(0); PG8_MMA(0, 1, At, B1); PG8_BAR;
            if (!hu) PG8_LDA(At, 0, 1); PG8_STAGE_A(PG8_SA(0, 0), a2, 0, last);
            PG8_BAR; PG8_WAIT_L(0); if (!hu) PG8_MMA(1, 0, At, B0); PG8_BAR; PG8_SCHED;
            PG8_STAGE(PG8_SB(0, 1), b2 + hstep, voffB);
            PG8_WAIT_V(6); PG8_BAR; if (!hu) PG8_MMA(1, 1, At, B1); PG8_BAR;
            PG8_LDB(B0, 1, 0); PG8_SCHED; PG8_LDA(At, 1, 0); PG8_STAGE_A(PG8_SA(0, 1), a2, 1, last);
            PG8_WAIT_L(8); PG8_BAR; PG8_WAIT_L(0); PG8_MMA(0, 0, At, B0); PG8_BAR; PG8_SCHED;
            PG8_LDB(B1, 1, 1); PG8_STAGE(PG8_SB(1, 0), b3, voffB);
            PG8_BAR; PG8_WAIT_L(0); PG8_MMA(0, 1, At, B1); PG8_BAR;
            if (!hu) PG8_LDA(At, 1, 1); PG8_STAGE_A(PG8_SA(1, 0), a3, 0, last);
            PG8_BAR; PG8_WAIT_L(0); if (!hu) PG8_MMA(1, 0, At, B0); PG8_BAR; PG8_SCHED;
            PG8_STAGE(PG8_SB(1, 1), b3 + hstep, voffB);
            PG8_WAIT_V(6); PG8_BAR; if (!hu) PG8_MMA(1, 1, At, B1); PG8_BAR;
        }
        PG8_STAMP();
        if constexpr (!Epi::AFTER_DRAIN) { E(acc, cur, wr, wc, fr, fq); S.done(cur); }
        PG8_STAMP();
        if (!has_next) break;
#pragma unroll
        for (int a = 0; a < 2; ++a)
#pragma unroll
            for (int b = 0; b < 2; ++b)
#pragma unroll
                for (int m = 0; m < 4; ++m)
#pragma unroll
                    for (int n = 0; n < 2; ++n) acc[a][b][m][n] = (f32x4){0.f, 0.f, 0.f, 0.f};
        cur = nxt; cA = nA; cB = nB; ++ui;
        if (GATHER) { goff[0][0] = noff[0][0]; goff[0][1] = noff[0][1]; goff[1][0] = noff[1][0]; goff[1][1] = noff[1][1]; }
    }
    PG8_WAIT_V(0);
    if (wr == 0) PG8_BAR;
    PG8_BAR;
    if constexpr (Epi::AFTER_DRAIN) { E.fused(acc, cur, wr, wc, fr, fq, lds, wid, lane); S.done(cur); }
    PG8_STAMP();
    if (STAMP && wid == 0) { stamps[lane] = lane < nts ? (((unsigned long long)(unsigned)ts_hi << 32) | (unsigned)ts_lo) : 0ull;
        if (lane == 62) stamps[62] = rt_entry; if (lane == 63) stamps[63] = (unsigned long long)wall_clock64(); }
#undef PG8_STAMP
#undef PG8_SA
#undef PG8_SB
#undef PG8_STAGE
#undef PG8_STAGE_A
#undef PG8_LOADOFF
#undef PG8_LDA
#undef PG8_LDB
#undef PG8_MMA
#undef PG8_WAIT_V
#undef PG8_WAIT_L
#undef PG8_BAR
#undef PG8_SCHED
}
}

namespace pg8 {
constexpr int TPE = SLOTS_PAD / 256;
struct EpiZ {
    static constexpr bool PERM = true, AFTER_DRAIN = false;
    bf16_t* O; int ldc;
    __device__ __forceinline__ void operator()(const f32x4 (&acc)[2][2][4][2], const Unit& u, int wr, int wc, int fr, int fq) const {
        const int row0 = u.pm * BM + wr * 64 + fr, col0 = u.pn * BM + wc * 32 + 8 * fq;
#pragma unroll
        for (int ai = 0; ai < 2; ++ai)
#pragma unroll
            for (int m = 0; m < 4; ++m) { bf16_t* rowp = O + (size_t)(row0 + ai * HALF + m * 16) * ldc + col0;
#pragma unroll
                for (int bj = 0; bj < 2; ++bj) { const f32x4 v0 = acc[ai][bj][m][0], v1 = acc[ai][bj][m][1];
                    u32x4 w; w.x = cvt_pk_bf16(v0[0], v0[1]); w.y = cvt_pk_bf16(v0[2], v0[3]); w.z = cvt_pk_bf16(v1[0], v1[1]); w.w = cvt_pk_bf16(v1[2], v1[3]);
                    *(u32x4*)(rowp + bj * HALF) = w; } }
    }
};
template <bool SRC16> struct EpiOut {
    static constexpr bool PERM = true, AFTER_DRAIN = false;
    const float* src_lat; const float* src_ctx; const bf16_t* srcb; bf16_t* dst; const float* mod;
    __device__ __forceinline__ void operator()(const f32x4 (&acc)[2][2][4][2], const Unit& u, int wr, int wc, int fr, int fq) const {
        const bool lat = u.pm < NLAT / BM; const int who = lat ? u.pm / (L / BM) : 2;
        const int row0 = u.pm * BM + wr * 64 + fr, col0 = u.pn * BM + wc * 32 + 8 * fq;
        const float* mv = mod + (size_t)(who * 6 + 2) * D;
        f32x4 m4[2][2];
#pragma unroll
        for (int bj = 0; bj < 2; ++bj)
#pragma unroll
            for (int n = 0; n < 2; ++n) m4[bj][n] = *(const f32x4*)(mv + col0 + bj * HALF + n * 4);
#pragma unroll
        for (int ai = 0; ai < 2; ++ai)
#pragma unroll
            for (int m = 0; m < 4; ++m) { const size_t grow = (size_t)(row0 + ai * HALF + m * 16);
#pragma unroll
                for (int bj = 0; bj < 2; ++bj) { const int c = col0 + bj * HALF; f32x4 x0, x1;
                    if (SRC16) { const u32x4 w = *(const u32x4*)(srcb + grow * D + c); x0 = (f32x4){bf_lo(w.x), bf_hi(w.x), bf_lo(w.y), bf_hi(w.y)}; x1 = (f32x4){bf_lo(w.z), bf_hi(w.z), bf_lo(w.w), bf_hi(w.w)}; }
                    else { const float* sp = (lat ? src_lat + grow * D : src_ctx + (grow - NLAT) * D) + c; x0 = __builtin_nontemporal_load((const f32x4*)sp); x1 = __builtin_nontemporal_load((const f32x4*)(sp + 4)); }
                    const f32x4 y0 = x0 + m4[bj][0] * acc[ai][bj][m][0], y1 = x1 + m4[bj][1] * acc[ai][bj][m][1];
                    u32x4 o; o.x = cvt_pk_bf16(y0[0], y0[1]); o.y = cvt_pk_bf16(y0[2], y0[3]); o.z = cvt_pk_bf16(y1[0], y1[1]); o.w = cvt_pk_bf16(y1[2], y1[3]);
                    *(u32x4*)(dst + grow * D + c) = o; } }
    }
};
__device__ __forceinline__ float silu_fast(float x) { return x * __builtin_amdgcn_rcpf(1.0f + __expf(-x)); }
struct EpiHid {
    static constexpr bool PERM = true, AFTER_DRAIN = false;
    bf16_t* O;
    __device__ __forceinline__ void operator()(const f32x4 (&acc)[2][2][4][2], const Unit& u, int wr, int wc, int fr, int fq) const {
        const int row0 = u.pm * BM + wr * 64 + fr, col0 = (u.pn & 7) * 128 + wc * 32 + 8 * fq;
#pragma unroll
        for (int ai = 0; ai < 2; ++ai)
#pragma unroll
            for (int m = 0; m < 4; ++m) { float h[8];
#pragma unroll
                for (int n = 0; n < 2; ++n)
#pragma unroll
                    for (int j = 0; j < 4; ++j) h[n * 4 + j] = silu_fast(acc[ai][0][m][n][j]) * acc[ai][1][m][n][j];
                u32x4 w; w.x = cvt_pk_bf16(h[0], h[1]); w.y = cvt_pk_bf16(h[2], h[3]); w.z = cvt_pk_bf16(h[4], h[5]); w.w = cvt_pk_bf16(h[6], h[7]);
                *(u32x4*)(O + (size_t)(row0 + ai * HALF + m * 16) * 1024 + col0) = w; }
    }
};
struct EpiY {
    static constexpr bool PERM = true, AFTER_DRAIN = false;
    bf16_t* O;
    __device__ __forceinline__ void operator()(const f32x4 (&acc)[2][2][4][2], const Unit& u, int wr, int wc, int fr, int fq) const {
        const int row0 = u.pm * BM + wr * 64 + fr, col0 = (u.pn & 3) * BM + wc * 32 + 8 * fq;
#pragma unroll
        for (int ai = 0; ai < 2; ++ai)
#pragma unroll
            for (int m = 0; m < 4; ++m) { bf16_t* rowp = O + (size_t)(row0 + ai * HALF + m * 16) * D + col0;
#pragma unroll
                for (int bj = 0; bj < 2; ++bj) { const f32x4 v0 = acc[ai][bj][m][0], v1 = acc[ai][bj][m][1];
                    u32x4 w; w.x = cvt_pk_bf16(v0[0], v0[1]); w.y = cvt_pk_bf16(v0[2], v0[3]); w.z = cvt_pk_bf16(v1[0], v1[1]); w.w = cvt_pk_bf16(v1[2], v1[3]);
                    *(u32x4*)(rowp + bj * HALF) = w; } }
    }
};
struct EpiCoef {
    static constexpr bool PERM = true, AFTER_DRAIN = false;
    const Params* P; int l;
    __device__ __forceinline__ void operator()(const f32x4 (&acc)[2][2][4][2], const Unit& u, int wr, int wc, int fr_, int fq_) const {
        int fr = fr_, fq = fq_; asm volatile("" : "+v"(fr), "+v"(fq));
        const int dir = u.pn >> 1, ch0 = (u.pn & 1) * 128 + wc * 32 + 8 * fq, row0 = u.pm * BM + wr * 64 + fr;
        const float* gb = P->a_gate_a_b + (l * 2 + dir) * 256 + ch0; const float* gx = P->a_gate_x_b + (l * 2 + dir) * 256 + ch0; const float* gs = P->SP8 + (l * 2 + dir) * 256 + ch0;
        bool small = true;
#pragma unroll
        for (int q = 0; q < 8; ++q) small = small && (gs[q] >= -0.5f);
        const bool poly = __all(small);
#pragma unroll
        for (int ai = 0; ai < 2; ++ai)
#pragma unroll
            for (int m = 0; m < 4; ++m) { const size_t row = (size_t)(row0 + ai * HALF + m * 16);
                const u32x4 xw = *(const u32x4*)(P->XAB + row * 256 + ch0); const unsigned xr[4] = {xw.x, xw.y, xw.z, xw.w};
                float om8[8], u8[8];
#pragma unroll
                for (int n = 0; n < 2; ++n)
#pragma unroll
                    for (int j = 0; j < 4; ++j) { const int q = n * 4 + j; const float xa = (q & 1) ? bf_hi(xr[q >> 1]) : bf_lo(xr[q >> 1]);
                        const float r = __builtin_amdgcn_rcpf(1.0f + __expf(-(acc[ai][0][m][n][j] + gb[q]))), ig = __builtin_amdgcn_rcpf(1.0f + __expf(-(acc[ai][1][m][n][j] + gx[q])));
                        const float y = r * gs[q];
                        float oma = -y * (1.0f + y * (0.5f + y * (0.16666667f + y * (0.041666667f + y * 0.0083333333f))));
                        if (!poly) oma = y > -0.5f ? oma : 1.0f - __expf(y);
                        om8[q] = oma; u8[q] = sqrtf(oma * (2.0f - oma)) * (ig * xa); }
                u32x4 wa, wu; wa.x = cvt_pk_bf16(om8[0], om8[1]); wa.y = cvt_pk_bf16(om8[2], om8[3]); wa.z = cvt_pk_bf16(om8[4], om8[5]); wa.w = cvt_pk_bf16(om8[6], om8[7]);
                wu.x = cvt_pk_bf16(u8[0], u8[1]); wu.y = cvt_pk_bf16(u8[2], u8[3]); wu.z = cvt_pk_bf16(u8[4], u8[5]); wu.w = cvt_pk_bf16(u8[6], u8[7]);
                *(u32x4*)(P->CA + ((size_t)dir * NR + row) * 256 + ch0) = wa; *(u32x4*)(P->CU + ((size_t)dir * NR + row) * 256 + ch0) = wu; }
    }
};
struct EpiRouter {
    static constexpr bool PERM = false, AFTER_DRAIN = false;
    float* AFF;
    __device__ __forceinline__ void operator()(const f32x4 (&acc)[2][2][4][2], const Unit& u, int wr, int wc, int fr_, int fq_) const {
        if (wc != 0) return;
        int fr = fr_, fq = fq_; asm volatile("" : "+v"(fr), "+v"(fq));
        const int lane = fq * 16 + fr;
#pragma unroll
        for (int ai = 0; ai < 2; ++ai)
#pragma unroll
            for (int m = 0; m < 4; ++m) { const f32x4 v = acc[ai][0][m][0];
                float mx = fmaxf(fmaxf(v[0], v[1]), fmaxf(v[2], v[3]));
                mx = fmaxf(mx, __int_as_float(__builtin_amdgcn_ds_bpermute((lane ^ 16) << 2, __float_as_int(mx)))); mx = fmaxf(mx, __int_as_float(__builtin_amdgcn_ds_bpermute((lane ^ 32) << 2, __float_as_int(mx))));
                const float e0 = __expf(v[0] - mx), e1 = __expf(v[1] - mx), e2 = __expf(v[2] - mx), e3 = __expf(v[3] - mx);
                float sm = (e0 + e1) + (e2 + e3);
                sm += __int_as_float(__builtin_amdgcn_ds_bpermute((lane ^ 16) << 2, __float_as_int(sm))); sm += __int_as_float(__builtin_amdgcn_ds_bpermute((lane ^ 32) << 2, __float_as_int(sm)));
                const float inv = 1.0f / sm;
                const int row = u.pm * BM + ai * HALF + wr * 64 + m * 16 + fr, seg = row_seg(row), t = row - seg_base(seg);
                float* o = AFF + ((size_t)seg * NE + 4 * fq) * L + t;
                o[0] = e0 * inv; o[(size_t)L] = e1 * inv; o[(size_t)2 * L] = e2 * inv; o[(size_t)3 * L] = e3 * inv; }
    }
};
struct GroupOrder {
    StaticOrder so; int tf, nNl, nsh, G, c;
    __device__ void init(int nsl, int nNl_, int G_, int c_) { const int tv = (nsl + 255) / 256, rem = nsl & 255; const bool sh = rem != 0 && rem <= 128; tf = sh ? tv - 1 : tv; nNl = nNl_; nsh = sh ? NE * nNl_ : 0; G = G_; c = c_;
        so.init(NE * tf * BM, nNl_ * BM, G_, c_); }
    __device__ bool next(int i, Unit& u) const {
        if (so.next(i, u)) { const int e = u.pm / tf; u.pm = e * TPE + (u.pm - e * tf); u.pn += e * nNl; return true; }
        const long j = (long)i * G + c - so.nwg; if (j >= nsh) return false;
        const int e = (int)j / nNl; u.pm = e * TPE + tf; u.pn = (int)j; return true;
    }
    __device__ __forceinline__ bool is_half(const Unit& u) const { return nsh != 0 && (u.pm % TPE) == tf; }
    __device__ __forceinline__ void a_ready(const Unit&) const {}
    __device__ __forceinline__ void done(const Unit&) const {}
};
}

namespace attn_body {
using bf16=__hip_bfloat16;
using bf16x8=__attribute__((ext_vector_type(8)))short;
using s16x4=__attribute__((ext_vector_type(4)))short;
using f32x16=__attribute__((ext_vector_type(16)))float;
using u32x4=__attribute__((ext_vector_type(4)))unsigned;
constexpr int D=64,ZP=DIN,OP=1024,NTC=LC/64;
constexpr int NW=8,QBLK=32,QB=QBLK*NW,KVBLK=64,NQB=L/QB;
__device__ __forceinline__ int crow(int r,int hi){return (r&3)+8*(r>>2)+4*hi;}
#define SBAR() __builtin_amdgcn_sched_barrier(0)
constexpr int NSLOT=3, SLOTB=8192;
constexpr int LDS_K=0, LDS_V=NSLOT*SLOTB, LDS_WS=2*NSLOT*SLOTB, LDS_OST=LDS_WS+NW*64*4, LDS_BYTES=LDS_OST+NW*4096;
constexpr float C2=0.125f*1.4426950408889634f;
__device__ __forceinline__ void glds16(const void*sbase,unsigned voff,unsigned lds_dst){unsigned keep;
  asm volatile("s_mov_b32 %0, m0\n\ts_mov_b32 m0, %3\n\ts_nop 0\n\tglobal_load_lds_dwordx4 %1, %2\n\ts_mov_b32 m0, %0":"=&s"(keep):"v"(voff),"s"(sbase),"s"(lds_dst):"memory");}
__device__ __forceinline__ float max3f(float a,float b,float c){float r;asm("v_max3_f32 %0, %1, %2, %3":"=v"(r):"v"(a),"v"(b),"v"(c));return r;}
__device__ __forceinline__ float max2f(float a,float b){float r;asm("v_max_f32_e32 %0, %1, %2":"=v"(r):"v"(a),"v"(b));return r;}
__device__ __forceinline__ float fadd_s(float a,float b){float r;asm("v_add_f32_e32 %0, %1, %2":"=v"(r):"v"(a),"v"(b));return r;}
__device__ __forceinline__ float fsub_s(float a,float b){float r;asm("v_sub_f32_e32 %0, %1, %2":"=v"(r):"v"(a),"v"(b));return r;}
typedef float f32x2_t __attribute__((ext_vector_type(2))); typedef __bf16 bf16x2_t __attribute__((ext_vector_type(2)));
__device__ __forceinline__ unsigned cvtpk_s(float lo,float hi){f32x2_t v={lo,hi};bf16x2_t b=__builtin_convertvector(v,bf16x2_t);return __builtin_bit_cast(unsigned,b);}
#define WAIT_BAR(N) asm volatile("s_waitcnt vmcnt(" #N ") lgkmcnt(0)\n\ts_barrier":::"memory")

__device__ __forceinline__ void qkt(f32x16&p0,f32x16&p1,const char*Kslot,const bf16x8*qr,const f32x16&negm,int r32,int hi){
  const char*kb=Kslot+hi*1024+r32*16;
  #pragma unroll
  for(int d0=0;d0<4;++d0){
    const bf16x8 b0=*reinterpret_cast<const bf16x8*>(kb+d0*2048);
    const bf16x8 b1=*reinterpret_cast<const bf16x8*>(kb+d0*2048+512);
    if(d0==0){p0=__builtin_amdgcn_mfma_f32_32x32x16_bf16(b0,qr[0],negm,0,0,0);p1=__builtin_amdgcn_mfma_f32_32x32x16_bf16(b1,qr[0],negm,0,0,0);}
    else{p0=__builtin_amdgcn_mfma_f32_32x32x16_bf16(b0,qr[d0],p0,0,0,0);p1=__builtin_amdgcn_mfma_f32_32x32x16_bf16(b1,qr[d0],p1,0,0,0);}}
}
typedef __attribute__((address_space(3))) const char* lds_cptr;
typedef short v4i16_t __attribute__((ext_vector_type(4)));
__device__ __forceinline__ void kload8(bf16x8*kf,lds_cptr kp){
  kf[0]=*(const __attribute__((address_space(3))) bf16x8*)(kp);      kf[1]=*(const __attribute__((address_space(3))) bf16x8*)(kp+512);
  kf[2]=*(const __attribute__((address_space(3))) bf16x8*)(kp+2048); kf[3]=*(const __attribute__((address_space(3))) bf16x8*)(kp+2560);
  kf[4]=*(const __attribute__((address_space(3))) bf16x8*)(kp+4096); kf[5]=*(const __attribute__((address_space(3))) bf16x8*)(kp+4608);
  kf[6]=*(const __attribute__((address_space(3))) bf16x8*)(kp+6144); kf[7]=*(const __attribute__((address_space(3))) bf16x8*)(kp+6656);
}
__device__ __forceinline__ void kload2(bf16x8*kf,lds_cptr kp,int j){ kf[2*j]=*(const __attribute__((address_space(3))) bf16x8*)(kp+j*2048); kf[2*j+1]=*(const __attribute__((address_space(3))) bf16x8*)(kp+j*2048+512); }
__device__ __forceinline__ s16x4 vtr(lds_cptr p){ return __builtin_bit_cast(s16x4,__builtin_amdgcn_ds_read_tr16_b64_v4i16((__attribute__((address_space(3))) v4i16_t*)p)); }
__device__ __forceinline__ float rowmax(const f32x16&p0,const f32x16&p1){
  float a=max3f(p0[0],p0[1],p1[0]),b=max3f(p0[2],p0[3],p1[1]);a=max3f(a,p1[2],p1[3]);
  #pragma unroll
  for(int r=4;r<16;r+=4){a=max3f(a,p0[r],p0[r+1]);b=max3f(b,p0[r+2],p0[r+3]);a=max3f(a,p1[r],p1[r+1]);b=max3f(b,p1[r+2],p1[r+3]);}
  const float m=max2f(a,b);
  auto rr=__builtin_amdgcn_permlane32_swap(__float_as_uint(m),__float_as_uint(m),false,false);
  return max2f(__uint_as_float(rr[0]),__uint_as_float(rr[1]));
}
__device__ __forceinline__ void pv(f32x16*o,int vb,bf16x8 pa0,bf16x8 pa1,bf16x8 pa2,bf16x8 pa3){
  #pragma unroll
  for(int d0=0;d0<2;++d0){s16x4 lo[4],hi[4];
    #pragma unroll
    for(int ks=0;ks<4;++ks){
      asm volatile("ds_read_b64_tr_b16 %0,%1 offset:%c2":"=&v"(lo[ks]):"v"(vb),"i"(d0*4096+ks*1024):"memory");
      asm volatile("ds_read_b64_tr_b16 %0,%1 offset:%c2":"=&v"(hi[ks]):"v"(vb),"i"(d0*4096+ks*1024+512):"memory");}
    asm volatile("s_waitcnt lgkmcnt(0)":::"memory");SBAR();
    #define PK(k) (bf16x8){lo[k][0],lo[k][1],lo[k][2],lo[k][3],hi[k][0],hi[k][1],hi[k][2],hi[k][3]}
    o[d0]=__builtin_amdgcn_mfma_f32_32x32x16_bf16(pa0,PK(0),o[d0],0,0,0);
    o[d0]=__builtin_amdgcn_mfma_f32_32x32x16_bf16(pa1,PK(1),o[d0],0,0,0);
    o[d0]=__builtin_amdgcn_mfma_f32_32x32x16_bf16(pa2,PK(2),o[d0],0,0,0);
    o[d0]=__builtin_amdgcn_mfma_f32_32x32x16_bf16(pa3,PK(3),o[d0],0,0,0);
    #undef PK
  }
}

#ifndef ATTN_STORE16
#define ATTN_STORE16(p,v) (*(u32x4*)(p)=(v))
#endif
__device__ __forceinline__ void wmask(f32x16&p0,f32x16&p1,int s0,int tq,int hi){
  const float NEG=-INFINITY;
  #pragma unroll
  for(int r=0;r<16;++r){ const int s=s0+4*hi+(r&3)+8*(r>>2); const int d0=tq-s,d1=d0-32;
    if(!(s>=0&&s<L&&d0<=WINDOW&&d0>=-WINDOW))p0[r]=NEG; if(!(s+32>=0&&s+32<L&&d1<=WINDOW&&d1>=-WINDOW))p1[r]=NEG; }
}
template<int MODE,int THRL,bool FAST> __device__ __forceinline__ void attn_unit(int b,int h,int qb,const bf16*__restrict__ Z,bf16*O,char*shm,int wv,float sinkl2,const float*qnw,const float*rope){
  constexpr bool ISC=(MODE==1||MODE==2),CTXQ=(MODE>=2),WIN=(MODE==1);
  constexpr int QCOL=ISC?Z_CQ:Z_DQ,KCOL=ISC?Z_CK:Z_DK,VCOL=ISC?Z_CV:Z_DV,OCOL=ISC?512:768;
  static_assert(!CTXQ||LC==QB,"context queries: one 256-row unit per (batch, head)");
  const int lane=lane_id(),r32=lane&31,hi=lane>>5; const int wid=wv;
  const long rowbase=CTXQ?(long)NLAT+(long)b*LC:(long)b*L; const int q0=CTXQ?0:qb*QB; const int kvh=h>>1;
  const bf16*Qw=Z+(rowbase+q0+wid*QBLK)*ZP+QCOL+h*D;
  const bf16*Zk=Z+KCOL+kvh*D,*Zv=Z+VCOL+kvh*D; const int crow0=NLAT+b*LC,lrow0=b*L;
  const int kt0=WIN?q0/KVBLK-2-NTC:-NTC;
  #define TROW(t) __builtin_amdgcn_readfirstlane((t)<NTC?crow0+(t)*KVBLK:lrow0+(CTXQ?0:(WIN?min(max(kt0+(t),0),L/KVBLK-1):kt0+(t)))*KVBLK)
  const unsigned lds0=(unsigned)(uintptr_t)shm;
  float*wsf=(float*)(shm+LDS_WS)+wid*64;
  const unsigned koff=(unsigned)(lane*ZP+wid*8)*2u, voff=(unsigned)((16*(wid&3)+(lane>>2))*ZP+(wid>>2)*32+(lane&3)*8)*2u;
  const unsigned kdst=lds0+LDS_K+wid*1024, vdst=lds0+LDS_V+wid*1024;
  #define DMA_K(t,slot) glds16(Zk+(long)TROW(t)*ZP,koff,(unsigned)__builtin_amdgcn_readfirstlane(kdst+(slot)))
  #define DMA_V(t,slot) glds16(Zv+(long)TROW(t)*ZP,voff,(unsigned)__builtin_amdgcn_readfirstlane(vdst+(slot)))
  const int vb0=(int)(lds0+LDS_V)+((lane>>4)&1)*32+(lane&3)*8+(4*hi+((lane&15)>>2))*64;
  const char*Kbase=shm+LDS_K; bf16x8 kf[8];
  const lds_cptr shm3=(lds_cptr)shm; const lds_cptr kp0=shm3+LDS_K+hi*1024+r32*16; const lds_cptr vp0=shm3+LDS_V+((lane>>4)&1)*32+(lane&3)*8+(4*hi+((lane&15)>>2))*64;
  constexpr int NT=CTXQ?NTC+2:(WIN?NTC+8:(LC+L)/KVBLK);
  DMA_K(0,0);DMA_V(0,0);DMA_K(1,SLOTB);
  bf16x8 qr[4];
  #pragma unroll
  for(int d0=0;d0<4;++d0)qr[d0]=*reinterpret_cast<const bf16x8*>(&Qw[(long)r32*ZP+d0*16+hi*8]);
  { float xq[4][8];
    #pragma unroll
    for(int d0=0;d0<4;++d0){
      #pragma unroll
      for(int j=0;j<8;++j)xq[d0][j]=__uint_as_float(((unsigned)(unsigned short)qr[d0][j])<<16); }
    if(!ISC){ float ss=0.f;
      #pragma unroll
      for(int d0=0;d0<4;++d0){
        #pragma unroll
        for(int j=0;j<8;++j)ss+=xq[d0][j]*xq[d0][j]; }
      {auto rr=__builtin_amdgcn_permlane32_swap(__float_as_uint(ss),__float_as_uint(ss),false,false);ss=__uint_as_float(rr[0])+__uint_as_float(rr[1]);}
      const float rstd=1.0f/sqrtf(ss*(1.0f/64.0f)+EPS);
      #pragma unroll
      for(int d0=0;d0<4;++d0){
        #pragma unroll
        for(int j=0;j<8;++j)xq[d0][j]=xq[d0][j]*rstd*qnw[16*d0+8*hi+j]; } }
    if(!CTXQ){ const int tpos=q0+wid*QBLK+r32,pr=tpos>>6,pc=tpos&63;
      #pragma unroll
      for(int j=0;j<8;++j){ const int f=8*hi+j;
        { const float c=rope[(pr*16+f)*2],s_=rope[(pr*16+f)*2+1],x1=xq[0][j],x2=xq[1][j]; xq[0][j]=x1*c-x2*s_; xq[1][j]=x2*c+x1*s_; }
        { const float c=rope[(pc*16+f)*2],s_=rope[(pc*16+f)*2+1],x1=xq[2][j],x2=xq[3][j]; xq[2][j]=x1*c-x2*s_; xq[3][j]=x2*c+x1*s_; } } }
    #pragma unroll
    for(int d0=0;d0<4;++d0){ const u32x4 w=(u32x4){cvtpk_s(xq[d0][0]*QC2,xq[d0][1]*QC2),cvtpk_s(xq[d0][2]*QC2,xq[d0][3]*QC2),cvtpk_s(xq[d0][4]*QC2,xq[d0][5]*QC2),cvtpk_s(xq[d0][6]*QC2,xq[d0][7]*QC2)}; qr[d0]=__builtin_bit_cast(bf16x8,w); } }
  float mhat=0.f,l_reg=0.f;f32x16 o[2];o[0]=f32x16{};o[1]=f32x16{};const f32x16 negm=f32x16{};
  const int tq=q0+wid*QBLK+r32;
  #define CMASK(P0,P1,t) do{ if(MODE&&(t)>=NTC)wmask(P0,P1,CTXQ?-(1<<24):(kt0+(t))*KVBLK,tq,hi); }while(0)
  bool resc=false;
  #define START(P0,P1) do{ resc=false; \
    if(!FAST){ const float rm=rowmax(P0,P1); const float dl=rm; mhat=fadd_s(mhat,dl); \
      _Pragma("unroll") for(int r=0;r<16;++r){P0[r]=fsub_s(P0[r],dl);P1[r]=fsub_s(P1[r],dl);} } \
    _Pragma("unroll") for(int r=0;r<16;++r)P0[r]=__builtin_amdgcn_exp2f(P0[r]); }while(0)
  #define RESC() do{ if(!FAST&&resc){ asm volatile("s_waitcnt lgkmcnt(0)":::"memory"); \
      _Pragma("unroll") for(int d_=0;d_<2;++d_) _Pragma("unroll") for(int r=0;r<16;++r)o[d_][r]*=wsf[crow(r,hi)]; } }while(0)
  f32x16 pA0,pA1,pB0,pB1;
  int sl_prev=0,sl_cur=0,sl_next=SLOTB;
  #define ROT() do{sl_prev=sl_cur;sl_cur=sl_next;sl_next=(sl_next==(NSLOT-1)*SLOTB)?0:sl_next+SLOTB;}while(0)
  DMA_K(2,2*SLOTB);
  WAIT_BAR(3);
  qkt(pA0,pA1,Kbase,qr,negm,r32,hi);asm volatile("s_nop 15\n\ts_nop 7":"+v"(pA0),"+v"(pA1));CMASK(pA0,pA1,0);
  START(pA0,pA1);
  _Pragma("unroll") for(int r=0;r<16;++r)pA1[r]=__builtin_amdgcn_exp2f(pA1[r]);
  WAIT_BAR(0);
  DMA_K(3,0);DMA_V(1,SLOTB);
  ROT();
  kload8(kf,kp0+sl_cur);
  WAIT_BAR(2);
  s16x4 vlo[8],vhi[8]; u32x4 pw0,pw1,pw2,pw3;
  #define PKW(P,B) cvtpk_s(P[B],P[B+1])
  #define PAF(k) __builtin_bit_cast(bf16x8,pw##k)
  #define VFR(i) (bf16x8){vlo[i][0],vlo[i][1],vlo[i][2],vlo[i][3],vhi[i][0],vhi[i][1],vhi[i][2],vhi[i][3]}
  #define PIN(x) asm volatile("":"+v"(x))
  #define MX3(a,b,c) __builtin_fmaxf(__builtin_fmaxf((a),(b)),(c))
  #define GAPA(MF,A0,A1,A2,A3,W0,W1,PW) do{ MF; sacc+=A0; sacc+=A1; sacc+=A2; sacc+=A3; PIN(sacc); W0; W1; PIN(PW); SBAR(); }while(0)
  #define EX(v) __builtin_amdgcn_exp2f(v)
  #define SH(v) (FAST?(v):(v)-mhat)
  #define GAPB(MF,X,B) do{ MF; X[B]=EX(SH(X[B])); X[B+1]=EX(SH(X[B+1])); X[B+2]=EX(SH(X[B+2])); X[B+3]=EX(SH(X[B+3])); PIN(X); SBAR(); }while(0)
  #define VRD(i) do{ vlo[i]=vtr(vp_+(((i)>>2)*4096+((i)&3)*1024)); vhi[i]=vtr(vp_+(((i)>>2)*4096+((i)&3)*1024+512)); }while(0)
  #define KRD(G,j) do{ if(G){ kload2(kf,kp0+sl_next,j); SBAR(); } }while(0)
  #define STEP(C0,C1,P0,P1,t,GK,GV,GL) do{ SBAR(); \
    const lds_cptr vp_=vp0+sl_prev; \
    VRD(0); SBAR(); float sacc=(P0[0]+P0[1]); \
    GAPA(C0=__builtin_amdgcn_mfma_f32_32x32x16_bf16(kf[0],qr[0],negm,0,0,0), P0[2],P0[3],P0[4],P0[5],     pw0[0]=PKW(P0,0), pw0[1]=PKW(P0,2), pw0); \
    VRD(4); SBAR(); GAPA(C1=__builtin_amdgcn_mfma_f32_32x32x16_bf16(kf[1],qr[0],negm,0,0,0), P0[6],P0[7],P0[8],P0[9],     pw0[2]=PKW(P0,4), pw0[3]=PKW(P0,6), pw0); \
    VRD(1); SBAR(); GAPA(C0=__builtin_amdgcn_mfma_f32_32x32x16_bf16(kf[2],qr[1],C0,0,0,0),   P0[10],P0[11],P0[12],P0[13], pw1[0]=PKW(P0,8), pw1[1]=PKW(P0,10), pw1); \
    VRD(5); SBAR(); GAPA(C1=__builtin_amdgcn_mfma_f32_32x32x16_bf16(kf[3],qr[1],C1,0,0,0),   P0[14],P0[15],P1[0],P1[1],   pw1[2]=PKW(P0,12),pw1[3]=PKW(P0,14), pw1); \
    VRD(2); SBAR(); GAPA(C0=__builtin_amdgcn_mfma_f32_32x32x16_bf16(kf[4],qr[2],C0,0,0,0),   P1[2],P1[3],P1[4],P1[5],     pw2[0]=PKW(P1,0), pw2[1]=PKW(P1,2), pw2); \
    VRD(6); SBAR(); GAPA(C1=__builtin_amdgcn_mfma_f32_32x32x16_bf16(kf[5],qr[2],C1,0,0,0),   P1[6],P1[7],P1[8],P1[9],     pw2[2]=PKW(P1,4), pw2[3]=PKW(P1,6), pw2); \
    VRD(3); SBAR(); GAPA(C0=__builtin_amdgcn_mfma_f32_32x32x16_bf16(kf[6],qr[3],C0,0,0,0),   P1[10],P1[11],P1[12],P1[13], pw3[0]=PKW(P1,8), pw3[1]=PKW(P1,10), pw3); \
    VRD(7); SBAR(); GAPA(C1=__builtin_amdgcn_mfma_f32_32x32x16_bf16(kf[7],qr[3],C1,0,0,0),   P1[14],P1[15],0.f,0.f,       pw3[2]=PKW(P1,12),pw3[3]=PKW(P1,14), pw3); \
    l_reg+=sacc; \
    if(GK){DMA_K((t)+3,sl_cur);} if(GV){DMA_V((t)+1,sl_next);} \
    CMASK(C0,C1,t); \
    if(!FAST){ float a=MX3(C0[0],C0[1],C1[0]),b=MX3(C0[2],C0[3],C1[1]); a=MX3(a,C1[2],C1[3]); \
      _Pragma("unroll") for(int r=4;r<16;r+=4){a=MX3(a,C0[r],C0[r+1]);b=MX3(b,C0[r+2],C0[r+3]);a=MX3(a,C1[r],C1[r+1]);b=MX3(b,C1[r+2],C1[r+3]);} \
      float rm=__builtin_fmaxf(a,b); { auto rr=__builtin_amdgcn_permlane32_swap(__float_as_uint(rm),__float_as_uint(rm),false,false); rm=__builtin_fmaxf(__uint_as_float(rr[0]),__uint_as_float(rr[1])); } \
      rm-=mhat;   \
      resc=false; \
      if(__builtin_expect(__any(rm>(float)THRL),0)){ const float dl=__builtin_fmaxf(rm,0.f); mhat+=dl; \
        const float f=__builtin_amdgcn_exp2f(-dl); l_reg*=f; if(hi==0)wsf[r32]=f; resc=true; } } \
    SBAR(); \
    GAPB(o[0]=__builtin_amdgcn_mfma_f32_32x32x16_bf16(PAF(0),VFR(0),o[0],0,0,0), C0,0); \
    GAPB(o[1]=__builtin_amdgcn_mfma_f32_32x32x16_bf16(PAF(0),VFR(4),o[1],0,0,0), C0,4); \
    KRD(GL,0); GAPB(o[0]=__builtin_amdgcn_mfma_f32_32x32x16_bf16(PAF(1),VFR(1),o[0],0,0,0), C0,8); \
    KRD(GL,1); GAPB(o[1]=__builtin_amdgcn_mfma_f32_32x32x16_bf16(PAF(1),VFR(5),o[1],0,0,0), C0,12); \
    KRD(GL,2); GAPB(o[0]=__builtin_amdgcn_mfma_f32_32x32x16_bf16(PAF(2),VFR(2),o[0],0,0,0), C1,0); \
    KRD(GL,3); GAPB(o[1]=__builtin_amdgcn_mfma_f32_32x32x16_bf16(PAF(2),VFR(6),o[1],0,0,0), C1,4); \
    GAPB(o[0]=__builtin_amdgcn_mfma_f32_32x32x16_bf16(PAF(3),VFR(3),o[0],0,0,0), C1,8); \
    GAPB(o[1]=__builtin_amdgcn_mfma_f32_32x32x16_bf16(PAF(3),VFR(7),o[1],0,0,0), C1,12); \
    }while(0)
  int t=1;
  for(;t+5<NT;t+=2){
    STEP(pB0,pB1,pA0,pA1,t,true,true,true);     WAIT_BAR(2); RESC(); ROT();
    STEP(pA0,pA1,pB0,pB1,t+1,true,true,true);   WAIT_BAR(2); RESC(); ROT();
  }
  #define ENDW(tt) do{ if((tt)+3<NT){WAIT_BAR(2);} else if((tt)+2<NT){WAIT_BAR(1);} else {WAIT_BAR(0);} }while(0)
  for(;t+1<NT;t+=2){
    STEP(pB0,pB1,pA0,pA1,t,(t+3<NT),(t+1<NT),(t+1<NT));       ENDW(t);   RESC(); ROT();
    STEP(pA0,pA1,pB0,pB1,t+1,(t+4<NT),(t+2<NT),(t+2<NT));     ENDW(t+1); RESC(); ROT();
  }
  STEP(pB0,pB1,pA0,pA1,NT-1,false,false,false); RESC();
  { float sacc=pB0[0]+pB0[1]; _Pragma("unroll") for(int r=2;r<16;++r)sacc+=pB0[r]; _Pragma("unroll") for(int r=0;r<16;++r)sacc+=pB1[r]; l_reg+=sacc;
    pw0=(u32x4){PKW(pB0,0),PKW(pB0,2),PKW(pB0,4),PKW(pB0,6)};pw1=(u32x4){PKW(pB0,8),PKW(pB0,10),PKW(pB0,12),PKW(pB0,14)};pw2=(u32x4){PKW(pB1,0),PKW(pB1,2),PKW(pB1,4),PKW(pB1,6)};pw3=(u32x4){PKW(pB1,8),PKW(pB1,10),PKW(pB1,12),PKW(pB1,14)};
    SBAR(); pv(o,vb0+sl_cur,PAF(0),PAF(1),PAF(2),PAF(3)); }
  #undef PKW
  #undef PAF
  #undef VFR
  #undef PIN
  #undef MX3
  #undef GAPA
  #undef GAPB
  #undef SH
  #undef EX
  #undef VRD
  #undef KRD
  #undef STEP
  #undef ENDW
  {auto rr=__builtin_amdgcn_permlane32_swap(__float_as_uint(l_reg),__float_as_uint(l_reg),false,false);l_reg=__uint_as_float(rr[0])+__uint_as_float(rr[1]);}
  if(ISC)l_reg+=__builtin_amdgcn_exp2f(sinkl2-mhat);
  if(hi==0)wsf[32+r32]=l_reg;asm volatile("s_waitcnt lgkmcnt(0)":::"memory");
  float rli[16];
  #pragma unroll
  for(int r=0;r<16;++r)rli[r]=__builtin_amdgcn_rcpf(wsf[32+crow(r,hi)]);
  bf16*Ow=O+(rowbase+q0+wid*QBLK)*OP+OCOL+h*D;
  { bf16*stg=(bf16*)(shm+LDS_OST)+wid*2048;
    #pragma unroll
    for(int r=0;r<16;++r){const int orow=crow(r,hi);
      #pragma unroll
      for(int d0=0;d0<2;++d0)stg[orow*64+d0*32+r32]=__float2bfloat16(o[d0][r]*rli[r]);}
    asm volatile("s_waitcnt lgkmcnt(0)":::"memory");
    #pragma unroll
    for(int i=0;i<4;++i){const int row=i*8+(lane>>3),ch=lane&7; const u32x4 v=*(const u32x4*)(stg+row*64+ch*8); ATTN_STORE16(Ow+(long)row*OP+ch*8,v);} }
  asm volatile("s_waitcnt lgkmcnt(0)\n\ts_barrier":::"memory");
  #undef DMA_K
  #undef DMA_V
  #undef TROW
  #undef CMASK
  #undef START
  #undef RESC
  #undef ROT
}
constexpr int ATTN_LDS_BYTES=LDS_BYTES;
template<int MODE,int THRL=8,bool FAST=false> __device__ __forceinline__ void attn_phase(char*lds,const bf16*Z,bf16*O,int wv,const float*sink,const float*qnw,const float*rope){
  const int G=grid_dim(), bid=block_id(), vcu=(G%8==0)?(bid%8)*(G/8)+bid/8:bid; constexpr int NQ=(MODE>=2)?1:NQB, NU=NB*4*NQ;
  const int upc=(NU+G-1)/G;
  const int voff=(MODE==3&&G>=2*NU)?NU:0;
  for(int i=0;i<upc;++i){ const int u=(vcu-voff)*upc+i; if(u<0||u>=NU)break; const int qb=u%NQ,bh=u/NQ; attn_unit<MODE,THRL,FAST>(bh>>2,bh&3,qb,Z,O,lds,wv,(MODE==1||MODE==2)?sink[bh&3]*1.4426950408889634f:0.f,qnw,rope); }
}
#undef SBAR
#undef WAIT_BAR
}

constexpr int LDS_BYTES = pg8::STAGE_BYTES + 16;
static_assert(attn_body::ATTN_LDS_BYTES <= pg8::STAGE_BYTES, "attention LDS");

typedef const __attribute__((address_space(4))) Params* KParams;
__device__ __forceinline__ const Params& fresh_params() { KParams p = (KParams)__builtin_amdgcn_kernarg_segment_ptr(); asm volatile("" : "+s"(p)); return *(const Params*)p; }


typedef float f4_t __attribute__((ext_vector_type(4)));
typedef unsigned u2_t __attribute__((ext_vector_type(2)));
__device__ __forceinline__ float lane_read(float v, int src) { return __int_as_float(__builtin_amdgcn_ds_bpermute(src << 2, __float_as_int(v))); }
__device__ __forceinline__ unsigned lane_read(unsigned v, int src) { return (unsigned)__builtin_amdgcn_ds_bpermute(src << 2, (int)v); }
__device__ __forceinline__ float wave_sum(float v, int lane) {
#pragma unroll
    for (int o = 32; o >= 1; o >>= 1) v += lane_read(v, lane ^ o);
    return v;
}
__device__ __forceinline__ unsigned pk_bf16(float lo, float hi) { return (unsigned)f2bf(lo) | ((unsigned)f2bf(hi) << 16); }
__device__ __forceinline__ void norm_mod_row(const float* x, const float* w, const float* sc, const float* sh, bf16_t* h, int lane, f4_t (&hv)[4]) {
    f4_t xv[4]; float ss = 0.f;
#pragma unroll
    for (int j = 0; j < 4; ++j) { xv[j] = ((const f4_t*)x)[j * 64 + lane]; ss += xv[j][0] * xv[j][0] + xv[j][1] * xv[j][1] + xv[j][2] * xv[j][2] + xv[j][3] * xv[j][3]; }
    ss = wave_sum(ss, lane);
    const float rstd = 1.0f / sqrtf(ss * (1.0f / D) + EPS);
#pragma unroll
    for (int j = 0; j < 4; ++j) { const f4_t wv4 = ((const f4_t*)w)[j * 64 + lane], s4 = ((const f4_t*)sc)[j * 64 + lane], b4 = ((const f4_t*)sh)[j * 64 + lane];
        hv[j] = xv[j] * rstd * wv4 * (1.0f + s4) + b4;
        u2_t o; o.x = pk_bf16(hv[j][0], hv[j][1]); o.y = pk_bf16(hv[j][2], hv[j][3]); ((u2_t*)h)[j * 64 + lane] = o; }
}
template <int NR_, class XF, class HF> __device__ __forceinline__ void norm_rows(const Params& P, int l, int which  , int r0, int dr, int n, int lane, XF xrow, HF hrow) {
    f4_t xv[NR_][4];
#pragma unroll
    for (int q = 0; q < NR_; ++q) { const int r = r0 + q * dr; if (r < n) { const float* x = xrow(r);
#pragma unroll
        for (int j = 0; j < 4; ++j) xv[q][j] = __builtin_nontemporal_load((const f4_t*)x + j * 64 + lane); } }
    f4_t gv[4], sv[4]; int wcur = -1;
#pragma unroll
    for (int q = 0; q < NR_; ++q) { const int r = r0 + q * dr; if (r < n) { float ss = 0.f;
#pragma unroll
        for (int j = 0; j < 4; ++j) ss += xv[q][j][0] * xv[q][j][0] + xv[q][j][1] * xv[q][j][1] + xv[q][j][2] * xv[q][j][2] + xv[q][j][3] * xv[q][j][3];
        ss = wave_sum(ss, lane);
        const float rstd = 1.0f / sqrtf(ss * (1.0f / D) + EPS); const int who = row_who(r);
        if (who != wcur) { wcur = who; const float* sc = modv(P, l, who, which == 1 ? 1 : 4); const float* sh = modv(P, l, who, which == 1 ? 0 : 3);
#pragma unroll
            for (int j = 0; j < 4; ++j) { gv[j] = ((const f4_t*)sc)[j * 64 + lane]; sv[j] = ((const f4_t*)sh)[j * 64 + lane]; } }
        bf16_t* h = hrow(r);
#pragma unroll
        for (int j = 0; j < 4; ++j) { const f4_t hv = xv[q][j] * rstd * gv[j] + sv[j];
            u2_t o; o.x = pk_bf16(hv[0], hv[1]); o.y = pk_bf16(hv[2], hv[3]); ((u2_t*)h)[j * 64 + lane] = o; } } }
}
template <int NR_, class HF> __device__ __forceinline__ void norm_rows16(const Params& P, int l, int r0, int dr, int n, int lane, HF hrow) {
    u2_t xr[NR_][4];
#pragma unroll
    for (int q = 0; q < NR_; ++q) { const int r = r0 + q * dr; if (r < n) { const u2_t* x = (const u2_t*)(P.XB + (size_t)r * D);
#pragma unroll
        for (int j = 0; j < 4; ++j) xr[q][j] = x[j * 64 + lane]; } }
    f4_t gv[4], sv[4]; int wcur = -1;
#pragma unroll
    for (int q = 0; q < NR_; ++q) { const int r = r0 + q * dr; if (r < n) { float ss = 0.f; f4_t xv[4];
#pragma unroll
        for (int j = 0; j < 4; ++j) { xv[j] = (f4_t){bf_lo(xr[q][j].x), bf_hi(xr[q][j].x), bf_lo(xr[q][j].y), bf_hi(xr[q][j].y)}; ss += xv[j][0] * xv[j][0] + xv[j][1] * xv[j][1] + xv[j][2] * xv[j][2] + xv[j][3] * xv[j][3]; }
        ss = wave_sum(ss, lane);
        const float rstd = 1.0f / sqrtf(ss * (1.0f / D) + EPS); const int who = row_who(r);
        if (who != wcur) { wcur = who; const float* sc = modv(P, l, who, 4); const float* sh = modv(P, l, who, 3);
#pragma unroll
            for (int j = 0; j < 4; ++j) { gv[j] = ((const f4_t*)sc)[j * 64 + lane]; sv[j] = ((const f4_t*)sh)[j * 64 + lane]; } }
        bf16_t* h = hrow(r);
#pragma unroll
        for (int j = 0; j < 4; ++j) { const f4_t hv = xv[j] * rstd * gv[j] + sv[j];
            u2_t o; o.x = pk_bf16(hv[0], hv[1]); o.y = pk_bf16(hv[2], hv[3]); ((u2_t*)h)[j * 64 + lane] = o; } } }
}
__device__ __forceinline__ void mod_wave(const Params& P, int w, int lane) {
    const int nb = w % 96, who = (w / 96) % 3, l = w / 288, n = nb * 64 + lane;
    const float* cv = who < 2 ? P.c + who * D : P.c_ctx; const float* wp = P.mod_w + (size_t)l * D * 6 * D + n;
    float acc = 0.f;
    for (int j = 0; j < 16; ++j) { const float x = cv[j * 64 + lane], sv = x * __builtin_amdgcn_rcpf(1.0f + __expf(-x));
#pragma unroll
        for (int kk = 0; kk < 64; ++kk) acc += __int_as_float(__builtin_amdgcn_readlane(__float_as_int(sv), kk)) * wp[(size_t)(j * 64 + kk) * 6 * D]; }
    float v = acc + P.mod_b[l * 6 * D + n];
    { const int part = nb >> 4, col = n & (D - 1);
      if (part == 1) v = (1.0f + v) * P.norm1_w[l * D + col]; else if (part == 4) v = (1.0f + v) * P.norm2_w[l * D + col]; }
    P.MOD[(size_t)(l * 3 + who) * 6 * D + n] = v;
}
struct CombVec { f4_t m5v[4], gv[4], sv[4]; int wcur; };
template <int LYR> __device__ __forceinline__ void comb_wave(const Params& P, int row, int lane, CombVec& cv) {
    const int who = row_who(row); u2_t* xb = (u2_t*)(P.XB + (size_t)row * D);
    int inv[16];
#pragma unroll
    for (int e = 0; e < NE; ++e) inv[e] = P.INV[(size_t)e * NR + row];
    f4_t acc[4];
#pragma unroll
    for (int j = 0; j < 4; ++j) acc[j] = (f4_t){0.f, 0.f, 0.f, 0.f};
#pragma unroll
    for (int e = 0; e < NE; ++e) { const int sl = __builtin_amdgcn_readfirstlane(inv[e]);
        if (sl >= 0) { const float g = P.GATE[e * SLOTS_PAD + sl]; const u2_t* yr = (const u2_t*)(P.Y + ((size_t)e * SLOTS_PAD + sl) * D);
#pragma unroll
            for (int j = 0; j < 4; ++j) { const u2_t w = yr[j * 64 + lane]; acc[j] += g * (f4_t){bf_lo(w.x), bf_hi(w.x), bf_lo(w.y), bf_hi(w.y)}; } } }
    if (who != cv.wcur) { cv.wcur = who; const float* m5 = modv(P, LYR, who, 5);
        const float* gsrc = LYR == 0 ? modv(P, 1, who, 1) : P.final_norm_w; const float* ssrc = modv(P, 1, who, 0);
#pragma unroll
        for (int j = 0; j < 4; ++j) { cv.m5v[j] = ((const f4_t*)m5)[j * 64 + lane]; cv.gv[j] = ((const f4_t*)gsrc)[j * 64 + lane]; if (LYR == 0) cv.sv[j] = ((const f4_t*)ssrc)[j * 64 + lane]; } }
    f4_t xv[4]; float ss = 0.f;
#pragma unroll
    for (int j = 0; j < 4; ++j) { const u2_t xw = xb[j * 64 + lane]; xv[j] = (f4_t){bf_lo(xw.x), bf_hi(xw.x), bf_lo(xw.y), bf_hi(xw.y)} + cv.m5v[j] * acc[j];
        ss += xv[j][0] * xv[j][0] + xv[j][1] * xv[j][1] + xv[j][2] * xv[j][2] + xv[j][3] * xv[j][3]; }
    ss = wave_sum(ss, lane);
    const float rstd = 1.0f / sqrtf(ss * (1.0f / D) + EPS);
    if (LYR == 0) {
        const float *w = P.norm1_w + D, *sc = modv(P, 1, who, 1), *sh = modv(P, 1, who, 0); bf16_t* h = P.H + (size_t)row * D;
#pragma unroll
        for (int j = 0; j < 4; ++j) { u2_t xo; xo.x = pk_bf16(xv[j][0], xv[j][1]); xo.y = pk_bf16(xv[j][2], xv[j][3]); xb[j * 64 + lane] = xo;
            const f4_t hv = xv[j] * rstd * cv.gv[j] + cv.sv[j];
            u2_t o; o.x = pk_bf16(hv[0], hv[1]); o.y = pk_bf16(hv[2], hv[3]); ((u2_t*)h)[j * 64 + lane] = o; }
    } else {
        float* x = P.out + (size_t)row * D;
#pragma unroll
        for (int j = 0; j < 4; ++j) __builtin_nontemporal_store(xv[j] * rstd * cv.gv[j], (f4_t*)x + j * 64 + lane);
    }
}
__device__ __forceinline__ unsigned block_excl_scan(unsigned v, unsigned* wsum, int wv, int lane, unsigned& total) {
    unsigned inc = v;
#pragma unroll
    for (int o = 1; o < 64; o <<= 1) { const unsigned t = lane_read(inc, (lane - o) & 63); if (lane >= o) inc += t; }
    __syncthreads();
    if (lane == 63) wsum[wv] = inc;
    __syncthreads();
    unsigned off = 0, tot = 0;
#pragma unroll
    for (int w = 0; w < 8; ++w) { const unsigned t = wsum[w]; off += (w < wv) ? t : 0u; tot += t; }
    total = tot; return off + inc - v;
}
__device__ __forceinline__ void topk_block(const Params& P, int item, int wv, int lane, unsigned* lds) {
    const int e = item & 15, seg = item >> 4, N = seg_len(seg), cap = 2 * N / NE, tid = wv * 64 + lane, base = seg_base(seg);
    const float* a = P.AFF + ((size_t)seg * NE + e) * L;
    unsigned* K = lds; unsigned* hist = lds + 16896; unsigned* sh = hist + 16 * 256; unsigned* wsum = sh + 8;
#define KP(i) ((i) + ((i) >> 5))
    { const int n4 = N >> 2; f4_t v[8];
#pragma unroll
        for (int j = 0; j < 8; ++j) { const int q = tid + 512 * j; if (q < n4) v[j] = ((const f4_t*)a)[q]; }
#pragma unroll
        for (int j = 0; j < 8; ++j) { const int q = tid + 512 * j; if (q < n4) { const int p = KP(4 * q); K[p] = __float_as_uint(v[j][0]); K[p + 1] = __float_as_uint(v[j][1]); K[p + 2] = __float_as_uint(v[j][2]); K[p + 3] = __float_as_uint(v[j][3]); } } }
    if (tid == 0) { sh[0] = 0u; sh[1] = (unsigned)cap; }
    __syncthreads();
    for (int pass = 3; pass >= 0; --pass) {
        const int shift = pass * 8; const unsigned maskhi = pass == 3 ? 0u : (0xFFFFFFFFu << (shift + 8));
        for (int i = tid; i < 16 * 256; i += 512) hist[i] = 0u;
        __syncthreads();
        const unsigned prefix = sh[0];
        for (int i = tid; i < N; i += 512) { const unsigned k = K[KP(i)]; if ((k & maskhi) == prefix) atomicAdd(&hist[(lane & 15) * 256 + ((k >> shift) & 255u)], 1u); }
        __syncthreads();
        if (wv == 0) {
            unsigned c[4]; unsigned tot = 0;
#pragma unroll
            for (int j = 0; j < 4; ++j) { unsigned a = 0;
#pragma unroll
                for (int q = 0; q < 16; ++q) a += hist[q * 256 + 4 * lane + j];
                c[j] = a; tot += a; }
            unsigned inc = tot;
#pragma unroll
            for (int o = 1; o < 64; o <<= 1) { const unsigned t = lane_read(inc, (lane + o) & 63); if (lane + o < 64) inc += t; }
            unsigned cum = inc - tot; const unsigned rem = sh[1];
#pragma unroll
            for (int j = 3; j >= 0; --j) { if (cum < rem && rem <= cum + c[j]) { sh[0] = prefix | ((unsigned)(4 * lane + j) << shift); sh[1] = rem - cum; } cum += c[j]; }
        }
        __syncthreads();
    }
    const unsigned kstar = sh[0], need = sh[1];
    const int per = (N + 511) / 512, i0 = tid * per; const bool act = i0 < N;
    unsigned gt = 0, eq = 0;
    if (act) for (int j = 0; j < per; ++j) { const unsigned k = K[KP(i0 + j)]; gt += k > kstar ? 1u : 0u; eq += k == kstar ? 1u : 0u; }
    unsigned tot;
    const unsigned eqb = block_excl_scan(eq, wsum, wv, lane, tot);
    const unsigned take = eqb >= need ? 0u : (need - eqb < eq ? need - eqb : eq);
    unsigned slot = block_excl_scan(gt + take, wsum, wv, lane, tot) + (unsigned)(seg < 2 ? seg * CAP_L : 2 * CAP_L + (seg - 2) * CAP_C);
    unsigned tie = eqb;
    if (act) for (int j = 0; j < per; ++j) { const int i = i0 + j; const unsigned k = K[KP(i)]; bool sel = k > kstar; if (k == kstar) { sel = tie < need; ++tie; }
        if (sel) { P.ROWLIST[e * SLOTS_PAD + slot] = base + i; P.GATE[e * SLOTS_PAD + slot] = __uint_as_float(k); K[KP(i)] = slot; ++slot; }
        else K[KP(i)] = 0xFFFFFFFFu; }
    __syncthreads();
    { const int n4 = N >> 2; int4* dst = (int4*)(P.INV + (size_t)e * NR + base);
        for (int q = tid; q < n4; q += 512) { const int p = KP(4 * q); int4 o; o.x = (int)K[p]; o.y = (int)K[p + 1]; o.z = (int)K[p + 2]; o.w = (int)K[p + 3]; dst[q] = o; } }
#undef KP
    __syncthreads();
}

extern __shared__ __attribute__((aligned(16))) unsigned char shm[];

namespace hg {
typedef short bf16x8 __attribute__((ext_vector_type(8)));
typedef float f32x16 __attribute__((ext_vector_type(16)));
typedef unsigned u32x2 __attribute__((ext_vector_type(2)));
typedef unsigned u32x4 __attribute__((ext_vector_type(4)));
typedef float f32x4_t __attribute__((ext_vector_type(4)));
constexpr int CLB = 160, NCHB = TOT / CLB, NBLK = CLB / 32;
constexpr int KTP = 80, QP = 144, OFF_KT = 0, OFF_QL = 64 * KTP, OFF_KL = OFF_QL + 32 * QP, OFF_LAM = OFF_KL + 32 * QP, WAVE_LDS = OFF_LAM + 256;
static_assert(8 * WAVE_LDS <= pg8::STAGE_BYTES, "hgrn LDS");
__device__ __forceinline__ unsigned pkbf(float lo, float hi) { unsigned r; asm volatile("v_cvt_pk_bf16_f32 %0, %1, %2" : "=v"(r) : "v"(lo), "v"(hi)); return r; }
__device__ __forceinline__ bf16x8 frag2(u32x2 a, u32x2 b) { u32x4 w = {a.x, a.y, b.x, b.y}; return __builtin_bit_cast(bf16x8, w); }
__device__ __forceinline__ bf16x8 accfrag(const f32x16& x, int s2) { u32x4 w = {pkbf(x[8 * s2], x[8 * s2 + 1]), pkbf(x[8 * s2 + 2], x[8 * s2 + 3]), pkbf(x[8 * s2 + 4], x[8 * s2 + 5]), pkbf(x[8 * s2 + 6], x[8 * s2 + 7])}; return __builtin_bit_cast(bf16x8, w); }
template <int PH> __device__ __forceinline__ void b_mfma_wave(const Params& P, int l, int u, int lane, int wv) {
    const int c = u % NCHB, bdh = u / NCHB, head = bdh & 3, dir = (bdh >> 2) & 1, b = bdh >> 3, sgn = dir ? -1 : 1;
    PG8_LAS unsigned char* wl = (PG8_LAS unsigned char*)shm + wv * WAVE_LDS;
    const int kk = lane & 31, h = lane >> 5;
    const float lb = P.LB[l * 256 + head * 64 + lane];
    f32x16 S[2][2];
    float* sst = P.SST + (size_t)u * 4096 + h * 256 + kk;
#pragma unroll
    for (int mt = 0; mt < 2; ++mt)
#pragma unroll
        for (int nt = 0; nt < 2; ++nt)
#pragma unroll
            for (int r = 0; r < 16; ++r) S[mt][nt][r] = PH == 1 ? 0.f : sst[(32 * mt + (r & 3) + 8 * (r >> 2)) * 64 + 32 * nt];
    float ptot = 1.f;
    for (int jb = 0; jb < NBLK; ++jb) {
        const int rbase = scan_row(b, dir, c * CLB + 32 * jb);
        bf16x8 vf[2][2]; const int vlane = sgn * 4 * h * DIN + kk;
#pragma unroll
        for (int s2 = 0; s2 < 2; ++s2)
#pragma unroll
            for (int nt = 0; nt < 2; ++nt) { unsigned w[4];
#pragma unroll
                for (int jp = 0; jp < 4; ++jp) { const int tu = 16 * s2 + 8 * (jp >> 1) + 2 * (jp & 1);
                    const bf16_t* vu = P.Z + ((long)rbase + (long)sgn * tu) * DIN + Z_BI + head * 64 + 32 * nt;
                    w[jp] = (unsigned)vu[vlane] | ((unsigned)vu[vlane + sgn * DIN] << 16); }
                vf[s2][nt] = __builtin_bit_cast(bf16x8, (u32x4){w[0], w[1], w[2], w[3]}); }
        { float lam = 1.f; unsigned ktw[4];
          const bf16_t* zf = P.Z + (size_t)rbase * DIN + Z_BFF + dir * 256 + head * 64 + lane; const bf16_t* zq = P.Z + (size_t)rbase * DIN + Z_BQ + head * 64 + lane;
#pragma unroll
          for (int t = 0; t < 32; ++t) { const long ro = (long)sgn * t * DIN;
              const float z = bf2f(zf[ro]), e = __expf(-z), sg = __builtin_amdgcn_rcpf(1.0f + e), f = lb + (1.0f - lb) * sg, om = (1.0f - lb) * e * sg;
              lam = fmaxf(lam * f, 1e-30f);
              const float kt = om * __builtin_amdgcn_rcpf(lam);
              if (t & 1) { ktw[(t >> 1) & 3] = ((unsigned)f2bf(kt) << 16) | ktw[(t >> 1) & 3]; } else ktw[(t >> 1) & 3] = (unsigned)f2bf(kt);
              if ((t & 7) == 7) *(PG8_LAS u32x4*)(wl + OFF_KT + lane * KTP + (t >> 3) * 16) = (u32x4){ktw[0], ktw[1], ktw[2], ktw[3]};
              if (PH == 3) { const float zqv = bf2f(zq[ro]), q = zqv * __builtin_amdgcn_rcpf(1.0f + __expf(-zqv)) * 0.125f;
                  *(PG8_LAS bf16_t*)(wl + OFF_QL + t * QP + lane * 2) = f2bf(q * lam); *(PG8_LAS bf16_t*)(wl + OFF_KL + t * QP + lane * 2) = f2bf(kt); } }
          *(PG8_LAS float*)(wl + OFF_LAM + lane * 4) = lam; ptot *= lam; }
        asm volatile("s_waitcnt lgkmcnt(0)" ::: "memory");
        if (PH == 3) {
            bf16x8 qf[4], kf[4];
#pragma unroll
            for (int sl = 0; sl < 4; ++sl) { const int o = (16 * sl + 4 * h) * 2;
                qf[sl] = frag2(*(PG8_LAS u32x2*)(wl + OFF_QL + kk * QP + o), *(PG8_LAS u32x2*)(wl + OFF_QL + kk * QP + o + 16));
                kf[sl] = frag2(*(PG8_LAS u32x2*)(wl + OFF_KL + kk * QP + o), *(PG8_LAS u32x2*)(wl + OFF_KL + kk * QP + o + 16)); }
            f32x16 ct = {};
#pragma unroll
            for (int sl = 0; sl < 4; ++sl) ct = __builtin_amdgcn_mfma_f32_32x32x16_bf16(kf[sl], qf[sl], ct, 0, 0, 0);
#pragma unroll
            for (int r = 0; r < 16; ++r) { const int sr = (r & 3) + 8 * (r >> 2) + 4 * h; if (sr > kk) ct[r] = 0.f; }
            const bf16x8 af0 = accfrag(ct, 0), af1 = accfrag(ct, 1);
            f32x16 o[2] = {{}, {}};
#pragma unroll
            for (int nt = 0; nt < 2; ++nt) {
#pragma unroll
                for (int sl = 0; sl < 4; ++sl) o[nt] = __builtin_amdgcn_mfma_f32_32x32x16_bf16(qf[sl], accfrag(S[sl >> 1][nt], sl & 1), o[nt], 0, 0, 0);
                o[nt] = __builtin_amdgcn_mfma_f32_32x32x16_bf16(af0, vf[0][nt], o[nt], 0, 0, 0);
                o[nt] = __builtin_amdgcn_mfma_f32_32x32x16_bf16(af1, vf[1][nt], o[nt], 0, 0, 0); }
#pragma unroll
            for (int nt = 0; nt < 2; ++nt)
#pragma unroll
                for (int r = 0; r < 16; ++r) { bf16_t* hu = P.HB + ((long)dir * NR + rbase + (long)sgn * ((r & 3) + 8 * (r >> 2))) * 256 + head * 64 + 32 * nt;
                    hu[sgn * 4 * h * 256 + kk] = f2bf(o[nt][r]); }
        }
#pragma unroll
        for (int mt = 0; mt < 2; ++mt) {
            bf16x8 a0, a1; { const int ro = (32 * mt + kk) * KTP + 4 * h * 2;
                a0 = frag2(*(PG8_LAS u32x2*)(wl + OFF_KT + ro), *(PG8_LAS u32x2*)(wl + OFF_KT + ro + 16));
                a1 = frag2(*(PG8_LAS u32x2*)(wl + OFF_KT + ro + 32), *(PG8_LAS u32x2*)(wl + OFF_KT + ro + 48)); }
#pragma unroll
            for (int nt = 0; nt < 2; ++nt) { S[mt][nt] = __builtin_amdgcn_mfma_f32_32x32x16_bf16(a0, vf[0][nt], S[mt][nt], 0, 0, 0); S[mt][nt] = __builtin_amdgcn_mfma_f32_32x32x16_bf16(a1, vf[1][nt], S[mt][nt], 0, 0, 0); }
#pragma unroll
            for (int g = 0; g < 4; ++g) { const f32x4_t lm = *(PG8_LAS f32x4_t*)(wl + OFF_LAM + (32 * mt + 8 * g + 4 * h) * 4);
#pragma unroll
                for (int nt = 0; nt < 2; ++nt) { S[mt][nt][4 * g] *= lm[0]; S[mt][nt][4 * g + 1] *= lm[1]; S[mt][nt][4 * g + 2] *= lm[2]; S[mt][nt][4 * g + 3] *= lm[3]; } } }
        asm volatile("s_waitcnt lgkmcnt(0)" ::: "memory");
    }
    if (PH == 1) {
#pragma unroll
        for (int mt = 0; mt < 2; ++mt)
#pragma unroll
            for (int nt = 0; nt < 2; ++nt)
#pragma unroll
                for (int r = 0; r < 16; ++r) sst[(32 * mt + (r & 3) + 8 * (r >> 2)) * 64 + 32 * nt] = S[mt][nt][r];
        P.PST[(size_t)u * 64 + lane] = ptot; }
}
}

struct GpuExec {
    int wv;
    __device__ __forceinline__ PG8_LAS unsigned char* lds() const { return (PG8_LAS unsigned char*)shm; }
    template <class F> __device__ __forceinline__ void run(i64 n, F f) { const Params& P = fresh_params(); const int G = grid_dim(); const i64 gsz = (i64)G * 512; for (i64 i = ((i64)wv * G + block_id()) * 64 + lane_id(); i < n; i += gsz) f(P, i); }
    __device__ __forceinline__ void sync_soft() {}
    template <class F> __device__ __forceinline__ void run_skipctx(i64 n, F f) { const Params& P = fresh_params(); const int G = grid_dim(), bid = block_id();
        if (G != 256) { for (i64 i = ((i64)wv * G + bid) * 64 + lane_id(); i < n; i += (i64)G * 512) f(P, i); return; }
        if (bid < 128 && (bid & 7) == 0) return;
        const int G2 = 240, rk = bid >= 128 ? bid - 16 : bid - (bid >> 3) - 1;
        for (i64 i = ((i64)wv * G2 + rk) * 64 + lane_id(); i < n; i += (i64)G2 * 512) f(P, i); }
    __device__ __forceinline__ void sync() { XcdBarrier b; b.bar = fresh_params().bar; b.x = xb_xcc_id(); b.st = (volatile LAS unsigned*)(lds() + pg8::STAGE_BYTES); xcd_barrier(b, wv == 0 && lane_id() == 0); }
    template <class F> __device__ __forceinline__ void run_from(int b0, i64 n, F f) {
        const Params& P = fresh_params(); const int G = grid_dim(), bid = block_id(), o = G > b0 ? b0 : 0, G2 = G - o; if (bid < o) return;
        const i64 gsz = (i64)G2 * 512; for (i64 i = ((i64)wv * G2 + (bid - o)) * 64 + lane_id(); i < n; i += gsz) f(P, i); }
    template <class F> __device__ __forceinline__ void run_wave_from(int b0, int n, F f) { const Params& P = fresh_params(); const int lane = lane_id(), G = grid_dim(), bid = block_id(), o = G > 2 * b0 ? b0 : 0, G2 = G - o; if (bid < o) return;
        for (int r = wv * G2 + (bid - o); r < n; r += G2 * 8) f(P, r, lane); }
    template <class F> __device__ __forceinline__ void run_wave(int n, F f) { const Params& P = fresh_params(); const int lane = lane_id(), G = grid_dim(), nw = G * 8; for (int r = wv * G + block_id(); r < n; r += nw) f(P, r, lane); }
    __device__ __forceinline__ void mod() { run_wave(2 * 3 * 96, [&](const Params& P, int w, int lane) { mod_wave(P, w, lane); }); }
    template <int WHICH> __device__ __forceinline__ void norm_phase(int l, int n) { const Params& P = fresh_params(); const int lane = lane_id(), G = grid_dim(), nw = G * 8;
        for (int r = wv * G + block_id(); r < n; r += 4 * nw) norm_rows<4>(P, l, WHICH, r, nw, n, lane, [&](int rr) { return WHICH == 1 ? xsrc_row(P, l, rr) : (const float*)xcur_row(P, rr); }, [&](int rr) { return P.H + (size_t)rr * D; }); }
    __device__ __forceinline__ void norm1(int l) { if (l == 0) norm_phase<1>(l, NR); }
    __device__ __forceinline__ void comb(int l) { CombVec cv; cv.wcur = -1; if (l == 0) run_wave(NR, [&](const Params& P, int r, int lane) { comb_wave<0>(P, r, lane, cv); }); else run_wave(NLAT, [&](const Params& P, int r, int lane) { comb_wave<1>(P, r, lane, cv); }); }
    __device__ __forceinline__ void norm2(int l) { const Params& P = fresh_params(); const int lane = lane_id(), G = grid_dim(), nw = G * 8, n = nrows_out(l);
        for (int r = wv * G + block_id(); r < n; r += 8 * nw) norm_rows16<8>(P, l, r, nw, n, lane, [&](int rr) { return P.H + (size_t)rr * D; }); }
    __device__ __forceinline__ void final_norm() {}
    __device__ __forceinline__ void xa(int l) { const Params& P = fresh_params(); const int G = grid_dim(); const i64 gsz = (i64)G * 512, n = (i64)NR * 32;
        i64 i = ((i64)wv * G + block_id()) * 64 + lane_id(); const int c8 = (int)(i & 31) * 8;
        float bw[8], w[4][8]; ld8f(P.a_conv_b + l * 256 + c8, bw);
#pragma unroll
        for (int j = 0; j < 4; ++j) ld8f(P.a_conv_w + (l * 4 + j) * 256 + c8, w[j]);
        for (; i < n; i += gsz) { const int row = (int)(i >> 5), seg = row_seg(row), t = row - seg_base(seg), len = seg_len(seg);
            float s[8];
#pragma unroll
            for (int q = 0; q < 8; ++q) s[q] = bw[q];
#pragma unroll
            for (int j = 0; j < 4; ++j) { const int tt = t + j - 2; if (tt >= 0 && tt < len) { float x[8]; ld8(P.Z + (size_t)(row + j - 2) * DIN + Z_AX + c8, x);
#pragma unroll
                for (int q = 0; q < 8; ++q) s[q] += w[j][q] * x[q]; } }
            st8(P.XAB + (size_t)row * 256 + c8, s); } }
    __device__ __forceinline__ void qkv_prep(int l) { run((i64)NR * 4, [&](const Params& P, i64 i) { st_qkv_prep_k(P, l, i); }); }
    __device__ __forceinline__ void b_pre(int l) {}
    __device__ __forceinline__ void b_scan(int l, int ph) {
        if (ph == 1) run_wave_from(8, 16 * hg::NCHB, [&](const Params& P, int u, int lane) { hg::b_mfma_wave<1>(P, l, u, lane, wv); });
        else if (ph == 2) { if (l == 0) run_skipctx((i64)2 * 2 * 4 * 4096, [&](const Params& P, i64 i) { st_b_scan2<hg::NCHB>(P, l, i); }); else run((i64)2 * 2 * 4 * 4096, [&](const Params& P, i64 i) { st_b_scan2<hg::NCHB>(P, l, i); }); }
        else run_wave(16 * hg::NCHB, [&](const Params& P, int u, int lane) { hg::b_mfma_wave<3>(P, l, u, lane, wv); });
    }
    __device__ __forceinline__ void topk(int l) { const Params& P = fresh_params(); const int lane = lane_id(); for (int it = block_id(); it < (l == 0 ? 4 : 2) * 16; it += grid_dim()) topk_block(P, it, wv, lane, (unsigned*)shm); }
    __device__ __forceinline__ void inproj(int l) {
        const Params& P = fresh_params();
        pg8::StaticOrder S; S.init(NR, DIN, grid_dim(), block_id());
        pg8::EpiZ E{P.Z, DIN};
        pg8::gemm_phase<pg8::EpiZ, pg8::StaticOrder, false>(lds(), pg8::Gemm{P.H, P.WINT, NR, DIN, D}, S, E, nullptr, wv);
    }
    __device__ __forceinline__ void a_coef(int l) {
        const Params& P = fresh_params();
        pg8::StaticOrder S; S.init(NR, 1024, grid_dim(), block_id());
        pg8::EpiCoef E{&P, l};
        pg8::gemm_phase<pg8::EpiCoef, pg8::StaticOrder, false>(lds(), pg8::Gemm{P.XAB, P.WG, NR, 1024, 256}, S, E, nullptr, wv);
    }
    __device__ __forceinline__ void router(int l) {
        const Params& P = fresh_params();
        pg8::StaticOrder S; S.init(nrows_out(l), 256, grid_dim(), block_id());
        pg8::EpiRouter E{P.AFF};
        pg8::gemm_phase<pg8::EpiRouter, pg8::StaticOrder, false>(lds(), pg8::Gemm{P.H, P.RWT, nrows_out(l), 256, D}, S, E, nullptr, wv);
    }
    __device__ __forceinline__ void outproj(int l) {
        const Params& P = fresh_params();
        pg8::StaticOrder S; S.init(nrows_out(l), D, grid_dim(), block_id());
        if (l == 0) { pg8::EpiOut<false> E{P.x, P.ctx, nullptr, P.XB, P.MOD + (size_t)l * 3 * 6 * D};
            pg8::gemm_phase<pg8::EpiOut<false>, pg8::StaticOrder, false>(lds(), pg8::Gemm{P.YM, P.WOUTT, nrows_out(l), D, D}, S, E, nullptr, wv); }
        else { pg8::EpiOut<true> E{nullptr, nullptr, P.XB, P.XB, P.MOD + (size_t)l * 3 * 6 * D};
            pg8::gemm_phase<pg8::EpiOut<true>, pg8::StaticOrder, false>(lds(), pg8::Gemm{P.YM, P.WOUTT, nrows_out(l), D, D}, S, E, nullptr, wv); }
    }
    __device__ __forceinline__ void attn_dense(int l) {
        const Params& P = fresh_params();
        if (P.FLAGS[l]) {
            attn_body::attn_phase<0, 8, true>((char*)shm, (const attn_body::bf16*)P.Z, (attn_body::bf16*)P.YM, wv, nullptr, P.d_qnorm_w + l * 64, P.ROPE);
            if (l == 0) attn_body::attn_phase<3, 8, true>((char*)shm, (const attn_body::bf16*)P.Z, (attn_body::bf16*)P.YM, wv, nullptr, P.d_qnorm_w + l * 64, P.ROPE);
        } else {
            attn_body::attn_phase<0, 8>((char*)shm, (const attn_body::bf16*)P.Z, (attn_body::bf16*)P.YM, wv, nullptr, P.d_qnorm_w + l * 64, P.ROPE);
            if (l == 0) attn_body::attn_phase<3, 8>((char*)shm, (const attn_body::bf16*)P.Z, (attn_body::bf16*)P.YM, wv, nullptr, P.d_qnorm_w + l * 64, P.ROPE);
        }
    }
    __device__ __forceinline__ void attn_win(int l) {
        const Params& P = fresh_params();
        attn_body::attn_phase<1, 8>((char*)shm, (const attn_body::bf16*)P.Z, (attn_body::bf16*)P.YM, wv, P.c_sink + l * 4, nullptr, P.ROPE);
        if (l == 0) attn_body::attn_phase<2, 8>((char*)shm, (const attn_body::bf16*)P.Z, (attn_body::bf16*)P.YM, wv, P.c_sink + l * 4, nullptr, P.ROPE);
    }
    __device__ __forceinline__ void moe1(int l) {
        const Params& P = fresh_params();
        pg8::GroupOrder S; S.init(nslots(l), 8, grid_dim(), block_id());
        pg8::EpiHid E{P.HID};
        pg8::gemm_phase<pg8::EpiHid, pg8::GroupOrder, false, true, true>(lds(), pg8::Gemm{P.H, P.W13T, NE * SLOTS_PAD, NE * 2048, D}, S, E, nullptr, wv, P.ROWLIST);
    }
    __device__ __forceinline__ void moe2(int l) {
        const Params& P = fresh_params();
        pg8::GroupOrder S; S.init(nslots(l), 4, grid_dim(), block_id());
        pg8::EpiY E{P.Y};
        pg8::gemm_phase<pg8::EpiY, pg8::GroupOrder, false, false, true>(lds(), pg8::Gemm{P.HID, P.W2T, NE * SLOTS_PAD, NE * 1024, 1024}, S, E, nullptr, wv);
    }
};

__global__ void __launch_bounds__(512, 2) mega_fwd(Params P) {
    GpuExec ex; ex.wv = __builtin_amdgcn_readfirstlane((int)threadIdx.x >> 6);
    volatile LAS unsigned* xbw = (volatile LAS unsigned*)(ex.lds() + pg8::STAGE_BYTES);
    if (threadIdx.x < 4) xbw[threadIdx.x] = 0u;
    __syncthreads();
    (void)xcd_barrier_post(fresh_params().bar, xbw, threadIdx.x == 0);
    pipeline(ex);
}

extern "C" void kernel_launch(void* const* d_in, const int* in_sizes, int n_in, void* d_out, int out_size, void* d_ws, size_t ws_size, hipStream_t stream) {
    Params P{};
    const float** f = (const float**)&P;
    for (int i = 0; i < 27; ++i) f[i] = (const float*)d_in[i];
    P.out = (float*)d_out;
    const size_t need = carve(P, (char*)d_ws);
    if (need > ws_size) fprintf(stderr, "workspace too small: need %zu have %zu\n", need, ws_size);
    static int grid = 0;
    if (!grid) {
        int dev = 0, cus = 0, per_cu = 0;
        (void)hipGetDevice(&dev);
        (void)hipDeviceGetAttribute(&cus, hipDeviceAttributeMultiprocessorCount, dev);
        (void)hipFuncSetAttribute((const void*)mega_fwd, hipFuncAttributeMaxDynamicSharedMemorySize, LDS_BYTES);
        (void)hipOccupancyMaxActiveBlocksPerMultiprocessor(&per_cu, mega_fwd, 512, LDS_BYTES);
        grid = cus * (per_cu < 1 ? per_cu : 1);
        if (grid <= 0) grid = 256;
    }
    (void)hipMemsetAsync(P.bar, 0, XCD_BAR_WORDS * sizeof(unsigned), stream);
    hipLaunchKernelGGL(mega_fwd, dim3(grid), dim3(512), LDS_BYTES, stream, P);
}
#endif
```

```cpp
#ifndef CPU_TEST
#include <hip/hip_runtime.h>
#include <hip/hip_bf16.h>
#include <cstdio>
#include <cstdint>
#define HD __device__ __forceinline__
#else
#include <cmath>
#include <cstdio>
#include <cstdint>
#include <cstring>
#define HD inline
#endif

#ifndef CFG_SEQ
#define CFG_SEQ 16384
#endif
#ifndef CFG_CTX
#define CFG_CTX 256
#endif

typedef unsigned short bf16_t;
typedef long long i64;

constexpr int NB = 2, L = CFG_SEQ, LC = CFG_CTX, D = 1024, DIN = 2816;
constexpr int NLAT = NB * L, NCTX = NB * LC, NR = NLAT + NCTX;
constexpr int NE = 16, CAP_L = 2 * L / NE, CAP_C = 2 * LC / NE;
constexpr int SLOTS_L = NB * CAP_L, SLOTS_ALL = NB * CAP_L + NB * CAP_C, SLOTS_PAD = ((SLOTS_ALL + 255) / 256) * 256;
constexpr int WINDOW = 128;
constexpr int TOT = LC + L, NCH = 128, CL = TOT / NCH;
static_assert(TOT % NCH == 0, "chunking");
static_assert(NCH % 8 == 0, "scan2 batches");
constexpr float EPS = 1e-6f;
constexpr float QC2 = 0.125f * 1.4426950408889634f;
constexpr int Z_AX = 0, Z_AY = 256, Z_BQ = 512, Z_BFF = 768, Z_BFB = 1024, Z_BI = 1280, Z_BG = 1536,
              Z_CQ = 1792, Z_CK = 2048, Z_CV = 2176, Z_DQ = 2304, Z_DK = 2560, Z_DV = 2688;

struct Params {
    const float *x, *c, *ctx, *c_ctx, *mod_w, *mod_b, *norm1_w, *w_in, *a_conv_w, *a_conv_b, *a_gate_a_w, *a_gate_a_b,
                *a_gate_x_w, *a_gate_x_b, *a_lambda, *b_lb_logits, *b_onorm_w, *c_sink, *d_qnorm_w, *d_knorm_w, *w_out,
                *norm2_w, *router_w, *exp_w1, *exp_w3, *exp_w2, *final_norm_w;
    float* out;
    unsigned* bar;
    float *MOD, *LB, *ROPE, *XC, *AFF, *GATE, *SP8;
    int *ROWLIST, *INV, *FLAGS;
    bf16_t *H, *Z, *YM, *HID, *Y, *XS;
    bf16_t *WINT, *WOUTT, *W13T, *W2T;
    bf16_t *RWT;
    bf16_t *XAB, *WG;
    bf16_t *CA, *CU;
    float *BQ, *BF; bf16_t *HB;
    float *CRA, *CRH, *SST, *PST;
    bf16_t* XB;
};

struct Carver { char* base; size_t off; void* take(size_t bytes) { void* p = base + off; off += (bytes + 255) & ~(size_t)255; return p; } };
inline size_t carve(Params& P, char* ws) {
    Carver c{ws, 0};
    P.bar = (unsigned*)c.take(16384);
    P.MOD = (float*)c.take(sizeof(float) * 2 * 3 * 6 * D);
    P.LB = (float*)c.take(sizeof(float) * 2 * 256);
    P.SP8 = (float*)c.take(sizeof(float) * 2 * 2 * 256);
    P.ROPE = (float*)c.take(sizeof(float) * 256 * 16 * 2);
    P.XC = (float*)c.take(sizeof(float) * (size_t)NCTX * D);
    P.AFF = (float*)c.take(sizeof(float) * (size_t)4 * NE * L);
    P.GATE = (float*)c.take(sizeof(float) * (size_t)NE * SLOTS_PAD);
    P.ROWLIST = (int*)c.take(sizeof(int) * (size_t)NE * SLOTS_PAD);
    P.INV = (int*)c.take(sizeof(int) * (size_t)NR * NE);
    P.FLAGS = (int*)c.take(256);
    P.WINT = (bf16_t*)c.take(2 * (size_t)DIN * D);
    P.WOUTT = (bf16_t*)c.take(2 * (size_t)D * D);
    P.W13T = (bf16_t*)c.take(2 * (size_t)NE * 2048 * D);
    P.W2T = (bf16_t*)c.take(2 * (size_t)NE * D * 1024);
    P.WG = (bf16_t*)c.take(2 * (size_t)1024 * 256);
    P.RWT = (bf16_t*)c.take(2 * (size_t)256 * D);
    P.H = (bf16_t*)c.take(2 * (size_t)NR * D);
    P.YM = P.H;
    const size_t zbytes = 2 * (size_t)NR * DIN, hidbytes = 2 * (size_t)NE * SLOTS_PAD * D;
    char* zreg = (char*)c.take(zbytes > hidbytes ? zbytes : hidbytes);
    P.Z = (bf16_t*)zreg; P.HID = (bf16_t*)zreg;
    const size_t f256 = sizeof(float) * (size_t)NR * 256, h256 = f256 / 2;
    const size_t crbytes = sizeof(float) * 4 * NCH * 256, sstbytes = sizeof(float) * (size_t)16 * NCH * 4096, pstbytes = sizeof(float) * 16 * NCH * 64;
    size_t tbytes = 5 * h256 + 2 * h256 + 2 * crbytes + sstbytes + pstbytes; if (tbytes < hidbytes) tbytes = hidbytes;
    char* treg = (char*)c.take(tbytes);
    P.XAB = (bf16_t*)treg; P.CA = (bf16_t*)(treg + h256); P.CU = (bf16_t*)(treg + 3 * h256); P.HB = (bf16_t*)(treg + 5 * h256);
    { char* q = treg + 5 * h256 + 2 * h256; P.CRA = (float*)q; P.CRH = (float*)(q + crbytes); P.SST = (float*)(q + 2 * crbytes); P.PST = (float*)(q + 2 * crbytes + sstbytes); }
#ifdef CPU_TEST
    P.BQ = (float*)c.take(f256); P.BF = (float*)c.take(2 * f256);
#else
    P.BQ = nullptr; P.BF = nullptr;
#endif
    P.XS = (bf16_t*)treg; P.Y = (bf16_t*)treg;
    P.XB = (bf16_t*)c.take(2 * (size_t)NR * D);
    return c.off;
}

struct alignas(16) U4 { unsigned x, y, z, w; };
struct alignas(16) F4 { float x, y, z, w; };
HD F4 ldnt4(const float* p) {
#if defined(__HIP_DEVICE_COMPILE__)
    typedef float v4f_ __attribute__((ext_vector_type(4))); const v4f_ v = __builtin_nontemporal_load((const v4f_*)p); return F4{v.x, v.y, v.z, v.w};
#else
    return *(const F4*)p;
#endif
}
HD float bf_lo(unsigned u) { union { unsigned u; float f; } c; c.u = u << 16; return c.f; }
HD float bf_hi(unsigned u) { union { unsigned u; float f; } c; c.u = u & 0xffff0000u; return c.f; }
HD unsigned pk2(float lo, float hi);
HD void ld8(const bf16_t* p, float (&v)[8]) { const U4 u = *(const U4*)p; v[0] = bf_lo(u.x); v[1] = bf_hi(u.x); v[2] = bf_lo(u.y); v[3] = bf_hi(u.y); v[4] = bf_lo(u.z); v[5] = bf_hi(u.z); v[6] = bf_lo(u.w); v[7] = bf_hi(u.w); }
HD void ld8f(const float* p, float (&v)[8]) { const F4 a = *(const F4*)p, b = *(const F4*)(p + 4); v[0] = a.x; v[1] = a.y; v[2] = a.z; v[3] = a.w; v[4] = b.x; v[5] = b.y; v[6] = b.z; v[7] = b.w; }
HD void st8f(float* p, const float (&v)[8]) { *(F4*)p = F4{v[0], v[1], v[2], v[3]}; *(F4*)(p + 4) = F4{v[4], v[5], v[6], v[7]}; }
HD float bf2f(bf16_t v) { union { unsigned u; float f; } c; c.u = ((unsigned)v) << 16; return c.f; }
HD bf16_t f2bf(float f) { union { unsigned u; float f; } c; c.f = f; unsigned u = c.u; u += 0x7FFFu + ((u >> 16) & 1u); return (bf16_t)(u >> 16); }
HD unsigned pk2(float lo, float hi) { return (unsigned)f2bf(lo) | ((unsigned)f2bf(hi) << 16); }
HD void st8(bf16_t* p, const float (&v)[8]) { *(U4*)p = U4{pk2(v[0], v[1]), pk2(v[2], v[3]), pk2(v[4], v[5]), pk2(v[6], v[7])}; }
HD float sigmoidf_(float x) { return 1.0f / (1.0f + expf(-x)); }
HD float siluf_(float x) { return x * sigmoidf_(x); }
HD float gelu_tanh_(float x) { return 0.5f * x * (1.0f + tanhf(0.7978845608028654f * (x + 0.044715f * x * x * x))); }

HD int row_who(int row) { return row < NLAT ? row / L : 2; }
HD int row_seg(int row) { return row < NLAT ? row / L : 2 + (row - NLAT) / LC; }
HD int seg_base(int seg) { return seg < 2 ? seg * L : NLAT + (seg - 2) * LC; }
HD int seg_len(int seg) { return seg < 2 ? L : LC; }
HD const float* modv(const Params& P, int l, int who, int part) { return P.MOD + ((size_t)(l * 3 + who) * 6 + part) * D; }
HD const float* xsrc_row(const Params& P, int l, int row) {
    if (row < NLAT) return (l == 0 ? P.x : P.out) + (size_t)row * D;
    return (l == 0 ? P.ctx : P.XC) + (size_t)(row - NLAT) * D;
}
HD float* xcur_row(const Params& P, int row) { return row < NLAT ? P.out + (size_t)row * D : P.XC + (size_t)(row - NLAT) * D; }
HD int nrows_out(int l) { return l == 0 ? NR : NLAT; }
HD int nslots(int l) { return l == 0 ? SLOTS_ALL : SLOTS_L; }

HD void st_mod(const Params& P, i64 i) {
    const int n = (int)(i % (6 * D)), who = (int)((i / (6 * D)) % 3), l = (int)(i / (6 * D) / 3);
    const float* cv = who < 2 ? P.c + who * D : P.c_ctx;
    const float* w = P.mod_w + (size_t)l * D * 6 * D + n;
    float s = 0.f;
    for (int k = 0; k < D; ++k) s += siluf_(cv[k]) * w[(size_t)k * 6 * D];
    P.MOD[i] = s + P.mod_b[l * 6 * D + n];
}
HD void st_lb(const Params& P, i64 i) {
    const float a = P.b_lb_logits[i], b = P.b_lb_logits[256 + i], m = fmaxf(a, b);
    const float ea = expf(a - m), eb = expf(b - m), s0 = ea / (ea + eb), s1 = eb / (ea + eb);
    P.LB[i] = s0 - s0; P.LB[256 + i] = (s0 + s1) - s0;
}
HD void st_flags(const Params& P, i64 l) {
    float mq = 0.f, mk = 0.f; for (int e = 0; e < 64; ++e) { mq = fmaxf(mq, fabsf(P.d_qnorm_w[l * 64 + e])); mk = fmaxf(mk, fabsf(P.d_knorm_w[l * 64 + e])); }
    P.FLAGS[l] = (8.0f * 1.4426950408889634f * mq * mk <= 60.0f) ? 1 : 0;
}
HD void st_sp8(const Params& P, i64 i) {
    P.SP8[i] = -8.0f * log1pf(expf(-P.a_lambda[i]));
}
HD void st_rope(const Params& P, i64 i) {
    const int f = (int)(i & 15), pos = (int)(i >> 4);
    const float inv = (float)exp(-(double)f / 16.0 * 9.210340371976184);
    const float ang = (float)pos * inv;
    double y = (double)ang;
    const double twopi = 6.283185307179586476925;
    y -= twopi * floor(y / twopi + 0.5);
    double s = 0.0, cc = 0.0, term = 1.0;
    for (int n = 0; n < 30; ++n) { if (n & 1) s += ((n >> 1) & 1) ? -term : term; else cc += ((n >> 1) & 1) ? -term : term; term *= y / (double)(n + 1); }
    P.ROPE[i * 2] = (float)cc; P.ROPE[i * 2 + 1] = (float)s;
}

template <class RowFn> HD void cvt_tile(const float* src, size_t ld, int N, size_t K, i64 i, bf16_t* dst, RowFn dst_row) {
    const int li = (int)(i & 63); const i64 w = i >> 6; const int nq = li & 15, kq = li >> 4, ntl = N / 64, nt = (int)(w % ntl), kt = (int)(w / ntl);
    const int n0 = nt * 64 + nq * 4, k0 = kt * 64 + kq * 16;
    float v[16][4];
#pragma unroll
    for (int r = 0; r < 16; ++r) { const F4 t = ldnt4(src + (size_t)(k0 + r) * ld + n0); v[r][0] = t.x; v[r][1] = t.y; v[r][2] = t.z; v[r][3] = t.w; }
#pragma unroll
    for (int j = 0; j < 4; ++j) { bf16_t* d = dst + (size_t)dst_row(n0 + j) * K + k0; float a[8], b[8];
#pragma unroll
        for (int r = 0; r < 8; ++r) { a[r] = v[r][j]; b[r] = v[8 + r][j]; }
        st8(d, a); st8(d + 8, b); }
}
HD void st_cvt_win(const Params& P, int l, i64 i) {
    cvt_tile(P.w_in + (size_t)l * D * DIN, DIN, DIN, D, i, P.WINT, [](int n) { return n; });
}
HD void st_cvt_wout(const Params& P, int l, i64 i) {
    cvt_tile(P.w_out + (size_t)l * D * D, D, D, D, i, P.WOUTT, [](int n) { return n; });
}
HD void st_cvt_w13(const Params& P, int l, i64 i) {
    const int which = (int)((i >> 14) & 1), e = (int)(i >> 15);
    const float* src = (which ? P.exp_w3 : P.exp_w1) + (size_t)(l * NE + e) * D * 1024;
    cvt_tile(src, 1024, 1024, D, i & 16383, P.W13T + (size_t)e * 2048 * D, [which](int f) { return (f >> 7) * 256 + which * 128 + (f & 127); });
}
HD void st_cvt_w2(const Params& P, int l, i64 i) {
    const int e = (int)(i >> 14);
    cvt_tile(P.exp_w2 + (size_t)(l * NE + e) * 1024 * D, D, D, 1024, i & 16383, P.W2T + (size_t)e * D * 1024, [](int n) { return n; });
}

HD void st_norm1(const Params& P, int l, i64 row) {
    const float* x = xsrc_row(P, l, (int)row);
    float ss = 0.f; for (int d = 0; d < D; ++d) ss += x[d] * x[d];
    const float rstd = 1.0f / sqrtf(ss * (1.0f / D) + EPS);
    const int who = row_who((int)row);
    const float *sh = modv(P, l, who, 0), *sc = modv(P, l, who, 1), *w = P.norm1_w + l * D;
    bf16_t* h = P.H + (size_t)row * D;
    for (int d = 0; d < D; ++d) h[d] = f2bf(x[d] * rstd * w[d] * (1.0f + sc[d]) + sh[d]);
}
HD void st_inproj(const Params& P, int l, i64 i) {
    const int n = (int)(i % DIN); const i64 row = i / DIN;
    const bf16_t* h = P.H + (size_t)row * D; const bf16_t* w = P.WINT + (size_t)n * D;
    float s = 0.f; for (int k = 0; k < D; ++k) s += bf2f(h[k]) * bf2f(w[k]);
    P.Z[i] = f2bf(s);
}
HD void st_cvt_wg(const Params& P, int l, i64 i) {
    const int kb = (int)(i & 31), n = (int)(i >> 5), pn = n >> 8, r = n & 255, g = r >> 7, ch = (pn & 1) * 128 + (r & 127), dir = pn >> 1, blk = ch >> 6, j = ch & 63;
    const float* w = (g ? P.a_gate_x_w : P.a_gate_a_w) + ((size_t)((l * 2 + dir) * 4 + blk) * 64) * 64 + j;
    bf16_t* dst = P.WG + (size_t)n * 256 + kb * 8;
    for (int q = 0; q < 8; ++q) { const int k = kb * 8 + q; dst[q] = (k >> 6) == blk ? f2bf(w[(size_t)(k & 63) * 64]) : (bf16_t)0; }
}
HD void st_xa(const Params& P, int l, i64 i) {
    const int c8 = (int)(i & 31) * 8, row = (int)(i >> 5), seg = row_seg(row), t = row - seg_base(seg), len = seg_len(seg);
    float s[8]; ld8f(P.a_conv_b + l * 256 + c8, s);
    for (int j = 0; j < 4; ++j) { const int tt = t + j - 2; if (tt >= 0 && tt < len) { float w[8], x[8]; ld8f(P.a_conv_w + (l * 4 + j) * 256 + c8, w); ld8(P.Z + (size_t)(row + j - 2) * DIN + Z_AX + c8, x);
#pragma unroll
        for (int q = 0; q < 8; ++q) s[q] += w[q] * x[q]; } }
    st8(P.XAB + (size_t)row * 256 + c8, s);
}
HD void a_coef_elem(const Params& P, int l, int dir, float pa, float px, float xa, int ch, float& oma, float& u) {
    const float r = sigmoidf_(pa + P.a_gate_a_b[(l * 2 + dir) * 256 + ch]), ig = sigmoidf_(px + P.a_gate_x_b[(l * 2 + dir) * 256 + ch]);
    const float log_a = -8.0f * r * log1pf(expf(-P.a_lambda[(l * 2 + dir) * 256 + ch]));
    oma = -expm1f(log_a); u = sqrtf(-expm1f(2.0f * log_a)) * (ig * xa);
}
HD void st_a_coef(const Params& P, int l, i64 i) {
    const int ch = (int)(i & 255); const i64 rr = i >> 8; const int row = (int)(rr % NR), dir = (int)(rr / NR);
    const bf16_t* xa = P.XAB + (size_t)row * 256;
    const bf16_t* wa = P.WG + (size_t)((dir * 2 + (ch >> 7)) * 256 + (ch & 127)) * 256; const bf16_t* wx = wa + (size_t)128 * 256;
    float pa = 0.f, px = 0.f;
    for (int k = 0; k < 256; ++k) { const float x = bf2f(xa[k]); pa += x * bf2f(wa[k]); px += x * bf2f(wx[k]); }
    float oma, u; a_coef_elem(P, l, dir, pa, px, bf2f(xa[ch]), ch, oma, u); P.CA[i] = f2bf(oma); P.CU[i] = f2bf(u);
}
HD int scan_row(int b, int dir, int s) {
    if (s < LC) return NLAT + b * LC + (dir ? LC - 1 - s : s);
    const int t = s - LC; return b * L + (dir ? L - 1 - t : t);
}
constexpr int SB = (CL % 10 == 0) ? 10 : ((CL % 6 == 0) ? 6 : 1);
HD void st_a_scan1(const Params& P, int l, i64 i) {
    const int ch = (int)(i & 255), c = (int)((i >> 8) % NCH), bd = (int)((i >> 8) / NCH), dir = bd & 1, b = bd >> 1;
    float h = 0.f, A = 1.f;
    for (int s0 = c * CL; s0 < (c + 1) * CL; s0 += SB) { float av[SB], uv[SB];
#pragma unroll
        for (int q = 0; q < SB; ++q) { const size_t idx = ((size_t)dir * NR + scan_row(b, dir, s0 + q)) * 256 + ch; av[q] = 1.0f - bf2f(P.CA[idx]); uv[q] = bf2f(P.CU[idx]); }
#pragma unroll
        for (int q = 0; q < SB; ++q) { h = av[q] * h + uv[q]; A *= av[q]; } }
    P.CRA[i] = A; P.CRH[i] = h;
}
HD void st_a_scan2(const Params& P, int l, i64 i) {
    const int ch = (int)(i & 255), bd = (int)(i >> 8);
    float carry = 0.f;
    for (int c0 = 0; c0 < NCH; c0 += 8) { float Av[8], hv[8];
#pragma unroll
        for (int q = 0; q < 8; ++q) { const size_t k = ((size_t)bd * NCH + c0 + q) * 256 + ch; Av[q] = P.CRA[k]; hv[q] = P.CRH[k]; }
#pragma unroll
        for (int q = 0; q < 8; ++q) { const size_t k = ((size_t)bd * NCH + c0 + q) * 256 + ch; P.CRH[k] = carry; carry = Av[q] * carry + hv[q]; } }
}
HD void st_a_scan3(const Params& P, int l, i64 i) {
    const int ch = (int)(i & 255), c = (int)((i >> 8) % NCH), bd = (int)((i >> 8) / NCH), dir = bd & 1, b = bd >> 1;
    float h = 0.f;
    for (int c0 = 0; c0 < c; c0 += 8) { float Av[8], hv[8];
#pragma unroll
        for (int q = 0; q < 8; ++q) { const int cc = c0 + q < c ? c0 + q : c - 1; const size_t k = ((size_t)bd * NCH + cc) * 256 + ch; Av[q] = P.CRA[k]; hv[q] = P.CRH[k]; }
#pragma unroll
        for (int q = 0; q < 8; ++q) if (c0 + q < c) h = Av[q] * h + hv[q]; }
    for (int s0 = c * CL; s0 < (c + 1) * CL; s0 += SB) { float av[SB], uv[SB]; size_t ix[SB];
#pragma unroll
        for (int q = 0; q < SB; ++q) { ix[q] = ((size_t)dir * NR + scan_row(b, dir, s0 + q)) * 256 + ch; av[q] = 1.0f - bf2f(P.CA[ix[q]]); uv[q] = bf2f(P.CU[ix[q]]); }
#pragma unroll
        for (int q = 0; q < SB; ++q) { h = av[q] * h + uv[q]; P.CU[ix[q]] = f2bf(h); } }
}
HD void st_a_out(const Params& P, int l, i64 i) {
    const int c8 = (int)(i & 31) * 8; const size_t row = (size_t)(i >> 5);
    float h0[8], h1[8], ay[8], y[8]; ld8(P.CU + row * 256 + c8, h0); ld8(P.CU + ((size_t)NR + row) * 256 + c8, h1); ld8(P.Z + row * DIN + Z_AY + c8, ay);
#pragma unroll
    for (int q = 0; q < 8; ++q) y[q] = (h0[q] + h1[q]) * gelu_tanh_(ay[q]);
    st8(P.YM + row * D + c8, y);
}
HD void st_b_pre(const Params& P, int l, i64 i) {
    const int c8 = (int)(i & 31) * 8; const size_t row = (size_t)(i >> 5);
    float lb[8], q[8], z[8], o[8]; ld8f(P.LB + l * 256 + c8, lb); ld8(P.Z + row * DIN + Z_BQ + c8, q);
#pragma unroll
    for (int k = 0; k < 8; ++k) o[k] = siluf_(q[k]) * 0.125f;
    st8f(P.BQ + row * 256 + c8, o);
    for (int dir = 0; dir < 2; ++dir) { ld8(P.Z + row * DIN + Z_BFF + dir * 256 + c8, z);
#pragma unroll
        for (int k = 0; k < 8; ++k) o[k] = lb[k] + (1.0f - lb[k]) * sigmoidf_(z[k]);
        st8f(P.BF + ((size_t)dir * NR + row) * 256 + c8, o); }
}
HD void st_b_scan1(const Params& P, int l, i64 i) {
    const int v = (int)(i & 63); const i64 u = i >> 6; const int c = (int)(u % NCH), bdh = (int)(u / NCH), head = bdh & 3, dir = (bdh >> 2) & 1, b = bdh >> 3;
    float S[64];
#pragma unroll
    for (int k = 0; k < 64; ++k) S[k] = 0.f;
    float pr = 1.f;
    for (int s = c * CL; s < (c + 1) * CL; ++s) { const size_t row = (size_t)scan_row(b, dir, s);
        const float* f = P.BF + ((size_t)dir * NR + row) * 256 + head * 64; const float vv = bf2f(P.Z[row * DIN + Z_BI + head * 64 + v]);
        pr *= f[v];
#pragma unroll
        for (int k = 0; k < 64; ++k) S[k] = f[k] * (S[k] - vv) + vv; }
    float* sst = P.SST + (size_t)u * 4096;
#pragma unroll
    for (int k = 0; k < 64; ++k) sst[k * 64 + v] = S[k];
    P.PST[u * 64 + v] = pr;
}
template <int NCH_> HD void st_b_scan2(const Params& P, int l, i64 i) {
    constexpr int NCH = NCH_; static_assert(NCH_ % 8 == 0, "scan2 batches");
    const int kv = (int)(i & 4095), bdh = (int)(i >> 12), k = kv >> 6;
    float carry = 0.f;
    float locA[8], ppA[8], locB[8], ppB[8];
#define B2LD(LOC, PP, C0) do { _Pragma("unroll") for (int q = 0; q < 8; ++q) { const int cc = (C0) + q < NCH ? (C0) + q : NCH - 1; const size_t u = (size_t)bdh * NCH + cc; LOC[q] = P.SST[u * 4096 + kv]; PP[q] = P.PST[u * 64 + k]; } } while (0)
#define B2ST(LOC, PP, C0) do { _Pragma("unroll") for (int q = 0; q < 8; ++q) { const size_t u = (size_t)bdh * NCH + (C0) + q; P.SST[u * 4096 + kv] = carry; carry = PP[q] * carry + LOC[q]; } } while (0)
    B2LD(locA, ppA, 0);
    for (int c0 = 0; c0 < NCH; c0 += 16) {
        B2LD(locB, ppB, c0 + 8);
        B2ST(locA, ppA, c0);
        if (c0 + 8 < NCH) { B2LD(locA, ppA, c0 + 16); B2ST(locB, ppB, c0 + 8); }
    }
#undef B2LD
#undef B2ST
}
HD void st_b_scan3(const Params& P, int l, i64 i) {
    const int v = (int)(i & 63); const i64 u = i >> 6; const int c = (int)(u % NCH), bdh = (int)(u / NCH), head = bdh & 3, dir = (bdh >> 2) & 1, b = bdh >> 3;
    float S[64]; const float* sst = P.SST + (size_t)u * 4096;
#pragma unroll
    for (int k = 0; k < 64; ++k) S[k] = sst[k * 64 + v];
    for (int s = c * CL; s < (c + 1) * CL; ++s) { const size_t row = (size_t)scan_row(b, dir, s);
        const float* f = P.BF + ((size_t)dir * NR + row) * 256 + head * 64; const float* q = P.BQ + row * 256 + head * 64;
        const float vv = bf2f(P.Z[row * DIN + Z_BI + head * 64 + v]); float o = 0.f;
#pragma unroll
        for (int k = 0; k < 64; ++k) { S[k] = f[k] * (S[k] - vv) + vv; o += q[k] * S[k]; }
        P.HB[((size_t)dir * NR + row) * 256 + head * 64 + v] = f2bf(o); }
}
HD void st_b_out(const Params& P, int l, i64 i) {
    const int head = (int)(i & 3); const size_t row = (size_t)(i >> 2);
    const bf16_t* o0 = P.HB + row * 256 + head * 64; const bf16_t* o1 = P.HB + ((size_t)NR + row) * 256 + head * 64;
    float o[64]; float ss = 0.f;
#pragma unroll
    for (int g = 0; g < 8; ++g) { float a[8], b[8]; ld8(o0 + g * 8, a); ld8(o1 + g * 8, b);
#pragma unroll
        for (int q = 0; q < 8; ++q) { o[g * 8 + q] = a[q] + b[q]; ss += o[g * 8 + q] * o[g * 8 + q]; } }
    const float rstd = 1.0f / sqrtf(ss * (1.0f / 64.0f) + EPS);
#pragma unroll
    for (int g = 0; g < 8; ++g) { float w[8], gt[8], y[8]; ld8f(P.b_onorm_w + l * 64 + g * 8, w); ld8(P.Z + row * DIN + Z_BG + head * 64 + g * 8, gt);
#pragma unroll
        for (int q = 0; q < 8; ++q) y[q] = o[g * 8 + q] * rstd * w[q] * siluf_(gt[q]);
        st8(P.YM + row * D + 256 + head * 64 + g * 8, y); }
}
HD void st_qkv_prep_rh(const Params& P, int l, int row, int hs) {
    const bool lat = row < NLAT;
    int col; const float* nw = nullptr;
    if (hs < 4) col = Z_CQ + hs * 64; else if (hs < 6) col = Z_CK + (hs - 4) * 64;
    else if (hs < 10) { col = Z_DQ + (hs - 6) * 64; nw = P.d_qnorm_w + l * 64; } else { col = Z_DK + (hs - 10) * 64; nw = P.d_knorm_w + l * 64; }
    if (!lat && !nw && hs >= 4) return;
    bf16_t* p = P.Z + (size_t)row * DIN + col;
    float x[64];
#pragma unroll
    for (int g = 0; g < 8; ++g) { float t8[8]; ld8(p + g * 8, t8);
#pragma unroll
        for (int q = 0; q < 8; ++q) x[g * 8 + q] = t8[q]; }
    if (nw) { float ss = 0.f;
#pragma unroll
        for (int e = 0; e < 64; ++e) ss += x[e] * x[e];
        const float rstd = 1.0f / sqrtf(ss * (1.0f / 64.0f) + EPS);
#pragma unroll
        for (int e = 0; e < 64; ++e) x[e] = x[e] * rstd * nw[e]; }
    if (lat) { const int t = row % L, pr = t / 64, pc = t % 64;
#pragma unroll
        for (int f = 0; f < 16; ++f) {
            { const float c = P.ROPE[(pr * 16 + f) * 2], s = P.ROPE[(pr * 16 + f) * 2 + 1], x1 = x[f], x2 = x[16 + f]; x[f] = x1 * c - x2 * s; x[16 + f] = x2 * c + x1 * s; }
            { const float c = P.ROPE[(pc * 16 + f) * 2], s = P.ROPE[(pc * 16 + f) * 2 + 1], x1 = x[32 + f], x2 = x[48 + f]; x[32 + f] = x1 * c - x2 * s; x[48 + f] = x2 * c + x1 * s; } } }
    const float osc = (hs < 4 || (hs >= 6 && hs < 10)) ? QC2 : 1.0f;
#pragma unroll
    for (int g = 0; g < 8; ++g) { float t8[8];
#pragma unroll
        for (int q = 0; q < 8; ++q) t8[q] = x[g * 8 + q] * osc;
        st8(p + g * 8, t8); }
}
HD void st_qkv_prep(const Params& P, int l, i64 i) { st_qkv_prep_rh(P, l, (int)(i / 12), (int)(i % 12)); }
HD void st_qkv_prep_k(const Params& P, int l, i64 i) { const int kk = (int)(i & 3); st_qkv_prep_rh(P, l, (int)(i >> 2), kk < 2 ? 4 + kk : 8 + kk); }
template <bool LOG2> HD void attn_sweep(const float (&q)[64], const bf16_t* Z, size_t row0, int nkeys, int kcol, int vcol, float& m, float& lsum, float (&acc)[64]) {
    for (int j = 0; j < nkeys; ++j) {
        const U4* kp = (const U4*)(Z + (row0 + j) * DIN + kcol); const U4* vp = (const U4*)(Z + (row0 + j) * DIN + vcol);
        float s = 0.f;
#pragma unroll
        for (int e = 0; e < 8; ++e) { const U4 k4 = kp[e];
            s += q[8 * e] * bf_lo(k4.x) + q[8 * e + 1] * bf_hi(k4.x) + q[8 * e + 2] * bf_lo(k4.y) + q[8 * e + 3] * bf_hi(k4.y) + q[8 * e + 4] * bf_lo(k4.z) + q[8 * e + 5] * bf_hi(k4.z) + q[8 * e + 6] * bf_lo(k4.w) + q[8 * e + 7] * bf_hi(k4.w); }
        if (s > m) { const float sc = LOG2 ? exp2f(m - s) : expf(m - s); lsum *= sc;
#pragma unroll
            for (int e = 0; e < 64; ++e) acc[e] *= sc;
            m = s; }
        const float p = LOG2 ? exp2f(s - m) : expf(s - m); lsum += p;
#pragma unroll
        for (int e = 0; e < 8; ++e) { const U4 v4 = vp[e];
            acc[8 * e] += p * bf_lo(v4.x); acc[8 * e + 1] += p * bf_hi(v4.x); acc[8 * e + 2] += p * bf_lo(v4.y); acc[8 * e + 3] += p * bf_hi(v4.y);
            acc[8 * e + 4] += p * bf_lo(v4.z); acc[8 * e + 5] += p * bf_hi(v4.z); acc[8 * e + 6] += p * bf_lo(v4.w); acc[8 * e + 7] += p * bf_hi(v4.w); }
    }
}
template <int WHICH  >
HD void st_attn(const Params& P, int l, int head, int row) {
    const int kv = head >> 1;
    const int qcol = (WHICH == 0 ? Z_CQ : Z_DQ) + head * 64, kcol = (WHICH == 0 ? Z_CK : Z_DK) + kv * 64, vcol = (WHICH == 0 ? Z_CV : Z_DV) + kv * 64;
    float q[64], acc[64];
#pragma unroll
    for (int e = 0; e < 64; ++e) { q[e] = bf2f(P.Z[(size_t)row * DIN + qcol + e]); acc[e] = 0.f; }
    float m, lsum;
    if (WHICH == 0) { m = P.c_sink[l * 4 + head] * 1.4426950408889634f; lsum = 1.0f; } else { m = -INFINITY; lsum = 0.f; }
    const int seg = row_seg(row), b = seg & 1;
    attn_sweep<true>(q, P.Z, (size_t)seg_base(2 + b), LC, kcol, vcol, m, lsum, acc);
    if (row < NLAT) { const int t = row - b * L; int lo = 0, hi = L - 1;
        if (WHICH == 0) { lo = t - WINDOW < 0 ? 0 : t - WINDOW; hi = t + WINDOW > L - 1 ? L - 1 : t + WINDOW; }
        attn_sweep<true>(q, P.Z, (size_t)b * L + lo, hi - lo + 1, kcol, vcol, m, lsum, acc); }
    const float inv = 1.0f / lsum;
    bf16_t* o = P.YM + (size_t)row * D + (WHICH == 0 ? 512 : 768) + head * 64;
#pragma unroll
    for (int e = 0; e < 64; ++e) o[e] = f2bf(acc[e] * inv);
}
HD void st_outproj(const Params& P, int l, i64 i) {
    const int n = (int)(i & (D - 1)), row = (int)(i >> 10);
    const bf16_t* y = P.YM + (size_t)row * D; const bf16_t* w = P.WOUTT + (size_t)n * D;
    float s = 0.f; for (int k = 0; k < D; ++k) s += bf2f(y[k]) * bf2f(w[k]);
    xcur_row(P, row)[n] = xsrc_row(P, l, row)[n] + modv(P, l, row_who(row), 2)[n] * s;
}
HD void st_norm2(const Params& P, int l, i64 row_) {
    const int row = (int)row_; const float* x = xcur_row(P, row);
    float ss = 0.f; for (int d = 0; d < D; ++d) ss += x[d] * x[d];
    const float rstd = 1.0f / sqrtf(ss * (1.0f / D) + EPS);
    const int who = row_who(row);
    const float *sh = modv(P, l, who, 3), *sc = modv(P, l, who, 4), *w = P.norm2_w + l * D;
    bf16_t* h = P.H + (size_t)row * D;
    for (int d = 0; d < D; ++d) h[d] = f2bf(x[d] * rstd * w[d] * (1.0f + sc[d]) + sh[d]);
}
HD void st_cvt_rw(const Params& P, int l, i64 i) {
    const int kb = (int)(i & 127), n = (int)(i >> 7);
    bf16_t* dst = P.RWT + (size_t)n * D + kb * 8;
    for (int q = 0; q < 8; ++q) dst[q] = n < NE ? f2bf(P.router_w[((size_t)l * D + kb * 8 + q) * NE + n]) : (bf16_t)0;
}
HD void st_router(const Params& P, int l, i64 row_) {
    const int row = (int)row_; const bf16_t* h = P.H + (size_t)row * D;
    float lg[16];
#pragma unroll
    for (int e = 0; e < 16; ++e) { float a = 0.f; const bf16_t* w = P.RWT + (size_t)e * D; for (int d = 0; d < D; ++d) a += bf2f(h[d]) * bf2f(w[d]); lg[e] = a; }
    float mx = lg[0];
#pragma unroll
    for (int e = 1; e < 16; ++e) mx = fmaxf(mx, lg[e]);
    float sum = 0.f;
#pragma unroll
    for (int e = 0; e < 16; ++e) { lg[e] = expf(lg[e] - mx); sum += lg[e]; }
    const int seg = row_seg(row), t = row - seg_base(seg);
#pragma unroll
    for (int e = 0; e < 16; ++e) P.AFF[((size_t)seg * NE + e) * L + t] = lg[e] / sum;
}
HD unsigned f2key(float f) { union { unsigned u; float f; } c; c.f = f; return c.u; }
HD void st_topk(const Params& P, int l, i64 i) {
    const int e = (int)(i & 15), seg = (int)(i >> 4), N = seg_len(seg), cap = 2 * N / NE;
    const float* a = P.AFF + ((size_t)seg * NE + e) * L;
    unsigned lo = 0u, hi = 0x7f800001u;
    while (hi - lo > 1u) { const unsigned mid = lo + ((hi - lo) >> 1); int cnt = 0; for (int t = 0; t < N; ++t) cnt += f2key(a[t]) >= mid ? 1 : 0; if (cnt >= cap) lo = mid; else hi = mid; }
    int gt = 0; for (int t = 0; t < N; ++t) gt += f2key(a[t]) > lo ? 1 : 0;
    int ties = cap - gt, slot = (seg < 2 ? seg * CAP_L : 2 * CAP_L + (seg - 2) * CAP_C);
    const int base = seg_base(seg);
    for (int t = 0; t < N; ++t) { const unsigned k = f2key(a[t]); bool sel = k > lo; if (k == lo && ties > 0) { sel = true; --ties; }
        if (sel) { P.ROWLIST[e * SLOTS_PAD + slot] = base + t; P.GATE[e * SLOTS_PAD + slot] = a[t]; P.INV[(size_t)e * NR + base + t] = slot; ++slot; }
        else P.INV[(size_t)e * NR + base + t] = -1; }
}
HD void st_gather(const Params& P, int l, i64 i) {
    const int c = (int)(i & 127); const i64 es = i >> 7; const int ns = nslots(l), slot = (int)(es % ns), e = (int)(es / ns);
    const int row = P.ROWLIST[e * SLOTS_PAD + slot];
    const bf16_t* src = P.H + (size_t)row * D + c * 8; bf16_t* dst = P.XS + ((size_t)e * SLOTS_PAD + slot) * D + c * 8;
    *(U4*)dst = *(const U4*)src;
}
HD void st_moe1(const Params& P, int l, i64 i) {
    const int f = (int)(i & 1023); const i64 es = i >> 10; const int ns = nslots(l), slot = (int)(es % ns), e = (int)(es / ns);
    const bf16_t* h = P.H + (size_t)P.ROWLIST[e * SLOTS_PAD + slot] * D;
    const bf16_t* w1 = P.W13T + ((size_t)e * 2048 + (f >> 7) * 256 + (f & 127)) * D; const bf16_t* w3 = w1 + (size_t)128 * D;
    float a1 = 0.f, a3 = 0.f;
    for (int d = 0; d < D; ++d) { const float hv = bf2f(h[d]); a1 += hv * bf2f(w1[d]); a3 += hv * bf2f(w3[d]); }
    P.HID[((size_t)e * SLOTS_PAD + slot) * 1024 + f] = f2bf(siluf_(a1) * a3);
}
HD void st_moe2(const Params& P, int l, i64 i) {
    const int d = (int)(i & 1023); const i64 es = i >> 10; const int ns = nslots(l), slot = (int)(es % ns), e = (int)(es / ns);
    const bf16_t* hid = P.HID + ((size_t)e * SLOTS_PAD + slot) * 1024;
    const bf16_t* w2 = P.W2T + ((size_t)e * D + d) * 1024;
    float s = 0.f; for (int f = 0; f < 1024; ++f) s += bf2f(hid[f]) * bf2f(w2[f]);
    P.Y[((size_t)e * SLOTS_PAD + slot) * D + d] = f2bf(s);
}
HD void st_moe_comb(const Params& P, int l, i64 i) {
    const int d8 = (int)(i & 127) * 8, row = (int)(i >> 7);
    float acc[8];
#pragma unroll
    for (int q = 0; q < 8; ++q) acc[q] = 0.f;
    for (int e = 0; e < NE; ++e) { const int s = P.INV[(size_t)e * NR + row]; if (s >= 0) { const float g = P.GATE[e * SLOTS_PAD + s]; float y[8]; ld8(P.Y + ((size_t)e * SLOTS_PAD + s) * D + d8, y);
#pragma unroll
        for (int q = 0; q < 8; ++q) acc[q] += g * y[q]; } }
    float x[8], m[8]; float* xp = xcur_row(P, row) + d8; ld8f(xp, x); ld8f(modv(P, l, row_who(row), 5) + d8, m);
#pragma unroll
    for (int q = 0; q < 8; ++q) x[q] += m[q] * acc[q];
    st8f(xp, x);
}
HD void st_final(const Params& P, i64 row) {
    float* x = P.out + (size_t)row * D;
    float ss = 0.f; for (int d = 0; d < D; ++d) ss += x[d] * x[d];
    const float rstd = 1.0f / sqrtf(ss * (1.0f / D) + EPS);
    for (int d = 0; d < D; ++d) x[d] = x[d] * rstd * P.final_norm_w[d];
}

template <int LYR, class E> HD void layer_body(E& ex) {
    constexpr int l = LYR;
        const int nro = nrows_out(l);
        ex.run((i64)(D / 16) * (DIN / 4), [&](const Params& P, i64 i) { st_cvt_win(P, l, i); });
        ex.run((i64)(D / 16) * (D / 4), [&](const Params& P, i64 i) { st_cvt_wout(P, l, i); });
        ex.run((i64)1024 * 32, [&](const Params& P, i64 i) { st_cvt_wg(P, l, i); });
        ex.run((i64)256 * 128, [&](const Params& P, i64 i) { st_cvt_rw(P, l, i); });
        if (l == 0) ex.sync();
        ex.norm1(l); ex.sync();
        constexpr i64 n13 = (i64)NE * 2 * 16384, n2 = (i64)NE * 16384, NTC = n13 + n2, A1 = 162816, A2 = (l == 0) ? 380928 : 0;
        auto cvt_any = [&](const Params& P, i64 i) { if (i < n13) st_cvt_w13(P, l, i); else st_cvt_w2(P, l, i - n13); };
        ex.inproj(l); ex.run_from(150, A1, [&](const Params& P, i64 i) { cvt_any(P, i); }); ex.sync();
        ex.xa(l);
        ex.qkv_prep(l);
        ex.b_pre(l); ex.sync();
        ex.a_coef(l); ex.b_scan(l, 1); ex.sync();
        if (l == 0) ex.run_skipctx((i64)2 * 2 * NCH * 256, [&](const Params& P, i64 i) { st_a_scan1(P, l, i); });
        else ex.run((i64)2 * 2 * NCH * 256, [&](const Params& P, i64 i) { st_a_scan1(P, l, i); });
        ex.b_scan(l, 2);
        ex.attn_win(l); ex.attn_dense(l); ex.sync();
        ex.run((i64)2 * 2 * NCH * 256, [&](const Params& P, i64 i) { st_a_scan3(P, l, i); });
        ex.b_scan(l, 3); ex.sync();
        ex.run((i64)nro * 32, [&](const Params& P, i64 i) { st_a_out(P, l, i); });
        ex.b_out(l); ex.sync();
        ex.outproj(l); if (l == 0) ex.run_from(8, A2, [&](const Params& P, i64 i) { cvt_any(P, A1 + i); }); ex.sync();
        ex.norm2(l);
        ex.run((i64)NE * SLOTS_PAD, [&](const Params& P, i64 i) { P.ROWLIST[i] = 0; }); ex.sync();
        constexpr i64 AR = 129024;
        ex.router(l); ex.run_from(130, AR, [&](const Params& P, i64 i) { cvt_any(P, A1 + A2 + i); }); ex.sync();
        ex.topk(l);
        { constexpr i64 B0 = A1 + A2 + AR, rest = NTC - B0, cap = ((NTC * 21 / 100) & ~(i64)63), A3 = rest < cap ? rest : cap; const int b0 = (l == 0 ? 4 : 2) * 16;
          ex.run_from(b0, A3, [&](const Params& P, i64 i) { cvt_any(P, B0 + i); });
          ex.run(rest - A3, [&](const Params& P, i64 i) { cvt_any(P, B0 + A3 + i); }); }
        ex.sync();
        ex.moe1(l); ex.sync();
        ex.moe2(l); ex.sync();
        ex.comb(l); ex.sync_soft();
}
template <class E> HD void pipeline(E& ex) {
    {
    ex.mod();
    ex.run(256, [&](const Params& P, i64 i) { st_lb(P, i); });
    ex.run(2, [&](const Params& P, i64 i) { st_flags(P, i); });
    ex.run(2 * 2 * 256, [&](const Params& P, i64 i) { st_sp8(P, i); });
    ex.run(256 * 16, [&](const Params& P, i64 i) { st_rope(P, i); });
    }
    layer_body<0>(ex);
    layer_body<1>(ex);
    ex.final_norm();
}
template <class E> HD void naive_inproj(int l, E& ex) { ex.run((i64)NR * DIN, [&](const Params& P, i64 i) { st_inproj(P, l, i); }); }
template <class E> HD void naive_outproj(int l, E& ex) { ex.run((i64)nrows_out(l) * D, [&](const Params& P, i64 i) { st_outproj(P, l, i); }); }
template <class E> HD void naive_moe1(int l, E& ex) { ex.run((i64)NE * nslots(l) * 1024, [&](const Params& P, i64 i) { st_moe1(P, l, i); }); }
template <class E> HD void naive_attn_win(int l, E& ex, int row0, int nrows) { ex.run((i64)4 * nrows, [&](const Params& P, i64 i) { st_attn<0>(P, l, (int)(i / nrows), row0 + (int)(i % nrows)); }); }
template <class E> HD void naive_attn_dense(int l, E& ex, int row0, int nrows) { ex.run((i64)4 * nrows, [&](const Params& P, i64 i) { st_attn<1>(P, l, (int)(i / nrows), row0 + (int)(i % nrows)); }); }
template <class E> HD void naive_qkv_prep(int l, E& ex) { ex.run((i64)NR * 12, [&](const Params& P, i64 i) { st_qkv_prep(P, l, i); }); }
template <class E> HD void naive_b_out(int l, E& ex) { ex.run((i64)nrows_out(l) * 4, [&](const Params& P, i64 i) { st_b_out(P, l, i); }); }
template <class E> HD void naive_xa(int l, E& ex) { ex.run((i64)NR * 32, [&](const Params& P, i64 i) { st_xa(P, l, i); }); }
template <class E> HD void naive_b_pre(int l, E& ex) { ex.run((i64)NR * 32, [&](const Params& P, i64 i) { st_b_pre(P, l, i); }); }
template <class E> HD void naive_b_scan(int l, int ph, E& ex) { if (ph == 2) ex.run((i64)2 * 2 * 4 * 4096, [&](const Params& P, i64 i) { st_b_scan2<NCH>(P, l, i); }); else if (ph == 1) ex.run((i64)2 * 2 * 4 * NCH * 64, [&](const Params& P, i64 i) { st_b_scan1(P, l, i); }); else ex.run((i64)2 * 2 * 4 * NCH * 64, [&](const Params& P, i64 i) { st_b_scan3(P, l, i); }); }
template <class E> HD void naive_a_coef(int l, E& ex) { ex.run((i64)2 * NR * 256, [&](const Params& P, i64 i) { st_a_coef(P, l, i); }); }
template <class E> HD void naive_comb(int l, E& ex) { ex.run((i64)nrows_out(l) * 128, [&](const Params& P, i64 i) { st_moe_comb(P, l, i); }); }
template <class E> HD void naive_mod(E& ex) { ex.run((i64)2 * 3 * 6 * D, [&](const Params& P, i64 i) { st_mod(P, i); }); }
template <class E> HD void naive_norm1(int l, E& ex) { ex.run(NR, [&](const Params& P, i64 i) { st_norm1(P, l, i); }); }
template <class E> HD void naive_norm2(int l, E& ex) { ex.run(nrows_out(l), [&](const Params& P, i64 i) { st_norm2(P, l, i); }); }
template <class E> HD void naive_router(int l, E& ex) { ex.run(nrows_out(l), [&](const Params& P, i64 i) { st_router(P, l, i); }); }
template <class E> HD void naive_topk(int l, E& ex) { ex.run((l == 0 ? 4 : 2) * 16, [&](const Params& P, i64 i) { st_topk(P, l, i); }); }
template <class E> HD void naive_final(E& ex) { ex.run(NLAT, [&](const Params& P, i64 i) { st_final(P, i); }); }
template <class E> HD void naive_moe2(int l, E& ex) { ex.run((i64)NE * nslots(l) * 1024, [&](const Params& P, i64 i) { st_moe2(P, l, i); }); }

#ifndef CPU_TEST
__device__ __forceinline__ int lane_id() { int l; asm volatile("v_mbcnt_lo_u32_b32 %0, -1, 0\n\tv_mbcnt_hi_u32_b32 %0, -1, %0" : "=v"(l)); return l; }
__device__ __forceinline__ int grid_dim() { int g = (int)gridDim.x; asm volatile("" : "+s"(g)); return g; }
__device__ __forceinline__ int block_id() { int b = (int)blockIdx.x; asm volatile("" : "+s"(b)); return b; }
#define XB_TMO      128
#define XB_XCNT(j)  (256  + 64 * (j))
#define XB_XSUB(j)  (1280 + 64 * (j))
#define XB_XGEN(j)  (2304 + 64 * (j))
#define XB_TOP      3328
#define XB_TOPGEN   3392
#define XCD_BAR_WORDS 3456
#define XB_SPIN_CAP (1u << 27)
#define LAS __attribute__((address_space(3)))

__device__ __forceinline__ unsigned xb_ld(unsigned* p)              { return __hip_atomic_load(p, __ATOMIC_RELAXED, __HIP_MEMORY_SCOPE_AGENT); }
__device__ __forceinline__ unsigned xb_add(unsigned* p, unsigned v) { return __hip_atomic_fetch_add(p, v, __ATOMIC_RELAXED, __HIP_MEMORY_SCOPE_AGENT); }
__device__ __forceinline__ unsigned xb_xcc_id() { return (unsigned)__builtin_amdgcn_s_getreg((3 << 11) | 20) & 0xFu; }
#define XB_SPIN(cond, bar) do { unsigned _sp = 0; while (cond) { __builtin_amdgcn_s_sleep(1); \
    if ((++_sp & 255u) == 0u) { if (xb_ld(&(bar)[XB_TMO])) break; if (_sp > XB_SPIN_CAP) { atomicAdd(&(bar)[XB_TMO], 1u); break; } } } } while (0)

struct XcdBarrier { unsigned* bar; unsigned x; volatile LAS unsigned* st; };

__device__ __forceinline__ XcdBarrier xcd_barrier_post(unsigned* bar, volatile LAS unsigned* st, bool leader) {
    XcdBarrier b; b.bar = bar; b.x = xb_xcc_id(); b.st = st;
    if (leader) (void)xb_add(&bar[XB_XCNT(b.x)], 1u);
    return b;
}
__device__ __forceinline__ void xcd_barrier_complete(unsigned* bar, unsigned x, unsigned& nloc, unsigned& nx) {
    const unsigned G = gridDim.x * gridDim.y * gridDim.z;
    unsigned sum, cnt, mine, sp = 0u;
    for (;;) {
        sum = 0u; cnt = 0u; mine = 0u;
#pragma unroll
        for (unsigned j = 0; j < 16; ++j) { const unsigned c = xb_ld(&bar[XB_XCNT(j)]); sum += c; cnt += (c > 0u) ? 1u : 0u; mine = (j == x) ? c : mine; }
        if (sum == G) break;
        __builtin_amdgcn_s_sleep(1);
        if ((++sp & 255u) == 0u) { if (xb_ld(&bar[XB_TMO])) break; if (sp > XB_SPIN_CAP) { atomicAdd(&bar[XB_TMO], 1u); break; } }
    }
    nloc = mine > 0u ? mine : 1u; nx = cnt > 0u ? cnt : 1u;
}
__device__ __forceinline__ void xcd_barrier(const XcdBarrier& b, bool leader) {
    asm volatile("s_waitcnt vmcnt(0)" ::: "memory");
    __syncthreads();
    if (leader) {
        unsigned* bar = b.bar;
        __builtin_amdgcn_s_waitcnt(0);
        unsigned nloc = b.st[0], nx = b.st[1];
        if (nloc == 0u) { xcd_barrier_complete(bar, b.x, nloc, nx); b.st[0] = nloc; b.st[1] = nx; }
        const unsigned old = xb_add(&bar[XB_XSUB(b.x)], 1u);
        const unsigned gen = old / nloc;
        if (old + 1u == (gen + 1u) * nloc) {
            __builtin_amdgcn_fence(__ATOMIC_RELEASE, "agent");
            asm volatile("s_waitcnt vmcnt(0)" ::: "memory");
            const unsigned og = xb_add(&bar[XB_TOP], 1u);
            const unsigned tg = og / nx;
            if (og + 1u == (tg + 1u) * nx) xb_add(&bar[XB_TOPGEN], 1u);
            else XB_SPIN(xb_ld(&bar[XB_TOPGEN]) == tg, bar);
            __builtin_amdgcn_fence(__ATOMIC_ACQUIRE, "agent");
            xb_add(&bar[XB_XGEN(b.x)], 1u);
            asm volatile("s_waitcnt vmcnt(0)" ::: "memory");
        } else {
            XB_SPIN(xb_ld(&bar[XB_XGEN(b.x)]) == gen, bar);
            __builtin_amdgcn_fence(__ATOMIC_ACQUIRE, "agent");
            asm volatile("s_waitcnt vmcnt(0)" ::: "memory");
        }
    }
    __syncthreads();
}

namespace pg8 {
#define PG8_LAS __attribute__((address_space(3)))
typedef unsigned short bf16_t;
typedef short bf16x8 __attribute__((ext_vector_type(8)));
typedef float f32x4 __attribute__((ext_vector_type(4)));
typedef unsigned u32x4 __attribute__((ext_vector_type(4)));
constexpr int BM = 256, BK = 64, HALF = 128, HTB = HALF * BK * 2  , STAGE_BYTES = 8 * HTB, NXCD = 8, WGM = 8;

__host__ __device__ __forceinline__ int lds_byte(int r, int c) { const int st = (r >> 4) * 2 + (c >> 5), rr = r & 15, cc = c & 31, ob = rr * 64 + cc * 2; return st * 1024 + (ob ^ (((ob >> 9) & 1) << 5)); }
__host__ __device__ __forceinline__ void stage_rc(int b, int& R, int& C) { const int st = b / 1024, sb = b % 1024, swz = sb ^ (((sb >> 9) & 1) << 5); R = (st >> 1) * 16 + swz / 64; C = (st & 1) * 32 + (swz % 64) / 2; }
__host__ __device__ __forceinline__ int perm32(int rho) { const int n = rho >> 4, i = rho & 15; return 8 * (i >> 2) + 4 * n + (i & 3); }

struct Unit { int pm, pn; };
struct Gemm { const bf16_t* A; const bf16_t* Bt; int M, N, K; };

struct StaticOrder {
    int nM, nN, nwg, G, c;
    __host__ __device__ void init(int M, int N, int G_, int c_) { nM = M / BM; nN = N / BM; nwg = nM * nN; G = G_; c = c_; }
    __host__ __device__ bool next(int i, Unit& u) const {
        const long L = (long)i * G + c; if (L >= nwg) return false;
        int wgid = (int)L; { const int q = nwg / NXCD, r = nwg % NXCD, xcd = wgid % NXCD, off = wgid / NXCD; wgid = (xcd < r ? xcd * (q + 1) : r * (q + 1) + (xcd - r) * q) + off; }
        const int nig = WGM * nN, gid = wgid / nig, fm = gid * WGM, gsz = (nM - fm) < WGM ? (nM - fm) : WGM;
        u.pm = fm + ((wgid % nig) % gsz); u.pn = (wgid % nig) / gsz; return true;
    }
    __device__ __forceinline__ void a_ready(const Unit&) const {}
    __device__ __forceinline__ void done(const Unit&) const {}
};
__device__ __forceinline__ unsigned cvt_pk_bf16(float lo, float hi) { unsigned r; asm volatile("v_cvt_pk_bf16_f32 %0, %1, %2" : "=v"(r) : "v"(lo), "v"(hi)); return r; }
typedef float f32x2 __attribute__((ext_vector_type(2)));
template <class Epi, class Sched, bool STAMP = false, bool GATHER = false, bool HALFU = false>
__device__ __forceinline__ void gemm_phase(PG8_LAS unsigned char* lds, const Gemm g, const Sched& S, const Epi& E, unsigned long long* stamps, int wv, const int* rowlist = nullptr) {
    int tid_ = wv * 64 + lane_id(); asm volatile("" : "+v"(tid_));
    const int tid = tid_, wid = __builtin_amdgcn_readfirstlane(tid >> 6), lane = tid & 63, wr = wid >> 2, wc = wid & 3, fr = lane & 15, fq = lane >> 4;
    const int K = g.K, nt = K / BK;
    int ts_lo = 0, ts_hi = 0, nts = 0; const unsigned long long rt_entry = STAMP ? (unsigned long long)wall_clock64() : 0ull;
#define PG8_STAMP() do { if (STAMP && wid == 0 && nts < 64) { const unsigned long long _c = (unsigned long long)clock64(); \
        ts_lo = (lane == nts) ? (int)(unsigned)_c : ts_lo; ts_hi = (lane == nts) ? (int)(unsigned)(_c >> 32) : ts_hi; ++nts; } } while (0)
    PG8_STAMP();
    unsigned voffA[2], voffB[2]; int RA[2]; unsigned CBy[2];
#pragma unroll
    for (int i = 0; i < 2; ++i) { int R, C; stage_rc(tid * 16 + i * 8192, R, C); const int Rb = Epi::PERM ? ((R & ~31) + perm32(R & 31)) : R;
        voffA[i] = (unsigned)(R * K + C) * 2u; voffB[i] = (unsigned)(Rb * K + C) * 2u; RA[i] = R; CBy[i] = (unsigned)C * 2u; }
    unsigned goff[2][2] = {{0u, 0u}, {0u, 0u}}, noff[2][2] = {{0u, 0u}, {0u, 0u}};
#define PG8_LOADOFF(dst, U) do { if (GATHER) { _Pragma("unroll") for (int h_ = 0; h_ < 2; ++h_) _Pragma("unroll") for (int i_ = 0; i_ < 2; ++i_) \
        dst[h_][i_] = (unsigned)rowlist[(U).pm * BM + h_ * HALF + RA[i_]] * (unsigned)(K * 2) + CBy[i_]; } } while (0)
#define PG8_STAGE_A(bufoff, base, h, nx) do { if (GATHER) { const unsigned so_[2] = {(nx) ? noff[h][0] : goff[h][0], (nx) ? noff[h][1] : goff[h][1]}; PG8_STAGE(bufoff, base, so_); } \
        else PG8_STAGE(bufoff, (base) + ((h) ? hstep : 0), voffA); } while (0)
    const size_t kstep = (size_t)(BK * 2);
    const size_t hstep = (size_t)HALF * K * 2;
    const size_t tstep = 2 * hstep;
    const unsigned ldsw = (unsigned)wid * 1024u;
    const int aoff = lds_byte(wr * 64 + fr, fq * 8), boff = lds_byte(wc * 32 + fr, fq * 8);
#define PG8_SA(b, h) (((b) * 2 + (h)) * HTB)
#define PG8_SB(b, h) ((4 + (b) * 2 + (h)) * HTB)
#define PG8_STAGE(bufoff, gbase, voff) do { _Pragma("unroll") for (int _i = 0; _i < 2; ++_i) \
        __builtin_amdgcn_global_load_lds((const unsigned*)((const char*)(gbase) + (voff)[_i]), (PG8_LAS unsigned*)(lds + (bufoff) + ldsw + _i * 8192), 16, 0, 0); } while (0)
#define PG8_LDA(dst, b, h) do { _Pragma("unroll") for (int m = 0; m < 4; ++m) _Pragma("unroll") for (int k = 0; k < 2; ++k) dst[m][k] = *(const PG8_LAS bf16x8*)(lds + PG8_SA(b, h) + aoff + m * 2048 + k * 1024); } while (0)
#define PG8_LDB(dst, b, h) do { _Pragma("unroll") for (int n = 0; n < 2; ++n) _Pragma("unroll") for (int k = 0; k < 2; ++k) dst[n][k] = *(const PG8_LAS bf16x8*)(lds + PG8_SB(b, h) + boff + n * 2048 + k * 1024); } while (0)
#define PG8_MMA(ai, bj, At, Bt) do { __builtin_amdgcn_s_setprio(1); _Pragma("unroll") for (int m = 0; m < 4; ++m) _Pragma("unroll") for (int n = 0; n < 2; ++n) _Pragma("unroll") for (int k = 0; k < 2; ++k) \
        acc[ai][bj][m][n] = __builtin_amdgcn_mfma_f32_16x16x32_bf16(Bt[n][k], At[m][k], acc[ai][bj][m][n], 0, 0, 0); __builtin_amdgcn_s_setprio(0); } while (0)
#define PG8_WAIT_V(n) asm volatile("s_waitcnt vmcnt(" #n ")" ::: "memory")
#define PG8_WAIT_L(n) asm volatile("s_waitcnt lgkmcnt(" #n ")" ::: "memory")
#define PG8_BAR __builtin_amdgcn_s_barrier()
#define PG8_SCHED __builtin_amdgcn_sched_barrier(0)
    Unit cur, nxt; int ui = 0;
    if (!S.next(0, cur)) return;
    f32x4 acc[2][2][4][2];
#pragma unroll
    for (int a = 0; a < 2; ++a)
#pragma unroll
        for (int b = 0; b < 2; ++b)
#pragma unroll
            for (int m = 0; m < 4; ++m)
#pragma unroll
                for (int n = 0; n < 2; ++n) acc[a][b][m][n] = (f32x4){0.f, 0.f, 0.f, 0.f};
    bf16x8 At[4][2], B0[2][2], B1[2][2];
    const char* cA = (const char*)g.A + (GATHER ? (size_t)0 : (size_t)cur.pm * tstep); const char* cB = (const char*)g.Bt + (size_t)cur.pn * tstep;
    PG8_LOADOFF(goff, cur);
    S.a_ready(cur);
    PG8_STAGE(PG8_SB(0, 0), cB, voffB); PG8_STAGE_A(PG8_SA(0, 0), cA, 0, false); PG8_STAGE(PG8_SB(0, 1), cB + hstep, voffB); PG8_STAGE_A(PG8_SA(0, 1), cA, 1, false);
    if (wr == 1) PG8_BAR;
    PG8_WAIT_V(4); PG8_BAR;
    PG8_STAGE(PG8_SB(1, 0), cB + kstep, voffB); PG8_STAGE_A(PG8_SA(1, 0), cA + kstep, 0, false); PG8_STAGE(PG8_SB(1, 1), cB + hstep + kstep, voffB);
    PG8_WAIT_V(6); PG8_BAR;
    PG8_STAMP();
    for (;;) {
        const bool has_next = S.next(ui + 1, nxt);
        bool hu = false; if constexpr (HALFU) hu = S.is_half(cur);
        const char* nA = (has_next && !GATHER) ? (const char*)g.A + (size_t)nxt.pm * tstep : cA; const char* nB = has_next ? (const char*)g.Bt + (size_t)nxt.pn * tstep : cB;
        if (GATHER) { if (has_next) PG8_LOADOFF(noff, nxt); else { noff[0][0] = goff[0][0]; noff[0][1] = goff[0][1]; noff[1][0] = goff[1][0]; noff[1][1] = goff[1][1]; } }
        for (int t = 0; t < nt; t += 2) {
            const bool last = (t == nt - 2);
            const char* a1 = cA + (size_t)(t + 1) * kstep;
            const char* a2 = last ? nA : cA + (size_t)(t + 2) * kstep; const char* b2 = last ? nB : cB + (size_t)(t + 2) * kstep;
            const char* a3 = a2 + kstep; const char* b3 = b2 + kstep;
            if (last && has_next) S.a_ready(nxt);
            PG8_LDB(B0, 0, 0); PG8_SCHED; PG8_LDA(At, 0, 0); PG8_STAGE_A(PG8_SA(1, 1), a1, 1, false);
            PG8_WAIT_L(8); PG8_BAR; PG8_WAIT_L(0); PG8_MMA(0, 0, At, B0); PG8_BAR; PG8_SCHED;
            PG8_LDB(B1, 0, 1); PG8_STAGE(PG8_SB(0, 0), b2, voffB);
            PG8_BAR; PG8_WAIT_L(0); PG8_MMA(0, 1, At, B1); PG8_BAR;
            if (!hu) PG8_LDA(At, 0, 1); PG8_STAGE_A(PG8_SA(0, 0), a2, 0, last);
            PG8_BAR; PG8_WAIT_L(0); if (!hu) PG8_MMA(1, 0, At, B0); PG8_BAR; PG8_SCHED;
            PG8_STAGE(PG8_SB(0, 1), b2 + hstep, voffB);
            PG8_WAIT_V(6); PG8_BAR; if (!hu) PG8_MMA(1, 1, At, B1); PG8_BAR;
            PG8_LDB(B0, 1, 0); PG8_SCHED; PG8_LDA(At, 1, 0); PG8_STAGE_A(PG8_SA(0, 1), a2, 1, last);
            PG8_WAIT_L(8); PG8_BAR; PG8_WAIT_L(0); PG8_MMA(0, 0, At, B0); PG8_BAR; PG8_SCHED;
            PG8_LDB(B1, 1, 1); PG8_STAGE(PG8_SB(1, 0), b3, voffB);
            PG8_BAR; PG8_WAIT_L(0); PG8_MMA(0, 1, At, B1); PG8_BAR;
            if (!hu) PG8_LDA(At, 1, 1); PG8_STAGE_A(PG8_SA(1, 0), a3, 0, last);
            PG8_BAR; PG8_WAIT_L(0); if (!hu) PG8_MMA(1, 0, At, B0); PG8_BAR; PG8_SCHED;
            PG8_STAGE(PG8_SB(1, 1), b3 + hstep, voffB);
            PG8_WAIT_V(6); PG8_BAR; if (!hu) PG8_MMA(1, 1, At, B1); PG8_BAR;
        }
        PG8_STAMP();
        if constexpr (!Epi::AFTER_DRAIN) { E(acc, cur, wr, wc, fr, fq); S.done(cur); }
        PG8_STAMP();
        if (!has_next) break;
#pragma unroll
        for (int a = 0; a < 2; ++a)
#pragma unroll
            for (int b = 0; b < 2; ++b)
#pragma unroll
                for (int m = 0; m < 4; ++m)
#pragma unroll
                    for (int n = 0; n < 2; ++n) acc[a][b][m][n] = (f32x4){0.f, 0.f, 0.f, 0.f};
        cur = nxt; cA = nA; cB = nB; ++ui;
        if (GATHER) { goff[0][0] = noff[0][0]; goff[0][1] = noff[0][1]; goff[1][0] = noff[1][0]; goff[1][1] = noff[1][1]; }
    }
    PG8_WAIT_V(0);
    if (wr == 0) PG8_BAR;
    PG8_BAR;
    if constexpr (Epi::AFTER_DRAIN) { E.fused(acc, cur, wr, wc, fr, fq, lds, wid, lane); S.done(cur); }
    PG8_STAMP();
    if (STAMP && wid == 0) { stamps[lane] = lane < nts ? (((unsigned long long)(unsigned)ts_hi << 32) | (unsigned)ts_lo) : 0ull;
        if (lane == 62) stamps[62] = rt_entry; if (lane == 63) stamps[63] = (unsigned long long)wall_clock64(); }
#undef PG8_STAMP
#undef PG8_SA
#undef PG8_SB
#undef PG8_STAGE
#undef PG8_STAGE_A
#undef PG8_LOADOFF
#undef PG8_LDA
#undef PG8_LDB
#undef PG8_MMA
#undef PG8_WAIT_V
#undef PG8_WAIT_L
#undef PG8_BAR
#undef PG8_SCHED
}
}

namespace pg8 {
constexpr int TPE = SLOTS_PAD / 256;
struct EpiZ {
    static constexpr bool PERM = true, AFTER_DRAIN = false;
    bf16_t* O; int ldc;
    __device__ __forceinline__ void operator()(const f32x4 (&acc)[2][2][4][2], const Unit& u, int wr, int wc, int fr, int fq) const {
        const int row0 = u.pm * BM + wr * 64 + fr, col0 = u.pn * BM + wc * 32 + 8 * fq;
#pragma unroll
        for (int ai = 0; ai < 2; ++ai)
#pragma unroll
            for (int m = 0; m < 4; ++m) { bf16_t* rowp = O + (size_t)(row0 + ai * HALF + m * 16) * ldc + col0;
#pragma unroll
                for (int bj = 0; bj < 2; ++bj) { const f32x4 v0 = acc[ai][bj][m][0], v1 = acc[ai][bj][m][1];
                    u32x4 w; w.x = cvt_pk_bf16(v0[0], v0[1]); w.y = cvt_pk_bf16(v0[2], v0[3]); w.z = cvt_pk_bf16(v1[0], v1[1]); w.w = cvt_pk_bf16(v1[2], v1[3]);
                    *(u32x4*)(rowp + bj * HALF) = w; } }
    }
};
template <bool SRC16> struct EpiOut {
    static constexpr bool PERM = true, AFTER_DRAIN = false;
    const float* src_lat; const float* src_ctx; const bf16_t* srcb; bf16_t* dst; const float* mod;
    __device__ __forceinline__ void operator()(const f32x4 (&acc)[2][2][4][2], const Unit& u, int wr, int wc, int fr, int fq) const {
        const bool lat = u.pm < NLAT / BM; const int who = lat ? u.pm / (L / BM) : 2;
        const int row0 = u.pm * BM + wr * 64 + fr, col0 = u.pn * BM + wc * 32 + 8 * fq;
        const float* mv = mod + (size_t)(who * 6 + 2) * D;
        f32x4 m4[2][2];
#pragma unroll
        for (int bj = 0; bj < 2; ++bj)
#pragma unroll
            for (int n = 0; n < 2; ++n) m4[bj][n] = *(const f32x4*)(mv + col0 + bj * HALF + n * 4);
#pragma unroll
        for (int ai = 0; ai < 2; ++ai)
#pragma unroll
            for (int m = 0; m < 4; ++m) { const size_t grow = (size_t)(row0 + ai * HALF + m * 16);
#pragma unroll
                for (int bj = 0; bj < 2; ++bj) { const int c = col0 + bj * HALF; f32x4 x0, x1;
                    if (SRC16) { const u32x4 w = *(const u32x4*)(srcb + grow * D + c); x0 = (f32x4){bf_lo(w.x), bf_hi(w.x), bf_lo(w.y), bf_hi(w.y)}; x1 = (f32x4){bf_lo(w.z), bf_hi(w.z), bf_lo(w.w), bf_hi(w.w)}; }
                    else { const float* sp = (lat ? src_lat + grow * D : src_ctx + (grow - NLAT) * D) + c; x0 = __builtin_nontemporal_load((const f32x4*)sp); x1 = __builtin_nontemporal_load((const f32x4*)(sp + 4)); }
                    const f32x4 y0 = x0 + m4[bj][0] * acc[ai][bj][m][0], y1 = x1 + m4[bj][1] * acc[ai][bj][m][1];
                    u32x4 o; o.x = cvt_pk_bf16(y0[0], y0[1]); o.y = cvt_pk_bf16(y0[2], y0[3]); o.z = cvt_pk_bf16(y1[0], y1[1]); o.w = cvt_pk_bf16(y1[2], y1[3]);
                    *(u32x4*)(dst + grow * D + c) = o; } }
    }
};
__device__ __forceinline__ float silu_fast(float x) { return x * __builtin_amdgcn_rcpf(1.0f + __expf(-x)); }
struct EpiHid {
    static constexpr bool PERM = true, AFTER_DRAIN = false;
    bf16_t* O;
    __device__ __forceinline__ void operator()(const f32x4 (&acc)[2][2][4][2], const Unit& u, int wr, int wc, int fr, int fq) const {
        const int row0 = u.pm * BM + wr * 64 + fr, col0 = (u.pn & 7) * 128 + wc * 32 + 8 * fq;
#pragma unroll
        for (int ai = 0; ai < 2; ++ai)
#pragma unroll
            for (int m = 0; m < 4; ++m) { float h[8];
#pragma unroll
                for (int n = 0; n < 2; ++n)
#pragma unroll
                    for (int j = 0; j < 4; ++j) h[n * 4 + j] = silu_fast(acc[ai][0][m][n][j]) * acc[ai][1][m][n][j];
                u32x4 w; w.x = cvt_pk_bf16(h[0], h[1]); w.y = cvt_pk_bf16(h[2], h[3]); w.z = cvt_pk_bf16(h[4], h[5]); w.w = cvt_pk_bf16(h[6], h[7]);
                *(u32x4*)(O + (size_t)(row0 + ai * HALF + m * 16) * 1024 + col0) = w; }
    }
};
struct EpiY {
    static constexpr bool PERM = true, AFTER_DRAIN = false;
    bf16_t* O;
    __device__ __forceinline__ void operator()(const f32x4 (&acc)[2][2][4][2], const Unit& u, int wr, int wc, int fr, int fq) const {
        const int row0 = u.pm * BM + wr * 64 + fr, col0 = (u.pn & 3) * BM + wc * 32 + 8 * fq;
#pragma unroll
        for (int ai = 0; ai < 2; ++ai)
#pragma unroll
            for (int m = 0; m < 4; ++m) { bf16_t* rowp = O + (size_t)(row0 + ai * HALF + m * 16) * D + col0;
#pragma unroll
                for (int bj = 0; bj < 2; ++bj) { const f32x4 v0 = acc[ai][bj][m][0], v1 = acc[ai][bj][m][1];
                    u32x4 w; w.x = cvt_pk_bf16(v0[0], v0[1]); w.y = cvt_pk_bf16(v0[2], v0[3]); w.z = cvt_pk_bf16(v1[0], v1[1]); w.w = cvt_pk_bf16(v1[2], v1[3]);
                    *(u32x4*)(rowp + bj * HALF) = w; } }
    }
};
struct EpiCoef {
    static constexpr bool PERM = true, AFTER_DRAIN = false;
    const Params* P; int l;
    __device__ __forceinline__ void operator()(const f32x4 (&acc)[2][2][4][2], const Unit& u, int wr, int wc, int fr_, int fq_) const {
        int fr = fr_, fq = fq_; asm volatile("" : "+v"(fr), "+v"(fq));
        const int dir = u.pn >> 1, ch0 = (u.pn & 1) * 128 + wc * 32 + 8 * fq, row0 = u.pm * BM + wr * 64 + fr;
        const float* gb = P->a_gate_a_b + (l * 2 + dir) * 256 + ch0; const float* gx = P->a_gate_x_b + (l * 2 + dir) * 256 + ch0; const float* gs = P->SP8 + (l * 2 + dir) * 256 + ch0;
        bool small = true;
#pragma unroll
        for (int q = 0; q < 8; ++q) small = small && (gs[q] >= -0.5f);
        const bool poly = __all(small);
#pragma unroll
        for (int ai = 0; ai < 2; ++ai)
#pragma unroll
            for (int m = 0; m < 4; ++m) { const size_t row = (size_t)(row0 + ai * HALF + m * 16);
                const u32x4 xw = *(const u32x4*)(P->XAB + row * 256 + ch0); const unsigned xr[4] = {xw.x, xw.y, xw.z, xw.w};
                float om8[8], u8[8];
#pragma unroll
                for (int n = 0; n < 2; ++n)
#pragma unroll
                    for (int j = 0; j < 4; ++j) { const int q = n * 4 + j; const float xa = (q & 1) ? bf_hi(xr[q >> 1]) : bf_lo(xr[q >> 1]);
                        const float r = __builtin_amdgcn_rcpf(1.0f + __expf(-(acc[ai][0][m][n][j] + gb[q]))), ig = __builtin_amdgcn_rcpf(1.0f + __expf(-(acc[ai][1][m][n][j] + gx[q])));
                        const float y = r * gs[q];
                        float oma = -y * (1.0f + y * (0.5f + y * (0.16666667f + y * (0.041666667f + y * 0.0083333333f))));
                        if (!poly) oma = y > -0.5f ? oma : 1.0f - __expf(y);
                        om8[q] = oma; u8[q] = sqrtf(oma * (2.0f - oma)) * (ig * xa); }
                u32x4 wa, wu; wa.x = cvt_pk_bf16(om8[0], om8[1]); wa.y = cvt_pk_bf16(om8[2], om8[3]); wa.z = cvt_pk_bf16(om8[4], om8[5]); wa.w = cvt_pk_bf16(om8[6], om8[7]);
                wu.x = cvt_pk_bf16(u8[0], u8[1]); wu.y = cvt_pk_bf16(u8[2], u8[3]); wu.z = cvt_pk_bf16(u8[4], u8[5]); wu.w = cvt_pk_bf16(u8[6], u8[7]);
                *(u32x4*)(P->CA + ((size_t)dir * NR + row) * 256 + ch0) = wa; *(u32x4*)(P->CU + ((size_t)dir * NR + row) * 256 + ch0) = wu; }
    }
};
struct EpiRouter {
    static constexpr bool PERM = false, AFTER_DRAIN = false;
    float* AFF;
    __device__ __forceinline__ void operator()(const f32x4 (&acc)[2][2][4][2], const Unit& u, int wr, int wc, int fr_, int fq_) const {
        if (wc != 0) return;
        int fr = fr_, fq = fq_; asm volatile("" : "+v"(fr), "+v"(fq));
        const int lane = fq * 16 + fr;
#pragma unroll
        for (int ai = 0; ai < 2; ++ai)
#pragma unroll
            for (int m = 0; m < 4; ++m) { const f32x4 v = acc[ai][0][m][0];
                float mx = fmaxf(fmaxf(v[0], v[1]), fmaxf(v[2], v[3]));
                mx = fmaxf(mx, __int_as_float(__builtin_amdgcn_ds_bpermute((lane ^ 16) << 2, __float_as_int(mx)))); mx = fmaxf(mx, __int_as_float(__builtin_amdgcn_ds_bpermute((lane ^ 32) << 2, __float_as_int(mx))));
                const float e0 = __expf(v[0] - mx), e1 = __expf(v[1] - mx), e2 = __expf(v[2] - mx), e3 = __expf(v[3] - mx);
                float sm = (e0 + e1) + (e2 + e3);
                sm += __int_as_float(__builtin_amdgcn_ds_bpermute((lane ^ 16) << 2, __float_as_int(sm))); sm += __int_as_float(__builtin_amdgcn_ds_bpermute((lane ^ 32) << 2, __float_as_int(sm)));
                const float inv = 1.0f / sm;
                const int row = u.pm * BM + ai * HALF + wr * 64 + m * 16 + fr, seg = row_seg(row), t = row - seg_base(seg);
                float* o = AFF + ((size_t)seg * NE + 4 * fq) * L + t;
                o[0] = e0 * inv; o[(size_t)L] = e1 * inv; o[(size_t)2 * L] = e2 * inv; o[(size_t)3 * L] = e3 * inv; }
    }
};
struct GroupOrder {
    StaticOrder so; int tf, nNl, nsh, G, c;
    __device__ void init(int nsl, int nNl_, int G_, int c_) { const int tv = (nsl + 255) / 256, rem = nsl & 255; const bool sh = rem != 0 && rem <= 128; tf = sh ? tv - 1 : tv; nNl = nNl_; nsh = sh ? NE * nNl_ : 0; G = G_; c = c_;
        so.init(NE * tf * BM, nNl_ * BM, G_, c_); }
    __device__ bool next(int i, Unit& u) const {
        if (so.next(i, u)) { const int e = u.pm / tf; u.pm = e * TPE + (u.pm - e * tf); u.pn += e * nNl; return true; }
        const long j = (long)i * G + c - so.nwg; if (j >= nsh) return false;
        const int e = (int)j / nNl; u.pm = e * TPE + tf; u.pn = (int)j; return true;
    }
    __device__ __forceinline__ bool is_half(const Unit& u) const { return nsh != 0 && (u.pm % TPE) == tf; }
    __device__ __forceinline__ void a_ready(const Unit&) const {}
    __device__ __forceinline__ void done(const Unit&) const {}
};
}

namespace attn_body {
using bf16=__hip_bfloat16;
using bf16x8=__attribute__((ext_vector_type(8)))short;
using s16x4=__attribute__((ext_vector_type(4)))short;
using f32x16=__attribute__((ext_vector_type(16)))float;
using u32x4=__attribute__((ext_vector_type(4)))unsigned;
constexpr int D=64,ZP=DIN,OP=1024,NTC=LC/64;
constexpr int NW=8,QBLK=32,QB=QBLK*NW,KVBLK=64,NQB=L/QB;
__device__ __forceinline__ int crow(int r,int hi){return (r&3)+8*(r>>2)+4*hi;}
#define SBAR() __builtin_amdgcn_sched_barrier(0)
constexpr int NSLOT=3, SLOTB=8192;
constexpr int LDS_K=0, LDS_V=NSLOT*SLOTB, LDS_WS=2*NSLOT*SLOTB, LDS_OST=LDS_WS+NW*64*4, LDS_BYTES=LDS_OST+NW*4096;
constexpr float C2=0.125f*1.4426950408889634f;
__device__ __forceinline__ void glds16(const void*sbase,unsigned voff,unsigned lds_dst){unsigned keep;
  asm volatile("s_mov_b32 %0, m0\n\ts_mov_b32 m0, %3\n\ts_nop 0\n\tglobal_load_lds_dwordx4 %1, %2\n\ts_mov_b32 m0, %0":"=&s"(keep):"v"(voff),"s"(sbase),"s"(lds_dst):"memory");}
__device__ __forceinline__ float max3f(float a,float b,float c){float r;asm("v_max3_f32 %0, %1, %2, %3":"=v"(r):"v"(a),"v"(b),"v"(c));return r;}
__device__ __forceinline__ float max2f(float a,float b){float r;asm("v_max_f32_e32 %0, %1, %2":"=v"(r):"v"(a),"v"(b));return r;}
__device__ __forceinline__ float fadd_s(float a,float b){float r;asm("v_add_f32_e32 %0, %1, %2":"=v"(r):"v"(a),"v"(b));return r;}
__device__ __forceinline__ float fsub_s(float a,float b){float r;asm("v_sub_f32_e32 %0, %1, %2":"=v"(r):"v"(a),"v"(b));return r;}
typedef float f32x2_t __attribute__((ext_vector_type(2))); typedef __bf16 bf16x2_t __attribute__((ext_vector_type(2)));
__device__ __forceinline__ unsigned cvtpk_s(float lo,float hi){f32x2_t v={lo,hi};bf16x2_t b=__builtin_convertvector(v,bf16x2_t);return __builtin_bit_cast(unsigned,b);}
#define WAIT_BAR(N) asm volatile("s_waitcnt vmcnt(" #N ") lgkmcnt(0)\n\ts_barrier":::"memory")

__device__ __forceinline__ void qkt(f32x16&p0,f32x16&p1,const char*Kslot,const bf16x8*qr,const f32x16&negm,int r32,int hi){
  const char*kb=Kslot+hi*1024+r32*16;
  #pragma unroll
  for(int d0=0;d0<4;++d0){
    const bf16x8 b0=*reinterpret_cast<const bf16x8*>(kb+d0*2048);
    const bf16x8 b1=*reinterpret_cast<const bf16x8*>(kb+d0*2048+512);
    if(d0==0){p0=__builtin_amdgcn_mfma_f32_32x32x16_bf16(b0,qr[0],negm,0,0,0);p1=__builtin_amdgcn_mfma_f32_32x32x16_bf16(b1,qr[0],negm,0,0,0);}
    else{p0=__builtin_amdgcn_mfma_f32_32x32x16_bf16(b0,qr[d0],p0,0,0,0);p1=__builtin_amdgcn_mfma_f32_32x32x16_bf16(b1,qr[d0],p1,0,0,0);}}
}
typedef __attribute__((address_space(3))) const char* lds_cptr;
typedef short v4i16_t __attribute__((ext_vector_type(4)));
__device__ __forceinline__ void kload8(bf16x8*kf,lds_cptr kp){
  kf[0]=*(const __attribute__((address_space(3))) bf16x8*)(kp);      kf[1]=*(const __attribute__((address_space(3))) bf16x8*)(kp+512);
  kf[2]=*(const __attribute__((address_space(3))) bf16x8*)(kp+2048); kf[3]=*(const __attribute__((address_space(3))) bf16x8*)(kp+2560);
  kf[4]=*(const __attribute__((address_space(3))) bf16x8*)(kp+4096); kf[5]=*(const __attribute__((address_space(3))) bf16x8*)(kp+4608);
  kf[6]=*(const __attribute__((address_space(3))) bf16x8*)(kp+6144); kf[7]=*(const __attribute__((address_space(3))) bf16x8*)(kp+6656);
}
__device__ __forceinline__ void kload2(bf16x8*kf,lds_cptr kp,int j){ kf[2*j]=*(const __attribute__((address_space(3))) bf16x8*)(kp+j*2048); kf[2*j+1]=*(const __attribute__((address_space(3))) bf16x8*)(kp+j*2048+512); }
__device__ __forceinline__ s16x4 vtr(lds_cptr p){ return __builtin_bit_cast(s16x4,__builtin_amdgcn_ds_read_tr16_b64_v4i16((__attribute__((address_space(3))) v4i16_t*)p)); }
__device__ __forceinline__ float rowmax(const f32x16&p0,const f32x16&p1){
  float a=max3f(p0[0],p0[1],p1[0]),b=max3f(p0[2],p0[3],p1[1]);a=max3f(a,p1[2],p1[3]);
  #pragma unroll
  for(int r=4;r<16;r+=4){a=max3f(a,p0[r],p0[r+1]);b=max3f(b,p0[r+2],p0[r+3]);a=max3f(a,p1[r],p1[r+1]);b=max3f(b,p1[r+2],p1[r+3]);}
  const float m=max2f(a,b);
  auto rr=__builtin_amdgcn_permlane32_swap(__float_as_uint(m),__float_as_uint(m),false,false);
  return max2f(__uint_as_float(rr[0]),__uint_as_float(rr[1]));
}
__device__ __forceinline__ void pv(f32x16*o,int vb,bf16x8 pa0,bf16x8 pa1,bf16x8 pa2,bf16x8 pa3){
  #pragma unroll
  for(int d0=0;d0<2;++d0){s16x4 lo[4],hi[4];
    #pragma unroll
    for(int ks=0;ks<4;++ks){
      asm volatile("ds_read_b64_tr_b16 %0,%1 offset:%c2":"=&v"(lo[ks]):"v"(vb),"i"(d0*4096+ks*1024):"memory");
      asm volatile("ds_read_b64_tr_b16 %0,%1 offset:%c2":"=&v"(hi[ks]):"v"(vb),"i"(d0*4096+ks*1024+512):"memory");}
    asm volatile("s_waitcnt lgkmcnt(0)":::"memory");SBAR();
    #define PK(k) (bf16x8){lo[k][0],lo[k][1],lo[k][2],lo[k][3],hi[k][0],hi[k][1],hi[k][2],hi[k][3]}
    o[d0]=__builtin_amdgcn_mfma_f32_32x32x16_bf16(pa0,PK(0),o[d0],0,0,0);
    o[d0]=__builtin_amdgcn_mfma_f32_32x32x16_bf16(pa1,PK(1),o[d0],0,0,0);
    o[d0]=__builtin_amdgcn_mfma_f32_32x32x16_bf16(pa2,PK(2),o[d0],0,0,0);
    o[d0]=__builtin_amdgcn_mfma_f32_32x32x16_bf16(pa3,PK(3),o[d0],0,0,0);
    #undef PK
  }
}

#ifndef ATTN_STORE16
#define ATTN_STORE16(p,v) (*(u32x4*)(p)=(v))
#endif
__device__ __forceinline__ void wmask(f32x16&p0,f32x16&p1,int s0,int tq,int hi){
  const float NEG=-INFINITY;
  #pragma unroll
  for(int r=0;r<16;++r){ const int s=s0+4*hi+(r&3)+8*(r>>2); const int d0=tq-s,d1=d0-32;
    if(!(s>=0&&s<L&&d0<=WINDOW&&d0>=-WINDOW))p0[r]=NEG; if(!(s+32>=0&&s+32<L&&d1<=WINDOW&&d1>=-WINDOW))p1[r]=NEG; }
}
template<int MODE,int THRL,bool FAST> __device__ __forceinline__ void attn_unit(int b,int h,int qb,const bf16*__restrict__ Z,bf16*O,char*shm,int wv,float sinkl2,const float*qnw,const float*rope){
  constexpr bool ISC=(MODE==1||MODE==2),CTXQ=(MODE>=2),WIN=(MODE==1);
  constexpr int QCOL=ISC?Z_CQ:Z_DQ,KCOL=ISC?Z_CK:Z_DK,VCOL=ISC?Z_CV:Z_DV,OCOL=ISC?512:768;
  static_assert(!CTXQ||LC==QB,"context queries: one 256-row unit per (batch, head)");
  const int lane=lane_id(),r32=lane&31,hi=lane>>5; const int wid=wv;
  const long rowbase=CTXQ?(long)NLAT+(long)b*LC:(long)b*L; const int q0=CTXQ?0:qb*QB; const int kvh=h>>1;
  const bf16*Qw=Z+(rowbase+q0+wid*QBLK)*ZP+QCOL+h*D;
  const bf16*Zk=Z+KCOL+kvh*D,*Zv=Z+VCOL+kvh*D; const int crow0=NLAT+b*LC,lrow0=b*L;
  const int kt0=WIN?q0/KVBLK-2-NTC:-NTC;
  #define TROW(t) __builtin_amdgcn_readfirstlane((t)<NTC?crow0+(t)*KVBLK:lrow0+(CTXQ?0:(WIN?min(max(kt0+(t),0),L/KVBLK-1):kt0+(t)))*KVBLK)
  const unsigned lds0=(unsigned)(uintptr_t)shm;
  float*wsf=(float*)(shm+LDS_WS)+wid*64;
  const unsigned koff=(unsigned)(lane*ZP+wid*8)*2u, voff=(unsigned)((16*(wid&3)+(lane>>2))*ZP+(wid>>2)*32+(lane&3)*8)*2u;
  const unsigned kdst=lds0+LDS_K+wid*1024, vdst=lds0+LDS_V+wid*1024;
  #define DMA_K(t,slot) glds16(Zk+(long)TROW(t)*ZP,koff,(unsigned)__builtin_amdgcn_readfirstlane(kdst+(slot)))
  #define DMA_V(t,slot) glds16(Zv+(long)TROW(t)*ZP,voff,(unsigned)__builtin_amdgcn_readfirstlane(vdst+(slot)))
  const int vb0=(int)(lds0+LDS_V)+((lane>>4)&1)*32+(lane&3)*8+(4*hi+((lane&15)>>2))*64;
  const char*Kbase=shm+LDS_K; bf16x8 kf[8];
  const lds_cptr shm3=(lds_cptr)shm; const lds_cptr kp0=shm3+LDS_K+hi*1024+r32*16; const lds_cptr vp0=shm3+LDS_V+((lane>>4)&1)*32+(lane&3)*8+(4*hi+((lane&15)>>2))*64;
  constexpr int NT=CTXQ?NTC+2:(WIN?NTC+8:(LC+L)/KVBLK);
  DMA_K(0,0);DMA_V(0,0);DMA_K(1,SLOTB);
  bf16x8 qr[4];
  #pragma unroll
  for(int d0=0;d0<4;++d0)qr[d0]=*reinterpret_cast<const bf16x8*>(&Qw[(long)r32*ZP+d0*16+hi*8]);
  { float xq[4][8];
    #pragma unroll
    for(int d0=0;d0<4;++d0){
      #pragma unroll
      for(int j=0;j<8;++j)xq[d0][j]=__uint_as_float(((unsigned)(unsigned short)qr[d0][j])<<16); }
    if(!ISC){ float ss=0.f;
      #pragma unroll
      for(int d0=0;d0<4;++d0){
        #pragma unroll
        for(int j=0;j<8;++j)ss+=xq[d0][j]*xq[d0][j]; }
      {auto rr=__builtin_amdgcn_permlane32_swap(__float_as_uint(ss),__float_as_uint(ss),false,false);ss=__uint_as_float(rr[0])+__uint_as_float(rr[1]);}
      const float rstd=1.0f/sqrtf(ss*(1.0f/64.0f)+EPS);
      #pragma unroll
      for(int d0=0;d0<4;++d0){
        #pragma unroll
        for(int j=0;j<8;++j)xq[d0][j]=xq[d0][j]*rstd*qnw[16*d0+8*hi+j]; } }
    if(!CTXQ){ const int tpos=q0+wid*QBLK+r32,pr=tpos>>6,pc=tpos&63;
      #pragma unroll
      for(int j=0;j<8;++j){ const int f=8*hi+j;
        { const float c=rope[(pr*16+f)*2],s_=rope[(pr*16+f)*2+1],x1=xq[0][j],x2=xq[1][j]; xq[0][j]=x1*c-x2*s_; xq[1][j]=x2*c+x1*s_; }
        { const float c=rope[(pc*16+f)*2],s_=rope[(pc*16+f)*2+1],x1=xq[2][j],x2=xq[3][j]; xq[2][j]=x1*c-x2*s_; xq[3][j]=x2*c+x1*s_; } } }
    #pragma unroll
    for(int d0=0;d0<4;++d0){ const u32x4 w=(u32x4){cvtpk_s(xq[d0][0]*QC2,xq[d0][1]*QC2),cvtpk_s(xq[d0][2]*QC2,xq[d0][3]*QC2),cvtpk_s(xq[d0][4]*QC2,xq[d0][5]*QC2),cvtpk_s(xq[d0][6]*QC2,xq[d0][7]*QC2)}; qr[d0]=__builtin_bit_cast(bf16x8,w); } }
  float mhat=0.f,l_reg=0.f;f32x16 o[2];o[0]=f32x16{};o[1]=f32x16{};const f32x16 negm=f32x16{};
  const int tq=q0+wid*QBLK+r32;
  #define CMASK(P0,P1,t) do{ if(MODE&&(t)>=NTC)wmask(P0,P1,CTXQ?-(1<<24):(kt0+(t))*KVBLK,tq,hi); }while(0)
  bool resc=false;
  #define START(P0,P1) do{ resc=false; \
    if(!FAST){ const float rm=rowmax(P0,P1); const float dl=rm; mhat=fadd_s(mhat,dl); \
      _Pragma("unroll") for(int r=0;r<16;++r){P0[r]=fsub_s(P0[r],dl);P1[r]=fsub_s(P1[r],dl);} } \
    _Pragma("unroll") for(int r=0;r<16;++r)P0[r]=__builtin_amdgcn_exp2f(P0[r]); }while(0)
  #define RESC() do{ if(!FAST&&resc){ asm volatile("s_waitcnt lgkmcnt(0)":::"memory"); \
      _Pragma("unroll") for(int d_=0;d_<2;++d_) _Pragma("unroll") for(int r=0;r<16;++r)o[d_][r]*=wsf[crow(r,hi)]; } }while(0)
  f32x16 pA0,pA1,pB0,pB1;
  int sl_prev=0,sl_cur=0,sl_next=SLOTB;
  #define ROT() do{sl_prev=sl_cur;sl_cur=sl_next;sl_next=(sl_next==(NSLOT-1)*SLOTB)?0:sl_next+SLOTB;}while(0)
  DMA_K(2,2*SLOTB);
  WAIT_BAR(3);
  qkt(pA0,pA1,Kbase,qr,negm,r32,hi);asm volatile("s_nop 15\n\ts_nop 7":"+v"(pA0),"+v"(pA1));CMASK(pA0,pA1,0);
  START(pA0,pA1);
  _Pragma("unroll") for(int r=0;r<16;++r)pA1[r]=__builtin_amdgcn_exp2f(pA1[r]);
  WAIT_BAR(0);
  DMA_K(3,0);DMA_V(1,SLOTB);
  ROT();
  kload8(kf,kp0+sl_cur);
  WAIT_BAR(2);
  s16x4 vlo[8],vhi[8]; u32x4 pw0,pw1,pw2,pw3;
  #define PKW(P,B) cvtpk_s(P[B],P[B+1])
  #define PAF(k) __builtin_bit_cast(bf16x8,pw##k)
  #define VFR(i) (bf16x8){vlo[i][0],vlo[i][1],vlo[i][2],vlo[i][3],vhi[i][0],vhi[i][1],vhi[i][2],vhi[i][3]}
  #define PIN(x) asm volatile("":"+v"(x))
  #define MX3(a,b,c) __builtin_fmaxf(__builtin_fmaxf((a),(b)),(c))
  #define GAPA(MF,A0,A1,A2,A3,W0,W1,PW) do{ MF; sacc+=A0; sacc+=A1; sacc+=A2; sacc+=A3; PIN(sacc); W0; W1; PIN(PW); SBAR(); }while(0)
  #define EX(v) __builtin_amdgcn_exp2f(v)
  #define SH(v) (FAST?(v):(v)-mhat)
  #define GAPB(MF,X,B) do{ MF; X[B]=EX(SH(X[B])); X[B+1]=EX(SH(X[B+1])); X[B+2]=EX(SH(X[B+2])); X[B+3]=EX(SH(X[B+3])); PIN(X); SBAR(); }while(0)
  #define VRD(i) do{ vlo[i]=vtr(vp_+(((i)>>2)*4096+((i)&3)*1024)); vhi[i]=vtr(vp_+(((i)>>2)*4096+((i)&3)*1024+512)); }while(0)
  #define KRD(G,j) do{ if(G){ kload2(kf,kp0+sl_next,j); SBAR(); } }while(0)
  #define STEP(C0,C1,P0,P1,t,GK,GV,GL) do{ SBAR(); \
    const lds_cptr vp_=vp0+sl_prev; \
    VRD(0); SBAR(); float sacc=(P0[0]+P0[1]); \
    GAPA(C0=__builtin_amdgcn_mfma_f32_32x32x16_bf16(kf[0],qr[0],negm,0,0,0), P0[2],P0[3],P0[4],P0[5],     pw0[0]=PKW(P0,0), pw0[1]=PKW(P0,2), pw0); \
    VRD(4); SBAR(); GAPA(C1=__builtin_amdgcn_mfma_f32_32x32x16_bf16(kf[1],qr[0],negm,0,0,0), P0[6],P0[7],P0[8],P0[9],     pw0[2]=PKW(P0,4), pw0[3]=PKW(P0,6), pw0); \
    VRD(1); SBAR(); GAPA(C0=__builtin_amdgcn_mfma_f32_32x32x16_bf16(kf[2],qr[1],C0,0,0,0),   P0[10],P0[11],P0[12],P0[13], pw1[0]=PKW(P0,8), pw1[1]=PKW(P0,10), pw1); \
    VRD(5); SBAR(); GAPA(C1=__builtin_amdgcn_mfma_f32_32x32x16_bf16(kf[3],qr[1],C1,0,0,0),   P0[14],P0[15],P1[0],P1[1],   pw1[2]=PKW(P0,12),pw1[3]=PKW(P0,14), pw1); \
    VRD(2); SBAR(); GAPA(C0=__builtin_amdgcn_mfma_f32_32x32x16_bf16(kf[4],qr[2],C0,0,0,0),   P1[2],P1[3],P1[4],P1[5],     pw2[0]=PKW(P1,0), pw2[1]=PKW(P1,2), pw2); \
    VRD(6); SBAR(); GAPA(C1=__builtin_amdgcn_mfma_f32_32x32x16_bf16(kf[5],qr[2],C1,0,0,0),   P1[6],P1[7],P1[8],P1[9],     pw2[2]=PKW(P1,4), pw2[3]=PKW(P1,6), pw2); \
    VRD(3); SBAR(); GAPA(C0=__builtin_amdgcn_mfma_f32_32x32x16_bf16(kf[6],qr[3],C0,0,0,0),   P1[10],P1[11],P1[12],P1[13], pw3[0]=PKW(P1,8), pw3[1]=PKW(P1,10), pw3); \
    VRD(7); SBAR(); GAPA(C1=__builtin_amdgcn_mfma_f32_32x32x16_bf16(kf[7],qr[3],C1,0,0,0),   P1[14],P1[15],0.f,0.f,       pw3[2]=PKW(P1,12),pw3[3]=PKW(P1,14), pw3); \
    l_reg+=sacc; \
    if(GK){DMA_K((t)+3,sl_cur);} if(GV){DMA_V((t)+1,sl_next);} \
    CMASK(C0,C1,t); \
    if(!FAST){ float a=MX3(C0[0],C0[1],C1[0]),b=MX3(C0[2],C0[3],C1[1]); a=MX3(a,C1[2],C1[3]); \
      _Pragma("unroll") for(int r=4;r<16;r+=4){a=MX3(a,C0[r],C0[r+1]);b=MX3(b,C0[r+2],C0[r+3]);a=MX3(a,C1[r],C1[r+1]);b=MX3(b,C1[r+2],C1[r+3]);} \
      float rm=__builtin_fmaxf(a,b); { auto rr=__builtin_amdgcn_permlane32_swap(__float_as_uint(rm),__float_as_uint(rm),false,false); rm=__builtin_fmaxf(__uint_as_float(rr[0]),__uint_as_float(rr[1])); } \
      rm-=mhat;   \
      resc=false; \
      if(__builtin_expect(__any(rm>(float)THRL),0)){ const float dl=__builtin_fmaxf(rm,0.f); mhat+=dl; \
        const float f=__builtin_amdgcn_exp2f(-dl); l_reg*=f; if(hi==0)wsf[r32]=f; resc=true; } } \
    SBAR(); \
    GAPB(o[0]=__builtin_amdgcn_mfma_f32_32x32x16_bf16(PAF(0),VFR(0),o[0],0,0,0), C0,0); \
    GAPB(o[1]=__builtin_amdgcn_mfma_f32_32x32x16_bf16(PAF(0),VFR(4),o[1],0,0,0), C0,4); \
    KRD(GL,0); GAPB(o[0]=__builtin_amdgcn_mfma_f32_32x32x16_bf16(PAF(1),VFR(1),o[0],0,0,0), C0,8); \
    KRD(GL,1); GAPB(o[1]=__builtin_amdgcn_mfma_f32_32x32x16_bf16(PAF(1),VFR(5),o[1],0,0,0), C0,12); \
    KRD(GL,2); GAPB(o[0]=__builtin_amdgcn_mfma_f32_32x32x16_bf16(PAF(2),VFR(2),o[0],0,0,0), C1,0); \
    KRD(GL,3); GAPB(o[1]=__builtin_amdgcn_mfma_f32_32x32x16_bf16(PAF(2),VFR(6),o[1],0,0,0), C1,4); \
    GAPB(o[0]=__builtin_amdgcn_mfma_f32_32x32x16_bf16(PAF(3),VFR(3),o[0],0,0,0), C1,8); \
    GAPB(o[1]=__builtin_amdgcn_mfma_f32_32x32x16_bf16(PAF(3),VFR(7),o[1],0,0,0), C1,12); \
    }while(0)
  int t=1;
  for(;t+5<NT;t+=2){
    STEP(pB0,pB1,pA0,pA1,t,true,true,true);     WAIT_BAR(2); RESC(); ROT();
    STEP(pA0,pA1,pB0,pB1,t+1,true,true,true);   WAIT_BAR(2); RESC(); ROT();
  }
  #define ENDW(tt) do{ if((tt)+3<NT){WAIT_BAR(2);} else if((tt)+2<NT){WAIT_BAR(1);} else {WAIT_BAR(0);} }while(0)
  for(;t+1<NT;t+=2){
    STEP(pB0,pB1,pA0,pA1,t,(t+3<NT),(t+1<NT),(t+1<NT));       ENDW(t);   RESC(); ROT();
    STEP(pA0,pA1,pB0,pB1,t+1,(t+4<NT),(t+2<NT),(t+2<NT));     ENDW(t+1); RESC(); ROT();
  }
  STEP(pB0,pB1,pA0,pA1,NT-1,false,false,false); RESC();
  { float sacc=pB0[0]+pB0[1]; _Pragma("unroll") for(int r=2;r<16;++r)sacc+=pB0[r]; _Pragma("unroll") for(int r=0;r<16;++r)sacc+=pB1[r]; l_reg+=sacc;
    pw0=(u32x4){PKW(pB0,0),PKW(pB0,2),PKW(pB0,4),PKW(pB0,6)};pw1=(u32x4){PKW(pB0,8),PKW(pB0,10),PKW(pB0,12),PKW(pB0,14)};pw2=(u32x4){PKW(pB1,0),PKW(pB1,2),PKW(pB1,4),PKW(pB1,6)};pw3=(u32x4){PKW(pB1,8),PKW(pB1,10),PKW(pB1,12),PKW(pB1,14)};
    SBAR(); pv(o,vb0+sl_cur,PAF(0),PAF(1),PAF(2),PAF(3)); }
  #undef PKW
  #undef PAF
  #undef VFR
  #undef PIN
  #undef MX3
  #undef GAPA
  #undef GAPB
  #undef SH
  #undef EX
  #undef VRD
  #undef KRD
  #undef STEP
  #undef ENDW
  {auto rr=__builtin_amdgcn_permlane32_swap(__float_as_uint(l_reg),__float_as_uint(l_reg),false,false);l_reg=__uint_as_float(rr[0])+__uint_as_float(rr[1]);}
  if(ISC)l_reg+=__builtin_amdgcn_exp2f(sinkl2-mhat);
  if(hi==0)wsf[32+r32]=l_reg;asm volatile("s_waitcnt lgkmcnt(0)":::"memory");
  float rli[16];
  #pragma unroll
  for(int r=0;r<16;++r)rli[r]=__builtin_amdgcn_rcpf(wsf[32+crow(r,hi)]);
  bf16*Ow=O+(rowbase+q0+wid*QBLK)*OP+OCOL+h*D;
  { bf16*stg=(bf16*)(shm+LDS_OST)+wid*2048;
    #pragma unroll
    for(int r=0;r<16;++r){const int orow=crow(r,hi);
      #pragma unroll
      for(int d0=0;d0<2;++d0)stg[orow*64+d0*32+r32]=__float2bfloat16(o[d0][r]*rli[r]);}
    asm volatile("s_waitcnt lgkmcnt(0)":::"memory");
    #pragma unroll
    for(int i=0;i<4;++i){const int row=i*8+(lane>>3),ch=lane&7; const u32x4 v=*(const u32x4*)(stg+row*64+ch*8); ATTN_STORE16(Ow+(long)row*OP+ch*8,v);} }
  asm volatile("s_waitcnt lgkmcnt(0)\n\ts_barrier":::"memory");
  #undef DMA_K
  #undef DMA_V
  #undef TROW
  #undef CMASK
  #undef START
  #undef RESC
  #undef ROT
}
constexpr int ATTN_LDS_BYTES=LDS_BYTES;
template<int MODE,int THRL=8,bool FAST=false> __device__ __forceinline__ void attn_phase(char*lds,const bf16*Z,bf16*O,int wv,const float*sink,const float*qnw,const float*rope){
  const int G=grid_dim(), bid=block_id(), vcu=(G%8==0)?(bid%8)*(G/8)+bid/8:bid; constexpr int NQ=(MODE>=2)?1:NQB, NU=NB*4*NQ;
  const int upc=(NU+G-1)/G;
  const int voff=(MODE==3&&G>=2*NU)?NU:0;
  for(int i=0;i<upc;++i){ const int u=(vcu-voff)*upc+i; if(u<0||u>=NU)break; const int qb=u%NQ,bh=u/NQ; attn_unit<MODE,THRL,FAST>(bh>>2,bh&3,qb,Z,O,lds,wv,(MODE==1||MODE==2)?sink[bh&3]*1.4426950408889634f:0.f,qnw,rope); }
}
#undef SBAR
#undef WAIT_BAR
}

constexpr int LDS_BYTES = pg8::STAGE_BYTES + 16;
static_assert(attn_body::ATTN_LDS_BYTES <= pg8::STAGE_BYTES, "attention LDS");

typedef const __attribute__((address_space(4))) Params* KParams;
__device__ __forceinline__ const Params& fresh_params() { KParams p = (KParams)__builtin_amdgcn_kernarg_segment_ptr(); asm volatile("" : "+s"(p)); return *(const Params*)p; }


typedef float f4_t __attribute__((ext_vector_type(4)));
typedef unsigned u2_t __attribute__((ext_vector_type(2)));
__device__ __forceinline__ float lane_read(float v, int src) { return __int_as_float(__builtin_amdgcn_ds_bpermute(src << 2, __float_as_int(v))); }
__device__ __forceinline__ unsigned lane_read(unsigned v, int src) { return (unsigned)__builtin_amdgcn_ds_bpermute(src << 2, (int)v); }
__device__ __forceinline__ float wave_sum(float v, int lane) {
#pragma unroll
    for (int o = 32; o >= 1; o >>= 1) v += lane_read(v, lane ^ o);
    return v;
}
__device__ __forceinline__ unsigned pk_bf16(float lo, float hi) { return (unsigned)f2bf(lo) | ((unsigned)f2bf(hi) << 16); }
__device__ __forceinline__ void norm_mod_row(const float* x, const float* w, const float* sc, const float* sh, bf16_t* h, int lane, f4_t (&hv)[4]) {
    f4_t xv[4]; float ss = 0.f;
#pragma unroll
    for (int j = 0; j < 4; ++j) { xv[j] = ((const f4_t*)x)[j * 64 + lane]; ss += xv[j][0] * xv[j][0] + xv[j][1] * xv[j][1] + xv[j][2] * xv[j][2] + xv[j][3] * xv[j][3]; }
    ss = wave_sum(ss, lane);
    const float rstd = 1.0f / sqrtf(ss * (1.0f / D) + EPS);
#pragma unroll
    for (int j = 0; j < 4; ++j) { const f4_t wv4 = ((const f4_t*)w)[j * 64 + lane], s4 = ((const f4_t*)sc)[j * 64 + lane], b4 = ((const f4_t*)sh)[j * 64 + lane];
        hv[j] = xv[j] * rstd * wv4 * (1.0f + s4) + b4;
        u2_t o; o.x = pk_bf16(hv[j][0], hv[j][1]); o.y = pk_bf16(hv[j][2], hv[j][3]); ((u2_t*)h)[j * 64 + lane] = o; }
}
template <int NR_, class XF, class HF> __device__ __forceinline__ void norm_rows(const Params& P, int l, int which  , int r0, int dr, int n, int lane, XF xrow, HF hrow) {
    f4_t xv[NR_][4];
#pragma unroll
    for (int q = 0; q < NR_; ++q) { const int r = r0 + q * dr; if (r < n) { const float* x = xrow(r);
#pragma unroll
        for (int j = 0; j < 4; ++j) xv[q][j] = __builtin_nontemporal_load((const f4_t*)x + j * 64 + lane); } }
    f4_t gv[4], sv[4]; int wcur = -1;
#pragma unroll
    for (int q = 0; q < NR_; ++q) { const int r = r0 + q * dr; if (r < n) { float ss = 0.f;
#pragma unroll
        for (int j = 0; j < 4; ++j) ss += xv[q][j][0] * xv[q][j][0] + xv[q][j][1] * xv[q][j][1] + xv[q][j][2] * xv[q][j][2] + xv[q][j][3] * xv[q][j][3];
        ss = wave_sum(ss, lane);
        const float rstd = 1.0f / sqrtf(ss * (1.0f / D) + EPS); const int who = row_who(r);
        if (who != wcur) { wcur = who; const float* sc = modv(P, l, who, which == 1 ? 1 : 4); const float* sh = modv(P, l, who, which == 1 ? 0 : 3);
#pragma unroll
            for (int j = 0; j < 4; ++j) { gv[j] = ((const f4_t*)sc)[j * 64 + lane]; sv[j] = ((const f4_t*)sh)[j * 64 + lane]; } }
        bf16_t* h = hrow(r);
#pragma unroll
        for (int j = 0; j < 4; ++j) { const f4_t hv = xv[q][j] * rstd * gv[j] + sv[j];
            u2_t o; o.x = pk_bf16(hv[0], hv[1]); o.y = pk_bf16(hv[2], hv[3]); ((u2_t*)h)[j * 64 + lane] = o; } } }
}
template <int NR_, class HF> __device__ __forceinline__ void norm_rows16(const Params& P, int l, int r0, int dr, int n, int lane, HF hrow) {
    u2_t xr[NR_][4];
#pragma unroll
    for (int q = 0; q < NR_; ++q) { const int r = r0 + q * dr; if (r < n) { const u2_t* x = (const u2_t*)(P.XB + (size_t)r * D);
#pragma unroll
        for (int j = 0; j < 4; ++j) xr[q][j] = x[j * 64 + lane]; } }
    f4_t gv[4], sv[4]; int wcur = -1;
#pragma unroll
    for (int q = 0; q < NR_; ++q) { const int r = r0 + q * dr; if (r < n) { float ss = 0.f; f4_t xv[4];
#pragma unroll
        for (int j = 0; j < 4; ++j) { xv[j] = (f4_t){bf_lo(xr[q][j].x), bf_hi(xr[q][j].x), bf_lo(xr[q][j].y), bf_hi(xr[q][j].y)}; ss += xv[j][0] * xv[j][0] + xv[j][1] * xv[j][1] + xv[j][2] * xv[j][2] + xv[j][3] * xv[j][3]; }
        ss = wave_sum(ss, lane);
        const float rstd = 1.0f / sqrtf(ss * (1.0f / D) + EPS); const int who = row_who(r);
        if (who != wcur) { wcur = who; const float* sc = modv(P, l, who, 4); const float* sh = modv(P, l, who, 3);
#pragma unroll
            for (int j = 0; j < 4; ++j) { gv[j] = ((const f4_t*)sc)[j * 64 + lane]; sv[j] = ((const f4_t*)sh)[j * 64 + lane]; } }
        bf16_t* h = hrow(r);
#pragma unroll
        for (int j = 0; j < 4; ++j) { const f4_t hv = xv[j] * rstd * gv[j] + sv[j];
            u2_t o; o.x = pk_bf16(hv[0], hv[1]); o.y = pk_bf16(hv[2], hv[3]); ((u2_t*)h)[j * 64 + lane] = o; } } }
}
__device__ __forceinline__ void mod_wave(const Params& P, int w, int lane) {
    const int nb = w % 96, who = (w / 96) % 3, l = w / 288, n = nb * 64 + lane;
    const float* cv = who < 2 ? P.c + who * D : P.c_ctx; const float* wp = P.mod_w + (size_t)l * D * 6 * D + n;
    float acc = 0.f;
    for (int j = 0; j < 16; ++j) { const float x = cv[j * 64 + lane], sv = x * __builtin_amdgcn_rcpf(1.0f + __expf(-x));
#pragma unroll
        for (int kk = 0; kk < 64; ++kk) acc += __int_as_float(__builtin_amdgcn_readlane(__float_as_int(sv), kk)) * wp[(size_t)(j * 64 + kk) * 6 * D]; }
    float v = acc + P.mod_b[l * 6 * D + n];
    { const int part = nb >> 4, col = n & (D - 1);
      if (part == 1) v = (1.0f + v) * P.norm1_w[l * D + col]; else if (part == 4) v = (1.0f + v) * P.norm2_w[l * D + col]; }
    P.MOD[(size_t)(l * 3 + who) * 6 * D + n] = v;
}
struct CombVec { f4_t m5v[4], gv[4], sv[4]; int wcur; };
template <int LYR> __device__ __forceinline__ void comb_wave(const Params& P, int row, int lane, CombVec& cv) {
    const int who = row_who(row); u2_t* xb = (u2_t*)(P.XB + (size_t)row * D);
    int inv[16];
#pragma unroll
    for (int e = 0; e < NE; ++e) inv[e] = P.INV[(size_t)e * NR + row];
    f4_t acc[4];
#pragma unroll
    for (int j = 0; j < 4; ++j) acc[j] = (f4_t){0.f, 0.f, 0.f, 0.f};
#pragma unroll
    for (int e = 0; e < NE; ++e) { const int sl = __builtin_amdgcn_readfirstlane(inv[e]);
        if (sl >= 0) { const float g = P.GATE[e * SLOTS_PAD + sl]; const u2_t* yr = (const u2_t*)(P.Y + ((size_t)e * SLOTS_PAD + sl) * D);
#pragma unroll
            for (int j = 0; j < 4; ++j) { const u2_t w = yr[j * 64 + lane]; acc[j] += g * (f4_t){bf_lo(w.x), bf_hi(w.x), bf_lo(w.y), bf_hi(w.y)}; } } }
    if (who != cv.wcur) { cv.wcur = who; const float* m5 = modv(P, LYR, who, 5);
        const float* gsrc = LYR == 0 ? modv(P, 1, who, 1) : P.final_norm_w; const float* ssrc = modv(P, 1, who, 0);
#pragma unroll
        for (int j = 0; j < 4; ++j) { cv.m5v[j] = ((const f4_t*)m5)[j * 64 + lane]; cv.gv[j] = ((const f4_t*)gsrc)[j * 64 + lane]; if (LYR == 0) cv.sv[j] = ((const f4_t*)ssrc)[j * 64 + lane]; } }
    f4_t xv[4]; float ss = 0.f;
#pragma unroll
    for (int j = 0; j < 4; ++j) { const u2_t xw = xb[j * 64 + lane]; xv[j] = (f4_t){bf_lo(xw.x), bf_hi(xw.x), bf_lo(xw.y), bf_hi(xw.y)} + cv.m5v[j] * acc[j];
        ss += xv[j][0] * xv[j][0] + xv[j][1] * xv[j][1] + xv[j][2] * xv[j][2] + xv[j][3] * xv[j][3]; }
    ss = wave_sum(ss, lane);
    const float rstd = 1.0f / sqrtf(ss * (1.0f / D) + EPS);
    if (LYR == 0) {
        const float *w = P.norm1_w + D, *sc = modv(P, 1, who, 1), *sh = modv(P, 1, who, 0); bf16_t* h = P.H + (size_t)row * D;
#pragma unroll
        for (int j = 0; j < 4; ++j) { u2_t xo; xo.x = pk_bf16(xv[j][0], xv[j][1]); xo.y = pk_bf16(xv[j][2], xv[j][3]); xb[j * 64 + lane] = xo;
            const f4_t hv = xv[j] * rstd * cv.gv[j] + cv.sv[j];
            u2_t o; o.x = pk_bf16(hv[0], hv[1]); o.y = pk_bf16(hv[2], hv[3]); ((u2_t*)h)[j * 64 + lane] = o; }
    } else {
        float* x = P.out + (size_t)row * D;
#pragma unroll
        for (int j = 0; j < 4; ++j) __builtin_nontemporal_store(xv[j] * rstd * cv.gv[j], (f4_t*)x + j * 64 + lane);
    }
}
__device__ __forceinline__ unsigned block_excl_scan(unsigned v, unsigned* wsum, int wv, int lane, unsigned& total) {
    unsigned inc = v;
#pragma unroll
    for (int o = 1; o < 64; o <<= 1) { const unsigned t = lane_read(inc, (lane - o) & 63); if (lane >= o) inc += t; }
    __syncthreads();
    if (lane == 63) wsum[wv] = inc;
    __syncthreads();
    unsigned off = 0, tot = 0;
#pragma unroll
    for (int w = 0; w < 8; ++w) { const unsigned t = wsum[w]; off += (w < wv) ? t : 0u; tot += t; }
    total = tot; return off + inc - v;
}
__device__ __forceinline__ void topk_block(const Params& P, int item, int wv, int lane, unsigned* lds) {
    const int e = item & 15, seg = item >> 4, N = seg_len(seg), cap = 2 * N / NE, tid = wv * 64 + lane, base = seg_base(seg);
    const float* a = P.AFF + ((size_t)seg * NE + e) * L;
    unsigned* K = lds; unsigned* hist = lds + 16896; unsigned* sh = hist + 16 * 256; unsigned* wsum = sh + 8;
#define KP(i) ((i) + ((i) >> 5))
    { const int n4 = N >> 2; f4_t v[8];
#pragma unroll
        for (int j = 0; j < 8; ++j) { const int q = tid + 512 * j; if (q < n4) v[j] = ((const f4_t*)a)[q]; }
#pragma unroll
        for (int j = 0; j < 8; ++j) { const int q = tid + 512 * j; if (q < n4) { const int p = KP(4 * q); K[p] = __float_as_uint(v[j][0]); K[p + 1] = __float_as_uint(v[j][1]); K[p + 2] = __float_as_uint(v[j][2]); K[p + 3] = __float_as_uint(v[j][3]); } } }
    if (tid == 0) { sh[0] = 0u; sh[1] = (unsigned)cap; }
    __syncthreads();
    for (int pass = 3; pass >= 0; --pass) {
        const int shift = pass * 8; const unsigned maskhi = pass == 3 ? 0u : (0xFFFFFFFFu << (shift + 8));
        for (int i = tid; i < 16 * 256; i += 512) hist[i] = 0u;
        __syncthreads();
        const unsigned prefix = sh[0];
        for (int i = tid; i < N; i += 512) { const unsigned k = K[KP(i)]; if ((k & maskhi) == prefix) atomicAdd(&hist[(lane & 15) * 256 + ((k >> shift) & 255u)], 1u); }
        __syncthreads();
        if (wv == 0) {
            unsigned c[4]; unsigned tot = 0;
#pragma unroll
            for (int j = 0; j < 4; ++j) { unsigned a = 0;
#pragma unroll
                for (int q = 0; q < 16; ++q) a += hist[q * 256 + 4 * lane + j];
                c[j] = a; tot += a; }
            unsigned inc = tot;
#pragma unroll
            for (int o = 1; o < 64; o <<= 1) { const unsigned t = lane_read(inc, (lane + o) & 63); if (lane + o < 64) inc += t; }
            unsigned cum = inc - tot; const unsigned rem = sh[1];
#pragma unroll
            for (int j = 3; j >= 0; --j) { if (cum < rem && rem <= cum + c[j]) { sh[0] = prefix | ((unsigned)(4 * lane + j) << shift); sh[1] = rem - cum; } cum += c[j]; }
        }
        __syncthreads();
    }
    const unsigned kstar = sh[0], need = sh[1];
    const int per = (N + 511) / 512, i0 = tid * per; const bool act = i0 < N;
    unsigned gt = 0, eq = 0;
    if (act) for (int j = 0; j < per; ++j) { const unsigned k = K[KP(i0 + j)]; gt += k > kstar ? 1u : 0u; eq += k == kstar ? 1u : 0u; }
    unsigned tot;
    const unsigned eqb = block_excl_scan(eq, wsum, wv, lane, tot);
    const unsigned take = eqb >= need ? 0u : (need - eqb < eq ? need - eqb : eq);
    unsigned slot = block_excl_scan(gt + take, wsum, wv, lane, tot) + (unsigned)(seg < 2 ? seg * CAP_L : 2 * CAP_L + (seg - 2) * CAP_C);
    unsigned tie = eqb;
    if (act) for (int j = 0; j < per; ++j) { const int i = i0 + j; const unsigned k = K[KP(i)]; bool sel = k > kstar; if (k == kstar) { sel = tie < need; ++tie; }
        if (sel) { P.ROWLIST[e * SLOTS_PAD + slot] = base + i; P.GATE[e * SLOTS_PAD + slot] = __uint_as_float(k); K[KP(i)] = slot; ++slot; }
        else K[KP(i)] = 0xFFFFFFFFu; }
    __syncthreads();
    { const int n4 = N >> 2; int4* dst = (int4*)(P.INV + (size_t)e * NR + base);
        for (int q = tid; q < n4; q += 512) { const int p = KP(4 * q); int4 o; o.x = (int)K[p]; o.y = (int)K[p + 1]; o.z = (int)K[p + 2]; o.w = (int)K[p + 3]; dst[q] = o; } }
#undef KP
    __syncthreads();
}

extern __shared__ __attribute__((aligned(16))) unsigned char shm[];

namespace hg {
typedef short bf16x8 __attribute__((ext_vector_type(8)));
typedef float f32x16 __attribute__((ext_vector_type(16)));
typedef unsigned u32x2 __attribute__((ext_vector_type(2)));
typedef unsigned u32x4 __attribute__((ext_vector_type(4)));
typedef float f32x4_t __attribute__((ext_vector_type(4)));
constexpr int CLB = 160, NCHB = TOT / CLB, NBLK = CLB / 32;
constexpr int KTP = 80, QP = 144, OFF_KT = 0, OFF_QL = 64 * KTP, OFF_KL = OFF_QL + 32 * QP, OFF_LAM = OFF_KL + 32 * QP, WAVE_LDS = OFF_LAM + 256;
static_assert(8 * WAVE_LDS <= pg8::STAGE_BYTES, "hgrn LDS");
__device__ __forceinline__ unsigned pkbf(float lo, float hi) { unsigned r; asm volatile("v_cvt_pk_bf16_f32 %0, %1, %2" : "=v"(r) : "v"(lo), "v"(hi)); return r; }
__device__ __forceinline__ bf16x8 frag2(u32x2 a, u32x2 b) { u32x4 w = {a.x, a.y, b.x, b.y}; return __builtin_bit_cast(bf16x8, w); }
__device__ __forceinline__ bf16x8 accfrag(const f32x16& x, int s2) { u32x4 w = {pkbf(x[8 * s2], x[8 * s2 + 1]), pkbf(x[8 * s2 + 2], x[8 * s2 + 3]), pkbf(x[8 * s2 + 4], x[8 * s2 + 5]), pkbf(x[8 * s2 + 6], x[8 * s2 + 7])}; return __builtin_bit_cast(bf16x8, w); }
template <int PH> __device__ __forceinline__ void b_mfma_wave(const Params& P, int l, int u, int lane, int wv) {
    const int c = u % NCHB, bdh = u / NCHB, head = bdh & 3, dir = (bdh >> 2) & 1, b = bdh >> 3, sgn = dir ? -1 : 1;
    PG8_LAS unsigned char* wl = (PG8_LAS unsigned char*)shm + wv * WAVE_LDS;
    const int kk = lane & 31, h = lane >> 5;
    const float lb = P.LB[l * 256 + head * 64 + lane];
    f32x16 S[2][2];
    float* sst = P.SST + (size_t)u * 4096 + h * 256 + kk;
#pragma unroll
    for (int mt = 0; mt < 2; ++mt)
#pragma unroll
        for (int nt = 0; nt < 2; ++nt)
#pragma unroll
            for (int r = 0; r < 16; ++r) S[mt][nt][r] = PH == 1 ? 0.f : sst[(32 * mt + (r & 3) + 8 * (r >> 2)) * 64 + 32 * nt];
    float ptot = 1.f;
    for (int jb = 0; jb < NBLK; ++jb) {
        const int rbase = scan_row(b, dir, c * CLB + 32 * jb);
        bf16x8 vf[2][2]; const int vlane = sgn * 4 * h * DIN + kk;
#pragma unroll
        for (int s2 = 0; s2 < 2; ++s2)
#pragma unroll
            for (int nt = 0; nt < 2; ++nt) { unsigned w[4];
#pragma unroll
                for (int jp = 0; jp < 4; ++jp) { const int tu = 16 * s2 + 8 * (jp >> 1) + 2 * (jp & 1);
                    const bf16_t* vu = P.Z + ((long)rbase + (long)sgn * tu) * DIN + Z_BI + head * 64 + 32 * nt;
                    w[jp] = (unsigned)vu[vlane] | ((unsigned)vu[vlane + sgn * DIN] << 16); }
                vf[s2][nt] = __builtin_bit_cast(bf16x8, (u32x4){w[0], w[1], w[2], w[3]}); }
        { float lam = 1.f; unsigned ktw[4];
          const bf16_t* zf = P.Z + (size_t)rbase * DIN + Z_BFF + dir * 256 + head * 64 + lane; const bf16_t* zq = P.Z + (size_t)rbase * DIN + Z_BQ + head * 64 + lane;
#pragma unroll
          for (int t = 0; t < 32; ++t) { const long ro = (long)sgn * t * DIN;
              const float z = bf2f(zf[ro]), e = __expf(-z), sg = __builtin_amdgcn_rcpf(1.0f + e), f = lb + (1.0f - lb) * sg, om = (1.0f - lb) * e * sg;
              lam = fmaxf(lam * f, 1e-30f);
              const float kt = om * __builtin_amdgcn_rcpf(lam);
              if (t & 1) { ktw[(t >> 1) & 3] = ((unsigned)f2bf(kt) << 16) | ktw[(t >> 1) & 3]; } else ktw[(t >> 1) & 3] = (unsigned)f2bf(kt);
              if ((t & 7) == 7) *(PG8_LAS u32x4*)(wl + OFF_KT + lane * KTP + (t >> 3) * 16) = (u32x4){ktw[0], ktw[1], ktw[2], ktw[3]};
              if (PH == 3) { const float zqv = bf2f(zq[ro]), q = zqv * __builtin_amdgcn_rcpf(1.0f + __expf(-zqv)) * 0.125f;
                  *(PG8_LAS bf16_t*)(wl + OFF_QL + t * QP + lane * 2) = f2bf(q * lam); *(PG8_LAS bf16_t*)(wl + OFF_KL + t * QP + lane * 2) = f2bf(kt); } }
          *(PG8_LAS float*)(wl + OFF_LAM + lane * 4) = lam; ptot *= lam; }
        asm volatile("s_waitcnt lgkmcnt(0)" ::: "memory");
        if (PH == 3) {
            bf16x8 qf[4], kf[4];
#pragma unroll
            for (int sl = 0; sl < 4; ++sl) { const int o = (16 * sl + 4 * h) * 2;
                qf[sl] = frag2(*(PG8_LAS u32x2*)(wl + OFF_QL + kk * QP + o), *(PG8_LAS u32x2*)(wl + OFF_QL + kk * QP + o + 16));
                kf[sl] = frag2(*(PG8_LAS u32x2*)(wl + OFF_KL + kk * QP + o), *(PG8_LAS u32x2*)(wl + OFF_KL + kk * QP + o + 16)); }
            f32x16 ct = {};
#pragma unroll
            for (int sl = 0; sl < 4; ++sl) ct = __builtin_amdgcn_mfma_f32_32x32x16_bf16(kf[sl], qf[sl], ct, 0, 0, 0);
#pragma unroll
            for (int r = 0; r < 16; ++r) { const int sr = (r & 3) + 8 * (r >> 2) + 4 * h; if (sr > kk) ct[r] = 0.f; }
            const bf16x8 af0 = accfrag(ct, 0), af1 = accfrag(ct, 1);
            f32x16 o[2] = {{}, {}};
#pragma unroll
            for (int nt = 0; nt < 2; ++nt) {
#pragma unroll
                for (int sl = 0; sl < 4; ++sl) o[nt] = __builtin_amdgcn_mfma_f32_32x32x16_bf16(qf[sl], accfrag(S[sl >> 1][nt], sl & 1), o[nt], 0, 0, 0);
                o[nt] = __builtin_amdgcn_mfma_f32_32x32x16_bf16(af0, vf[0][nt], o[nt], 0, 0, 0);
                o[nt] = __builtin_amdgcn_mfma_f32_32x32x16_bf16(af1, vf[1][nt], o[nt], 0, 0, 0); }
#pragma unroll
            for (int nt = 0; nt < 2; ++nt)
#pragma unroll
                for (int r = 0; r < 16; ++r) { bf16_t* hu = P.HB + ((long)dir * NR + rbase + (long)sgn * ((r & 3) + 8 * (r >> 2))) * 256 + head * 64 + 32 * nt;
                    hu[sgn * 4 * h * 256 + kk] = f2bf(o[nt][r]); }
        }
#pragma unroll
        for (int mt = 0; mt < 2; ++mt) {
            bf16x8 a0, a1; { const int ro = (32 * mt + kk) * KTP + 4 * h * 2;
                a0 = frag2(*(PG8_LAS u32x2*)(wl + OFF_KT + ro), *(PG8_LAS u32x2*)(wl + OFF_KT + ro + 16));
                a1 = frag2(*(PG8_LAS u32x2*)(wl + OFF_KT + ro + 32), *(PG8_LAS u32x2*)(wl + OFF_KT + ro + 48)); }
#pragma unroll
            for (int nt = 0; nt < 2; ++nt) { S[mt][nt] = __builtin_amdgcn_mfma_f32_32x32x16_bf16(a0, vf[0][nt], S[mt][nt], 0, 0, 0); S[mt][nt] = __builtin_amdgcn_mfma_f32_32x32x16_bf16(a1, vf[1][nt], S[mt][nt], 0, 0, 0); }
#pragma unroll
            for (int g = 0; g < 4; ++g) { const f32x4_t lm = *(PG8_LAS f32x4_t*)(wl + OFF_LAM + (32 * mt + 8 * g + 4 * h) * 4);
#pragma unroll
                for (int nt = 0; nt < 2; ++nt) { S[mt][nt][4 * g] *= lm[0]; S[mt][nt][4 * g + 1] *= lm[1]; S[mt][nt][4 * g + 2] *= lm[2]; S[mt][nt][4 * g + 3] *= lm[3]; } } }
        asm volatile("s_waitcnt lgkmcnt(0)" ::: "memory");
    }
    if (PH == 1) {
#pragma unroll
        for (int mt = 0; mt < 2; ++mt)
#pragma unroll
            for (int nt = 0; nt < 2; ++nt)
#pragma unroll
                for (int r = 0; r < 16; ++r) sst[(32 * mt + (r & 3) + 8 * (r >> 2)) * 64 + 32 * nt] = S[mt][nt][r];
        P.PST[(size_t)u * 64 + lane] = ptot; }
}
}

struct GpuExec {
    int wv;
    __device__ __forceinline__ PG8_LAS unsigned char* lds() const { return (PG8_LAS unsigned char*)shm; }
    template <class F> __device__ __forceinline__ void run(i64 n, F f) { const Params& P = fresh_params(); const int G = grid_dim(); const i64 gsz = (i64)G * 512; for (i64 i = ((i64)wv * G + block_id()) * 64 + lane_id(); i < n; i += gsz) f(P, i); }
    __device__ __forceinline__ void sync_soft() {}
    template <class F> __device__ __forceinline__ void run_skipctx(i64 n, F f) { const Params& P = fresh_params(); const int G = grid_dim(), bid = block_id();
        if (G != 256) { for (i64 i = ((i64)wv * G + bid) * 64 + lane_id(); i < n; i += (i64)G * 512) f(P, i); return; }
        if (bid < 128 && (bid & 7) == 0) return;
        const int G2 = 240, rk = bid >= 128 ? bid - 16 : bid - (bid >> 3) - 1;
        for (i64 i = ((i64)wv * G2 + rk) * 64 + lane_id(); i < n; i += (i64)G2 * 512) f(P, i); }
    __device__ __forceinline__ void sync() { XcdBarrier b; b.bar = fresh_params().bar; b.x = xb_xcc_id(); b.st = (volatile LAS unsigned*)(lds() + pg8::STAGE_BYTES); xcd_barrier(b, wv == 0 && lane_id() == 0); }
    template <class F> __device__ __forceinline__ void run_from(int b0, i64 n, F f) {
        const Params& P = fresh_params(); const int G = grid_dim(), bid = block_id(), o = G > b0 ? b0 : 0, G2 = G - o; if (bid < o) return;
        const i64 gsz = (i64)G2 * 512; for (i64 i = ((i64)wv * G2 + (bid - o)) * 64 + lane_id(); i < n; i += gsz) f(P, i); }
    template <class F> __device__ __forceinline__ void run_wave_from(int b0, int n, F f) { const Params& P = fresh_params(); const int lane = lane_id(), G = grid_dim(), bid = block_id(), o = G > 2 * b0 ? b0 : 0, G2 = G - o; if (bid < o) return;
        for (int r = wv * G2 + (bid - o); r < n; r += G2 * 8) f(P, r, lane); }
    template <class F> __device__ __forceinline__ void run_wave(int n, F f) { const Params& P = fresh_params(); const int lane = lane_id(), G = grid_dim(), nw = G * 8; for (int r = wv * G + block_id(); r < n; r += nw) f(P, r, lane); }
    __device__ __forceinline__ void mod() { run_wave(2 * 3 * 96, [&](const Params& P, int w, int lane) { mod_wave(P, w, lane); }); }
    template <int WHICH> __device__ __forceinline__ void norm_phase(int l, int n) { const Params& P = fresh_params(); const int lane = lane_id(), G = grid_dim(), nw = G * 8;
        for (int r = wv * G + block_id(); r < n; r += 4 * nw) norm_rows<4>(P, l, WHICH, r, nw, n, lane, [&](int rr) { return WHICH == 1 ? xsrc_row(P, l, rr) : (const float*)xcur_row(P, rr); }, [&](int rr) { return P.H + (size_t)rr * D; }); }
    __device__ __forceinline__ void norm1(int l) { if (l == 0) norm_phase<1>(l, NR); }
    __device__ __forceinline__ void comb(int l) { CombVec cv; cv.wcur = -1; if (l == 0) run_wave(NR, [&](const Params& P, int r, int lane) { comb_wave<0>(P, r, lane, cv); }); else run_wave(NLAT, [&](const Params& P, int r, int lane) { comb_wave<1>(P, r, lane, cv); }); }
    __device__ __forceinline__ void norm2(int l) { const Params& P = fresh_params(); const int lane = lane_id(), G = grid_dim(), nw = G * 8, n = nrows_out(l);
        for (int r = wv * G + block_id(); r < n; r += 8 * nw) norm_rows16<8>(P, l, r, nw, n, lane, [&](int rr) { return P.H + (size_t)rr * D; }); }
    __device__ __forceinline__ void final_norm() {}
    __device__ __forceinline__ void xa(int l) { const Params& P = fresh_params(); const int G = grid_dim(); const i64 gsz = (i64)G * 512, n = (i64)NR * 32;
        i64 i = ((i64)wv * G + block_id()) * 64 + lane_id(); const int c8 = (int)(i & 31) * 8;
        float bw[8], w[4][8]; ld8f(P.a_conv_b + l * 256 + c8, bw);
#pragma unroll
        for (int j = 0; j < 4; ++j) ld8f(P.a_conv_w + (l * 4 + j) * 256 + c8, w[j]);
        for (; i < n; i += gsz) { const int row = (int)(i >> 5), seg = row_seg(row), t = row - seg_base(seg), len = seg_len(seg);
            float s[8];
#pragma unroll
            for (int q = 0; q < 8; ++q) s[q] = bw[q];
#pragma unroll
            for (int j = 0; j < 4; ++j) { const int tt = t + j - 2; if (tt >= 0 && tt < len) { float x[8]; ld8(P.Z + (size_t)(row + j - 2) * DIN + Z_AX + c8, x);
#pragma unroll
                for (int q = 0; q < 8; ++q) s[q] += w[j][q] * x[q]; } }
            st8(P.XAB + (size_t)row * 256 + c8, s); } }
    __device__ __forceinline__ void b_out(int l) { const Params& P = fresh_params(); const int G = grid_dim(); const i64 gsz = (i64)G * 512, n = (i64)nrows_out(l) * 4;
        float w[64];
#pragma unroll
        for (int g = 0; g < 8; ++g) { float t8[8]; ld8f(P.b_onorm_w + l * 64 + g * 8, t8);
#pragma unroll
            for (int q = 0; q < 8; ++q) w[g * 8 + q] = t8[q]; }
        for (i64 i = ((i64)wv * G + block_id()) * 64 + lane_id(); i < n; i += gsz) { const int head = (int)(i & 3); const size_t row = (size_t)(i >> 2);
            const bf16_t* o0 = P.HB + row * 256 + head * 64; const bf16_t* o1 = P.HB + ((size_t)NR + row) * 256 + head * 64;
            float o[64]; float ss = 0.f;
#pragma unroll
            for (int g = 0; g < 8; ++g) { float a[8], b[8]; ld8(o0 + g * 8, a); ld8(o1 + g * 8, b);
#pragma unroll
                for (int q = 0; q < 8; ++q) { o[g * 8 + q] = a[q] + b[q]; ss += o[g * 8 + q] * o[g * 8 + q]; } }
            const float rstd = 1.0f / sqrtf(ss * (1.0f / 64.0f) + EPS);
#pragma unroll
            for (int g = 0; g < 8; ++g) { float gt[8], y[8]; ld8(P.Z + row * DIN + Z_BG + head * 64 + g * 8, gt);
#pragma unroll
                for (int q = 0; q < 8; ++q) y[q] = o[g * 8 + q] * rstd * w[g * 8 + q] * siluf_(gt[q]);
                st8(P.YM + row * D + 256 + head * 64 + g * 8, y); } } }
    __device__ __forceinline__ void qkv_prep(int l) { run((i64)NR * 4, [&](const Params& P, i64 i) { st_qkv_prep_k(P, l, i); }); }
    __device__ __forceinline__ void b_pre(int l) {}
    __device__ __forceinline__ void b_scan(int l, int ph) {
        if (ph == 1) run_wave_from(8, 16 * hg::NCHB, [&](const Params& P, int u, int lane) { hg::b_mfma_wave<1>(P, l, u, lane, wv); });
        else if (ph == 2) { if (l == 0) run_skipctx((i64)2 * 2 * 4 * 4096, [&](const Params& P, i64 i) { st_b_scan2<hg::NCHB>(P, l, i); }); else run((i64)2 * 2 * 4 * 4096, [&](const Params& P, i64 i) { st_b_scan2<hg::NCHB>(P, l, i); }); }
        else run_wave(16 * hg::NCHB, [&](const Params& P, int u, int lane) { hg::b_mfma_wave<3>(P, l, u, lane, wv); });
    }
    __device__ __forceinline__ void topk(int l) { const Params& P = fresh_params(); const int lane = lane_id(); for (int it = block_id(); it < (l == 0 ? 4 : 2) * 16; it += grid_dim()) topk_block(P, it, wv, lane, (unsigned*)shm); }
    __device__ __forceinline__ void inproj(int l) {
        const Params& P = fresh_params();
        pg8::StaticOrder S; S.init(NR, DIN, grid_dim(), block_id());
        pg8::EpiZ E{P.Z, DIN};
        pg8::gemm_phase<pg8::EpiZ, pg8::StaticOrder, false>(lds(), pg8::Gemm{P.H, P.WINT, NR, DIN, D}, S, E, nullptr, wv);
    }
    __device__ __forceinline__ void a_coef(int l) {
        const Params& P = fresh_params();
        pg8::StaticOrder S; S.init(NR, 1024, grid_dim(), block_id());
        pg8::EpiCoef E{&P, l};
        pg8::gemm_phase<pg8::EpiCoef, pg8::StaticOrder, false>(lds(), pg8::Gemm{P.XAB, P.WG, NR, 1024, 256}, S, E, nullptr, wv);
    }
    __device__ __forceinline__ void router(int l) {
        const Params& P = fresh_params();
        pg8::StaticOrder S; S.init(nrows_out(l), 256, grid_dim(), block_id());
        pg8::EpiRouter E{P.AFF};
        pg8::gemm_phase<pg8::EpiRouter, pg8::StaticOrder, false>(lds(), pg8::Gemm{P.H, P.RWT, nrows_out(l), 256, D}, S, E, nullptr, wv);
    }
    __device__ __forceinline__ void outproj(int l) {
        const Params& P = fresh_params();
        pg8::StaticOrder S; S.init(nrows_out(l), D, grid_dim(), block_id());
        if (l == 0) { pg8::EpiOut<false> E{P.x, P.ctx, nullptr, P.XB, P.MOD + (size_t)l * 3 * 6 * D};
            pg8::gemm_phase<pg8::EpiOut<false>, pg8::StaticOrder, false>(lds(), pg8::Gemm{P.YM, P.WOUTT, nrows_out(l), D, D}, S, E, nullptr, wv); }
        else { pg8::EpiOut<true> E{nullptr, nullptr, P.XB, P.XB, P.MOD + (size_t)l * 3 * 6 * D};
            pg8::gemm_phase<pg8::EpiOut<true>, pg8::StaticOrder, false>(lds(), pg8::Gemm{P.YM, P.WOUTT, nrows_out(l), D, D}, S, E, nullptr, wv); }
    }
    __device__ __forceinline__ void attn_dense(int l) {
        const Params& P = fresh_params();
        if (P.FLAGS[l]) {
            attn_body::attn_phase<0, 8, true>((char*)shm, (const attn_body::bf16*)P.Z, (attn_body::bf16*)P.YM, wv, nullptr, P.d_qnorm_w + l * 64, P.ROPE);
            if (l == 0) attn_body::attn_phase<3, 8, true>((char*)shm, (const attn_body::bf16*)P.Z, (attn_body::bf16*)P.YM, wv, nullptr, P.d_qnorm_w + l * 64, P.ROPE);
        } else {
            attn_body::attn_phase<0, 8>((char*)shm, (const attn_body::bf16*)P.Z, (attn_body::bf16*)P.YM, wv, nullptr, P.d_qnorm_w + l * 64, P.ROPE);
            if (l == 0) attn_body::attn_phase<3, 8>((char*)shm, (const attn_body::bf16*)P.Z, (attn_body::bf16*)P.YM, wv, nullptr, P.d_qnorm_w + l * 64, P.ROPE);
        }
    }
    __device__ __forceinline__ void attn_win(int l) {
        const Params& P = fresh_params();
        attn_body::attn_phase<1, 8>((char*)shm, (const attn_body::bf16*)P.Z, (attn_body::bf16*)P.YM, wv, P.c_sink + l * 4, nullptr, P.ROPE);
        if (l == 0) attn_body::attn_phase<2, 8>((char*)shm, (const attn_body::bf16*)P.Z, (attn_body::bf16*)P.YM, wv, P.c_sink + l * 4, nullptr, P.ROPE);
    }
    __device__ __forceinline__ void moe1(int l) {
        const Params& P = fresh_params();
        pg8::GroupOrder S; S.init(nslots(l), 8, grid_dim(), block_id());
        pg8::EpiHid E{P.HID};
        pg8::gemm_phase<pg8::EpiHid, pg8::GroupOrder, false, true, true>(lds(), pg8::Gemm{P.H, P.W13T, NE * SLOTS_PAD, NE * 2048, D}, S, E, nullptr, wv, P.ROWLIST);
    }
    __device__ __forceinline__ void moe2(int l) {
        const Params& P = fresh_params();
        pg8::GroupOrder S; S.init(nslots(l), 4, grid_dim(), block_id());
        pg8::EpiY E{P.Y};
        pg8::gemm_phase<pg8::EpiY, pg8::GroupOrder, false, false, true>(lds(), pg8::Gemm{P.HID, P.W2T, NE * SLOTS_PAD, NE * 1024, 1024}, S, E, nullptr, wv);
    }
};

__global__ void __launch_bounds__(512, 2) mega_fwd(Params P) {
    GpuExec ex; ex.wv = __builtin_amdgcn_readfirstlane((int)threadIdx.x >> 6);
    volatile LAS unsigned* xbw = (volatile LAS unsigned*)(ex.lds() + pg8::STAGE_BYTES);
    if (threadIdx.x < 4) xbw[threadIdx.x] = 0u;
    __syncthreads();
    (void)xcd_barrier_post(fresh_params().bar, xbw, threadIdx.x == 0);
    pipeline(ex);
}

extern "C" void kernel_launch(void* const* d_in, const int* in_sizes, int n_in, void* d_out, int out_size, void* d_ws, size_t ws_size, hipStream_t stream) {
    Params P{};
    const float** f = (const float**)&P;
    for (int i = 0; i < 27; ++i) f[i] = (const float*)d_in[i];
    P.out = (float*)d_out;
    const size_t need = carve(P, (char*)d_ws);
    if (need > ws_size) fprintf(stderr, "workspace too small: need %zu have %zu\n", need, ws_size);
    static int grid = 0;
    if (!grid) {
        int dev = 0, cus = 0, per_cu = 0;
        (void)hipGetDevice(&dev);
        (void)hipDeviceGetAttribute(&cus, hipDeviceAttributeMultiprocessorCount, dev);
        (void)hipFuncSetAttribute((const void*)mega_fwd, hipFuncAttributeMaxDynamicSharedMemorySize, LDS_BYTES);
        (void)hipOccupancyMaxActiveBlocksPerMultiprocessor(&per_cu, mega_fwd, 512, LDS_BYTES);
        grid = cus * (per_cu < 1 ? per_cu : 1);
        if (grid <= 0) grid = 256;
    }
    (void)hipMemsetAsync(P.bar, 0, XCD_BAR_WORDS * sizeof(unsigned), stream);
    hipLaunchKernelGGL(mega_fwd, dim3(grid), dim3(512), LDS_BYTES, stream, P);
}
#endif
```
